# Optimizing an MI355X kernel written in HIP

```python
import math
import jax
import jax.numpy as jnp
from jax import lax
import numpy as np

D_MODEL = 2048
BATCH = 2
SEQ = 4096
DEPTH = 2

FNET_GROUPS = 4
FNET_GROUP_DIM = 128
FNET_WIDTH = FNET_GROUPS * FNET_GROUP_DIM
HGRN_HEADS = 6
HGRN_EXPAND = 128
HGRN_HEAD_DV = 128
HGRN_DK = HGRN_HEADS * HGRN_EXPAND
HGRN_DV = HGRN_HEADS * HGRN_HEAD_DV
HGRN_CHUNK = 64
HGRN_NORM_EPS = 1e-6
LB_FLOOR = 1e-30
ATTN_GROUPS = ((128, 1), (512, 4), (2048, 16))
ATTN_HEADS_PER_GROUP = 4
ATTN_HEAD_DIM = 64
ATTN_HEADS = ATTN_HEADS_PER_GROUP * len(ATTN_GROUPS)
ATTN_WIDTH = ATTN_HEADS * ATTN_HEAD_DIM
ATTN_OUT_WIDTH = ATTN_HEADS_PER_GROUP * ATTN_HEAD_DIM
ATTN_BLOCK = 128
ROPE_THETA = 500000.0
ROPE_DIM = ATTN_HEAD_DIM // 4
NEG_BIG = -1e30
N_BRANCHES = 3
IN_WIDTHS = (FNET_WIDTH, HGRN_DK, HGRN_DK, HGRN_DK, HGRN_DV, HGRN_DV,
             ATTN_WIDTH, ATTN_WIDTH, ATTN_WIDTH, N_BRANCHES * D_MODEL)
W_IN = sum(IN_WIDTHS)
PEER_HEADS = 8
PEER_N_KEYS = 128
PEER_N_EXPERTS = PEER_N_KEYS * PEER_N_KEYS
PEER_QUERY_DIM = 256
PEER_HALF = PEER_QUERY_DIM // 2
PEER_TOPK = 16
PEER_TOKEN_BLOCK = 128
DN_ALPHA = (2.0 * DEPTH) ** 0.25
DN_BETA = (8.0 * DEPTH) ** -0.25
LN_EPS = 1e-5

kernel_name = "hybrid_fnet_hgrn2_dilated_peer_encoder"


def layer_norm(x, g, b):
    xf = x.astype(jnp.float32)
    mu = jnp.mean(xf, axis=-1, keepdims=True)
    var = jnp.mean(jnp.square(xf - mu), axis=-1, keepdims=True)
    y = (xf - mu) * lax.rsqrt(var + LN_EPS) * g.astype(jnp.float32) + b.astype(jnp.float32)
    return y.astype(x.dtype)


def split_cols(h, widths):
    out, start = [], 0
    for w in widths:
        out.append(h[..., start:start + w])
        start += w
    return out


def fourier_branch(u):
    B, S, _ = u.shape
    ug = u.reshape(B, S, FNET_GROUPS, FNET_GROUP_DIM).astype(jnp.float32)
    y = jnp.fft.fft2(ug, axes=(1, 3), norm="ortho").real
    return y.reshape(B, S, FNET_WIDTH).astype(u.dtype)


def gla_chunk_scan(q, k, v, logf):
    B, H, S, dk = q.shape
    dv = v.shape[-1]
    C = HGRN_CHUNK
    n = S // C

    def chunks(t):
        return jnp.moveaxis(t.reshape(B, H, n, C, t.shape[-1]), 2, 0)

    lower = jnp.tril(jnp.ones((C, C), dtype=bool))[:, :, None]

    def step(state, inp):
        qc, kc, vc, gc = inp
        b = jnp.cumsum(gc, axis=2)
        o = jnp.einsum('bhtk,bhkv->bhtv', qc * jnp.exp(b), state)
        diff = b[:, :, :, None, :] - b[:, :, None, :, :]
        decay = jnp.where(lower, jnp.exp(jnp.where(lower, diff, 0.0)), 0.0)
        a = jnp.einsum('bhtk,bhsk,bhtsk->bhts', qc, kc, decay)
        o = o + jnp.einsum('bhts,bhsv->bhtv', a, vc)
        b_last = b[:, :, -1:, :]
        state = (jnp.exp(b_last[:, :, 0, :])[..., None] * state
                 + jnp.einsum('bhsk,bhsv->bhkv', kc * jnp.exp(b_last - b), vc))
        return state, o

    s0 = jnp.zeros((B, H, dk, dv), jnp.float32)
    _, o = lax.scan(step, s0, (chunks(q), chunks(k), chunks(v), chunks(logf)))
    return jnp.moveaxis(o, 0, 2).reshape(B, H, S, dv)


def hgrn2_branch(f_fwd_pre, f_bwd_pre, q, i, g, lb_fwd, lb_bwd, norm_g):
    dtype = q.dtype
    B, S, _ = q.shape

    def heads(t, d):
        return t.astype(jnp.float32).reshape(B, S, HGRN_HEADS, d).transpose(0, 2, 1, 3)

    qh = heads(q, HGRN_EXPAND)
    vh = heads(i, HGRN_HEAD_DV)

    def forget(z_pre, lb):
        z = heads(z_pre, HGRN_EXPAND)
        lbh = lb.astype(jnp.float32).reshape(HGRN_HEADS, 1, HGRN_EXPAND)
        log_lb = jnp.log(jnp.maximum(lbh, LB_FLOOR))
        logf = jnp.logaddexp(log_lb, jnp.log1p(-lbh) + jax.nn.log_sigmoid(z))
        key = (1.0 - lbh) * jax.nn.sigmoid(-z)
        return key, logf

    k_f, lf_f = forget(f_fwd_pre, lb_fwd)
    k_b, lf_b = forget(f_bwd_pre, lb_bwd)
    o_f = gla_chunk_scan(qh, k_f, vh, lf_f)
    flip = lambda t: jnp.flip(t, axis=2)
    o_b = flip(gla_chunk_scan(flip(qh), flip(k_b), flip(vh), flip(lf_b)))
    o = o_f + o_b
    o = o * lax.rsqrt(jnp.mean(jnp.square(o), axis=-1, keepdims=True) + HGRN_NORM_EPS)
    o = o.transpose(0, 2, 1, 3).reshape(B, S, HGRN_DV) * norm_g.astype(jnp.float32)
    return (o * jax.nn.silu(g.astype(jnp.float32))).astype(dtype)


def partial_rope(t, cos, sin):
    half = ROPE_DIM // 2
    c = cos[None, :, None, :].astype(t.dtype)
    s = sin[None, :, None, :].astype(t.dtype)
    t1 = t[..., :half]
    t2 = t[..., half:ROPE_DIM]
    return jnp.concatenate([t1 * c - t2 * s, t2 * c + t1 * s, t[..., ROPE_DIM:]], axis=-1)


def band_attend(q, k, v, radius, block):
    N, L, dh = q.shape
    nb = -(-L // block)
    Lp = nb * block
    width = block + 2 * radius
    qp = jnp.pad(q, ((0, 0), (0, Lp - L), (0, 0))).reshape(N, nb, block, dh)
    pad_kv = ((0, 0), (radius, Lp - L + radius), (0, 0))
    kp = jnp.pad(k, pad_kv)
    vp = jnp.pad(v, pad_kv)
    idx = (jnp.arange(nb) * block)[:, None] + jnp.arange(width)[None, :]
    kb = kp[:, idx]
    vb = vp[:, idx]
    s = jnp.einsum('nbqd,nbkd->nbqk', qp, kb).astype(jnp.float32) * (1.0 / math.sqrt(dh))
    qpos = (jnp.arange(nb) * block)[:, None] + jnp.arange(block)[None, :]
    kpos = idx - radius
    rel = kpos[:, None, :] - qpos[:, :, None]
    valid = (jnp.abs(rel) <= radius) & (kpos[:, None, :] >= 0) & (kpos[:, None, :] < L)
    s = jnp.where(valid[None], s, NEG_BIG)
    lse = jax.nn.logsumexp(s, axis=-1)
    p = jnp.exp(s - lse[..., None])
    o = jnp.einsum('nbqk,nbkd->nbqd', p.astype(v.dtype), vb)
    return o.reshape(N, Lp, dh)[:, :L], lse.reshape(N, Lp)[:, :L]


def dilated_attention_branch(q, k, v, cos, sin):
    B, S, _ = q.shape
    G = ATTN_HEADS_PER_GROUP
    dh = ATTN_HEAD_DIM
    qh = partial_rope(q.reshape(B, S, ATTN_HEADS, dh), cos, sin)
    kh = partial_rope(k.reshape(B, S, ATTN_HEADS, dh), cos, sin)
    vh = v.reshape(B, S, ATTN_HEADS, dh)
    outs, lses = [], []
    for gi, (window, dil) in enumerate(ATTN_GROUPS):
        radius = window // (2 * dil)
        L = S // dil

        def to_sub(t):
            t = t[:, :, gi * G:(gi + 1) * G]
            return t.reshape(B, L, dil, G, dh).transpose(0, 2, 3, 1, 4).reshape(B * dil * G, L, dh)

        o, lse = band_attend(to_sub(qh), to_sub(kh), to_sub(vh), radius, min(ATTN_BLOCK, L))
        outs.append(o.reshape(B, dil, G, L, dh).transpose(0, 3, 1, 2, 4).reshape(B, S, G, dh))
        lses.append(lse.reshape(B, dil, G, L).transpose(0, 3, 1, 2).reshape(B, S, G))
    w = jax.nn.softmax(jnp.stack(lses, axis=0), axis=0)
    out = jnp.sum(w[..., None] * jnp.stack(outs, axis=0).astype(jnp.float32), axis=0)
    return out.reshape(B, S, ATTN_OUT_WIDTH).astype(q.dtype)


def hybrid_mixer(x, w_in, w_br_f, w_br_h, w_br_a, w_out, lb_fwd, lb_bwd, hgrn_norm_g, cos, sin):
    B, S, D = x.shape
    h = x @ w_in
    (u_f, f_fwd, f_bwd, q_h, i_h, g_h, q_a, k_a, v_a, gate_pre) = split_cols(h, IN_WIDTHS)
    y_f = fourier_branch(u_f)
    y_h = hgrn2_branch(f_fwd, f_bwd, q_h, i_h, g_h, lb_fwd, lb_bwd, hgrn_norm_g)
    y_a = dilated_attention_branch(q_a, k_a, v_a, cos, sin)
    gates = jax.nn.sigmoid(gate_pre.reshape(B, S, N_BRANCHES, D))
    merged = (gates[:, :, 0] * (y_f @ w_br_f)
              + gates[:, :, 1] * (y_h @ w_br_h)
              + gates[:, :, 2] * (y_a @ w_br_a))
    return merged @ w_out


def peer_ffn(x, w_query, sub_keys, u, v):
    B, S, D = x.shape
    T = B * S
    xt = x.reshape(T, D)
    qh = (xt @ w_query).reshape(T, PEER_HEADS, 2, PEER_HALF)
    s = jnp.einsum('thpd,pkd->thpk', qh, sub_keys).astype(jnp.float32)
    top_s, top_i = lax.top_k(s, PEER_TOPK)
    cand = top_s[:, :, 0, :, None] + top_s[:, :, 1, None, :]
    best_s, best_c = lax.top_k(cand.reshape(T, PEER_HEADS, PEER_TOPK * PEER_TOPK), PEER_TOPK)
    i1 = jnp.take_along_axis(top_i[:, :, 0], best_c // PEER_TOPK, axis=-1)
    i2 = jnp.take_along_axis(top_i[:, :, 1], best_c % PEER_TOPK, axis=-1)
    experts = (i1 * PEER_N_KEYS + i2).reshape(T, PEER_HEADS * PEER_TOPK)
    gate = jax.nn.softmax(best_s, axis=-1).reshape(T, PEER_HEADS * PEER_TOPK).astype(x.dtype)
    nblk = T // PEER_TOKEN_BLOCK

    def token_block(args):
        xb, eb, gb = args
        hidden = jax.nn.gelu(jnp.einsum('td,tkd->tk', xb, jnp.take(u, eb, axis=0)), approximate=False)
        return jnp.einsum('tk,tkd->td', gb * hidden, jnp.take(v, eb, axis=0))

    y = lax.map(token_block, (xt.reshape(nblk, PEER_TOKEN_BLOCK, D),
                              experts.reshape(nblk, PEER_TOKEN_BLOCK, -1),
                              gate.reshape(nblk, PEER_TOKEN_BLOCK, -1)))
    return y.reshape(B, S, D)


def setup_inputs(seed: int = 0) -> dict:
    key = jax.random.key(seed)
    ks = jax.random.split(key, 18)
    f32 = jnp.float32

    def nrm(k, shape, scale):
        return jax.random.normal(k, shape, f32) * scale

    D = D_MODEL
    return {
        "x": nrm(ks[0], (BATCH, SEQ, D), 1.0),
        "emb_ln_g": 1.0 + nrm(ks[1], (D,), 0.02),
        "emb_ln_b": nrm(ks[2], (D,), 0.02),
        "w_in": nrm(ks[3], (DEPTH, D, W_IN), D ** -0.5),
        "w_br_fourier": nrm(ks[4], (DEPTH, FNET_WIDTH, D), DN_BETA * FNET_WIDTH ** -0.5),
        "w_br_hgrn": nrm(ks[5], (DEPTH, HGRN_DV, D), DN_BETA * HGRN_DV ** -0.5),
        "w_br_attn": nrm(ks[6], (DEPTH, ATTN_OUT_WIDTH, D), DN_BETA * ATTN_OUT_WIDTH ** -0.5),
        "w_out": nrm(ks[7], (DEPTH, D, D), DN_BETA * D ** -0.5),
        "hgrn_lb_logits": nrm(ks[8], (2, DEPTH, HGRN_DK), 0.5),
        "hgrn_norm_g": 1.0 + nrm(ks[9], (DEPTH, HGRN_DV), 0.02),
        "ln_mix_g": 1.0 + nrm(ks[10], (DEPTH, D), 0.02),
        "ln_mix_b": nrm(ks[11], (DEPTH, D), 0.02),
        "peer_w_query": nrm(ks[12], (DEPTH, D, PEER_HEADS * PEER_QUERY_DIM), D ** -0.5),
        "peer_sub_keys": nrm(ks[13], (DEPTH, 2, PEER_N_KEYS, PEER_HALF), PEER_HALF ** -0.5),
        "peer_u": nrm(ks[14], (DEPTH, PEER_N_EXPERTS, D), D ** -0.5),
        "peer_v": nrm(ks[15], (DEPTH, PEER_N_EXPERTS, D), DN_BETA),
        "ln_ffn_g": 1.0 + nrm(ks[16], (DEPTH, D), 0.02),
        "ln_ffn_b": nrm(ks[17], (DEPTH, D), 0.02),
    }


def reference(x, emb_ln_g, emb_ln_b, w_in, w_br_fourier, w_br_hgrn, w_br_attn, w_out,
              hgrn_lb_logits, hgrn_norm_g, ln_mix_g, ln_mix_b, peer_w_query, peer_sub_keys,
              peer_u, peer_v, ln_ffn_g, ln_ffn_b):
    S = x.shape[1]
    pos = jnp.arange(S, dtype=jnp.float32)
    inv_freq = ROPE_THETA ** (-jnp.arange(0, ROPE_DIM, 2, dtype=jnp.float32) / ROPE_DIM)
    ang = pos[:, None] * inv_freq[None, :]
    cos, sin = jnp.cos(ang), jnp.sin(ang)
    lb_p = jax.nn.softmax(hgrn_lb_logits.astype(jnp.float32), axis=1)
    lb = jnp.cumsum(lb_p, axis=1) - lb_p[:, :1]
    x = layer_norm(x, emb_ln_g, emb_ln_b)
    for l in range(DEPTH):
        mix = hybrid_mixer(x, w_in[l], w_br_fourier[l], w_br_hgrn[l], w_br_attn[l], w_out[l],
                           lb[0, l], lb[1, l], hgrn_norm_g[l], cos, sin)
        x = layer_norm(DN_ALPHA * x + mix, ln_mix_g[l], ln_mix_b[l])
        ffn = peer_ffn(x, peer_w_query[l], peer_sub_keys[l], peer_u[l], peer_v[l])
        x = layer_norm(DN_ALPHA * x + ffn, ln_ffn_g[l], ln_ffn_b[l])
    return x
```

```cpp
#include <hip/hip_runtime.h>
#include <hip/hip_cooperative_groups.h>
#include <cstdio>
#include <cstdint>
namespace cg = cooperative_groups;
namespace pg8 {
#define PG8_LAS __attribute__((address_space(3)))
typedef unsigned short bf16_t;
typedef short bf16x8 __attribute__((ext_vector_type(8)));
typedef float f32x4 __attribute__((ext_vector_type(4)));
typedef unsigned u32x4 __attribute__((ext_vector_type(4)));
constexpr int BM = 256, BK = 64, HALF = 128, HTB = HALF * BK * 2  , STAGE_BYTES = 8 * HTB, NXCD = 8, WGM = 8;

__host__ __device__ __forceinline__ int lds_byte(int r, int c) { const int st = (r >> 4) * 2 + (c >> 5), rr = r & 15, cc = c & 31, ob = rr * 64 + cc * 2; return st * 1024 + (ob ^ (((ob >> 9) & 1) << 5)); }
__host__ __device__ __forceinline__ void stage_rc(int b, int& R, int& C) { const int st = b / 1024, sb = b % 1024, swz = sb ^ (((sb >> 9) & 1) << 5); R = (st >> 1) * 16 + swz / 64; C = (st & 1) * 32 + (swz % 64) / 2; }
__host__ __device__ __forceinline__ int perm32(int rho) { const int n = rho >> 4, i = rho & 15; return 8 * (i >> 2) + 4 * n + (i & 3); }

struct Unit { int pm, pn; };
struct Gemm { const bf16_t* A; const bf16_t* Bt; int M, N, K, lda, ldb; };

struct StaticOrder {
    int nM, nN, nwg, G, c;
    __host__ __device__ void init(int M, int N, int G_, int c_) { nM = M / BM; nN = N / BM; nwg = nM * nN; G = G_; c = c_; }
    __host__ __device__ bool next(int i, Unit& u) const {
        const long L = (long)i * G + c; if (L >= nwg) return false;
        int wgid = (int)L; { const int q = nwg / NXCD, r = nwg % NXCD, xcd = wgid % NXCD, off = wgid / NXCD; wgid = (xcd < r ? xcd * (q + 1) : r * (q + 1) + (xcd - r) * q) + off; }
        const int nig = WGM * nN, gid = wgid / nig, fm = gid * WGM, gsz = (nM - fm) < WGM ? (nM - fm) : WGM;
        u.pm = fm + ((wgid % nig) % gsz); u.pn = (wgid % nig) / gsz; return true;
    }
    __device__ __forceinline__ void a_ready(const Unit&) const {}
    __device__ __forceinline__ void done(const Unit&) const {}
};

__device__ __forceinline__ unsigned cvt_pk_bf16(float lo, float hi) { unsigned r; asm volatile("v_cvt_pk_bf16_f32 %0, %1, %2" : "=v"(r) : "v"(lo), "v"(hi)); return r; }
typedef float f32x2 __attribute__((ext_vector_type(2)));
__device__ __forceinline__ f32x2 gelu_pk(f32x2 v) {
    const f32x2 av = __builtin_elementwise_abs(v), d = av * 0.2316418882f + 1.0f;
    f32x2 t; t.x = __builtin_amdgcn_rcpf(d.x); t.y = __builtin_amdgcn_rcpf(d.y);
    f32x2 q = t * 0.5307027145f + (-0.7265760135f); q = q * t + 0.7107068705f; q = q * t + (-0.142248368f); q = q * t + 0.127414796f; q = q * t;
    const f32x2 s = (v * v) * (-0.72134752044f);
    f32x2 e; e.x = __builtin_amdgcn_exp2f(s.x); e.y = __builtin_amdgcn_exp2f(s.y);
    const f32x2 m = v * (q * e), r = v - m;
    f32x2 o; o.x = v.x < 0.f ? m.x : r.x; o.y = v.y < 0.f ? m.y : r.y; return o;
}

template <int ACT  > struct EpiBf16 {
    static constexpr bool PERM = true, AFTER_DRAIN = false; static_assert(ACT == 0 || ACT == 1, "EpiBf16: ACT is 0 (none) or 1 (gelu_pk)");
    bf16_t* O; int ldc; const float* bias; int split_cols; size_t split_stride; float scale0;
    __device__ __forceinline__ void operator()(const f32x4 (&acc)[2][2][4][2], const Unit& u, int wr, int wc, int fr, int fq) const {
        const int row0 = u.pm * BM + wr * 64 + fr; int colt = u.pn * BM; bf16_t* base = O;
        float sc = 1.f; if (split_cols) { const int t = colt / split_cols; base += (size_t)t * split_stride; colt -= t * split_cols; if (t == 0) sc = scale0; }
        const int col0 = colt + wc * 32 + 8 * fq, bcol0 = u.pn * BM + wc * 32 + 8 * fq;
        f32x4 bv[2][2];
#pragma unroll
        for (int bj = 0; bj < 2; ++bj)
#pragma unroll
            for (int n = 0; n < 2; ++n) bv[bj][n] = bias ? *(const f32x4*)(bias + bcol0 + bj * HALF + 4 * n) : (f32x4){0.f, 0.f, 0.f, 0.f};
#pragma unroll
        for (int ai = 0; ai < 2; ++ai)
#pragma unroll
            for (int m = 0; m < 4; ++m) { bf16_t* rowp = base + (size_t)(row0 + ai * HALF + m * 16) * ldc + col0;
#pragma unroll
                for (int bj = 0; bj < 2; ++bj) { f32x4 v0 = acc[ai][bj][m][0] + bv[bj][0], v1 = acc[ai][bj][m][1] + bv[bj][1];
                    if (ACT == 1) { f32x2 a = gelu_pk((f32x2){v0[0], v0[1]}), b = gelu_pk((f32x2){v0[2], v0[3]}), c = gelu_pk((f32x2){v1[0], v1[1]}), d = gelu_pk((f32x2){v1[2], v1[3]});
                        v0 = (f32x4){a.x, a.y, b.x, b.y}; v1 = (f32x4){c.x, c.y, d.x, d.y}; }
                    v0 = v0 * sc; v1 = v1 * sc; u32x4 w; w.x = cvt_pk_bf16(v0[0], v0[1]); w.y = cvt_pk_bf16(v0[2], v0[3]); w.z = cvt_pk_bf16(v1[0], v1[1]); w.w = cvt_pk_bf16(v1[2], v1[3]);
                    *(u32x4*)(rowp + bj * HALF) = w; } }
    }
};
#ifndef EXP_MIX_SCALE
#define EXP_MIX_SCALE 1.0f
#endif

struct EpiF32 {
    static constexpr bool PERM = false, AFTER_DRAIN = false;
    float* C; int ldc;
    __device__ __forceinline__ void operator()(const f32x4 (&acc)[2][2][4][2], const Unit& u, int wr, int wc, int fr, int fq) const {
        const int row0 = u.pm * BM + wr * 64 + fr, col0 = u.pn * BM + wc * 32 + 4 * fq;
        float* rowp = C + (size_t)row0 * ldc + col0;
#pragma unroll
        for (int ai = 0; ai < 2; ++ai) {
#pragma unroll
            for (int m = 0; m < 4; ++m) {
#pragma unroll
                for (int bj = 0; bj < 2; ++bj)
#pragma unroll
                    for (int n = 0; n < 2; ++n) *(f32x4*)(rowp + bj * HALF + n * 16) = acc[ai][bj][m][n];
                rowp += (size_t)16 * ldc; asm volatile("" : "+v"(rowp) :: "memory"); }
            rowp += (size_t)64 * ldc; }
    }
};
struct EpiPT {
    static constexpr bool PERM = true, AFTER_DRAIN = false;
    bf16_t* PT;
    __device__ __forceinline__ void operator()(const f32x4 (&acc)[2][2][4][2], const Unit& u, int wr, int wc, int fr, int fq) const {
        const int m0 = u.pm * BM, part = m0 >> 9, j0 = m0 & 511, n0 = u.pn * BM, b = n0 >> 12, n10 = n0 & 4095;
        bf16_t* base = PT + (size_t)(b * 512 + j0) * 8192 + part * 4096 + n10;
        const int row0 = wr * 64 + fr, col0 = wc * 32 + 8 * fq;
        bf16_t* rowp = base + (size_t)row0 * 8192 + col0;
#pragma unroll
        for (int ai = 0; ai < 2; ++ai) {
#pragma unroll
            for (int m = 0; m < 4; ++m) {
#pragma unroll
                for (int bj = 0; bj < 2; ++bj) { const f32x4 v0 = acc[ai][bj][m][0], v1 = acc[ai][bj][m][1];
                    u32x4 w; w.x = cvt_pk_bf16(v0[0], v0[1]); w.y = cvt_pk_bf16(v0[2], v0[3]); w.z = cvt_pk_bf16(v1[0], v1[1]); w.w = cvt_pk_bf16(v1[2], v1[3]);
                    *(u32x4*)(rowp + bj * HALF) = w; }
                rowp += 16 * 8192; asm volatile("" : "+v"(rowp) :: "memory"); }
            rowp += 64 * 8192; }
    }
};
typedef unsigned u32x2 __attribute__((ext_vector_type(2)));
template <int MODE> struct EpiGate {
    static constexpr bool PERM = false, AFTER_DRAIN = false;
    const bf16_t* gate; int ldg; float* accbuf; bf16_t* out; int ldc;
    __device__ __forceinline__ void operator()(const f32x4 (&acc)[2][2][4][2], const Unit& u, int wr, int wc, int fr, int fq) const {
        const int row0 = u.pm * BM + wr * 64 + fr, col0 = u.pn * BM + wc * 32 + 4 * fq;
        const bf16_t* gp = gate + (size_t)row0 * ldg + col0; float* ab = accbuf + (size_t)row0 * ldc + col0; bf16_t* op = out + (size_t)row0 * ldc + col0;
#pragma unroll
        for (int ai = 0; ai < 2; ++ai) {
#pragma unroll
            for (int m = 0; m < 4; ++m) {
#pragma unroll
                for (int bj = 0; bj < 2; ++bj)
#pragma unroll
                    for (int n = 0; n < 2; ++n) { const int c = bj * HALF + n * 16;
                        const u32x2 gw = *(const u32x2*)(gp + c);
                        f32x4 gt; gt[0] = __uint_as_float(gw.x << 16); gt[1] = __uint_as_float(gw.x & 0xffff0000u); gt[2] = __uint_as_float(gw.y << 16); gt[3] = __uint_as_float(gw.y & 0xffff0000u);
                        f32x4 v;
#pragma unroll
                        for (int e = 0; e < 4; ++e) v[e] = acc[ai][bj][m][n][e] * __builtin_amdgcn_rcpf(1.0f + __expf(-gt[e]));
                        if (MODE == 0) *(f32x4*)(ab + c) = v;
                        else if (MODE == 1) *(f32x4*)(ab + c) = *(const f32x4*)(ab + c) + v;
                        else { const f32x4 o = *(const f32x4*)(ab + c) + v; u32x2 w; w.x = cvt_pk_bf16(o[0], o[1]); w.y = cvt_pk_bf16(o[2], o[3]); *(u32x2*)(op + c) = w; } }
                gp += (size_t)16 * ldg; ab += (size_t)16 * ldc; op += (size_t)16 * ldc; asm volatile("" : "+v"(gp), "+v"(ab), "+v"(op) :: "memory"); }
            gp += (size_t)64 * ldg; ab += (size_t)64 * ldc; op += (size_t)64 * ldc; }
    }
};
struct EpiResid {
    static constexpr bool PERM = false, AFTER_DRAIN = false;
    const float* base; float* C; int ldc; float alpha;
    __device__ __forceinline__ void operator()(const f32x4 (&acc)[2][2][4][2], const Unit& u, int wr, int wc, int fr, int fq) const {
        const int row0 = u.pm * BM + wr * 64 + fr, col0 = u.pn * BM + wc * 32 + 4 * fq;
        const float* bp = base + (size_t)row0 * ldc + col0; float* cp = C + (size_t)row0 * ldc + col0;
#pragma unroll
        for (int ai = 0; ai < 2; ++ai) {
#pragma unroll
            for (int m = 0; m < 4; ++m) {
#pragma unroll
                for (int bj = 0; bj < 2; ++bj)
#pragma unroll
                    for (int n = 0; n < 2; ++n) { const f32x4 bs = *(const f32x4*)(bp + bj * HALF + n * 16); *(f32x4*)(cp + bj * HALF + n * 16) = bs * alpha + acc[ai][bj][m][n] * EXP_MIX_SCALE; }
                bp += (size_t)16 * ldc; cp += (size_t)16 * ldc; asm volatile("" : "+v"(bp), "+v"(cp) :: "memory"); }
            bp += (size_t)64 * ldc; cp += (size_t)64 * ldc; }
    }
};
struct OneUnit {
    int pm, pn;
    __device__ __forceinline__ bool next(int i, Unit& u) const { if (i > 0) return false; u.pm = pm; u.pn = pn; return true; }
    __device__ __forceinline__ void a_ready(const Unit&) const {}
    __device__ __forceinline__ void done(const Unit&) const {}
};
template <class Epi, class Sched, bool ALIGN_EPI = false, bool SP2 = false>
__device__ __forceinline__ void gemm_phase(PG8_LAS unsigned char* lds, const Gemm g, const Sched& S, const Epi& E) {
    int tid_ = threadIdx.x; asm volatile("" : "+v"(tid_));
    const int tid = tid_, wid = __builtin_amdgcn_readfirstlane(tid >> 6), lane = tid & 63, wr = wid >> 2, wc = wid & 3, fr = lane & 15, fq = lane >> 4;
    int K_ = g.K; asm volatile("" : "+s"(K_));
    const int K = K_, nt = K / BK;
    unsigned voffA[2], voffB[2];
#pragma unroll
    for (int i = 0; i < 2; ++i) { int R, C; stage_rc(tid * 16 + i * 8192, R, C); const int Rb = Epi::PERM ? ((R & ~31) + perm32(R & 31)) : R;
        voffA[i] = (unsigned)(R * g.lda + C) * 2u; voffB[i] = (unsigned)(Rb * g.ldb + C) * 2u; }
    const size_t kstep = (size_t)(BK * 2);
    const size_t hstepA = (size_t)HALF * g.lda * 2, hstepB = (size_t)HALF * g.ldb * 2;
    const size_t tstepA = 2 * hstepA, tstepB = 2 * hstepB;
    const unsigned ldsw = (unsigned)wid * 1024u;
    const int aoff = lds_byte(wr * 64 + fr, fq * 8), boff = lds_byte(wc * 32 + fr, fq * 8);
#define PG8_SA(b, h) (((b) * 2 + (h)) * HTB)
#define PG8_SB(b, h) ((4 + (b) * 2 + (h)) * HTB)
#define PG8_STAGE(bufoff, gbase, voff) do { _Pragma("unroll") for (int _i = 0; _i < 2; ++_i) \
        __builtin_amdgcn_global_load_lds((const unsigned*)((const char*)(gbase) + (voff)[_i]), (PG8_LAS unsigned*)(lds + (bufoff) + ldsw + _i * 8192), 16, 0, 0); } while (0)
#define PG8_LDA(dst, b, h) do { _Pragma("unroll") for (int m = 0; m < 4; ++m) _Pragma("unroll") for (int k = 0; k < 2; ++k) dst[m][k] = *(const PG8_LAS bf16x8*)(lds + PG8_SA(b, h) + aoff + m * 2048 + k * 1024); } while (0)
#define PG8_LDB(dst, b, h) do { _Pragma("unroll") for (int n = 0; n < 2; ++n) _Pragma("unroll") for (int k = 0; k < 2; ++k) dst[n][k] = *(const PG8_LAS bf16x8*)(lds + PG8_SB(b, h) + boff + n * 2048 + k * 1024); } while (0)
#define PG8_MMA(ai, bj, At, Bt) do { __builtin_amdgcn_s_setprio(1); _Pragma("unroll") for (int m = 0; m < 4; ++m) _Pragma("unroll") for (int n = 0; n < 2; ++n) _Pragma("unroll") for (int k = 0; k < 2; ++k) \
        acc[ai][bj][m][n] = __builtin_amdgcn_mfma_f32_16x16x32_bf16(Bt[n][k], At[m][k], acc[ai][bj][m][n], 0, 0, 0); __builtin_amdgcn_s_setprio(0); } while (0)
#define PG8_WAIT_V(n) asm volatile("s_waitcnt vmcnt(" #n ")" ::: "memory")
#define PG8_WAIT_L(n) asm volatile("s_waitcnt lgkmcnt(" #n ")" ::: "memory")
#define PG8_BAR __builtin_amdgcn_s_barrier()
#define PG8_SCHED __builtin_amdgcn_sched_barrier(0)
    Unit cur, nxt; int ui = 0;
    if (!S.next(0, cur)) return;
    f32x4 acc[2][2][4][2];
#pragma unroll
    for (int a = 0; a < 2; ++a)
#pragma unroll
        for (int b = 0; b < 2; ++b)
#pragma unroll
            for (int m = 0; m < 4; ++m)
#pragma unroll
                for (int n = 0; n < 2; ++n) acc[a][b][m][n] = (f32x4){0.f, 0.f, 0.f, 0.f};
    bf16x8 At[4][2], B0[2][2], B1[2][2];
    const char* cA = (const char*)g.A + (size_t)cur.pm * tstepA; const char* cB = (const char*)g.Bt + (size_t)cur.pn * tstepB;
    S.a_ready(cur);
    if constexpr (SP2) {
        PG8_STAGE(PG8_SB(0, 0), cB, voffB); PG8_STAGE(PG8_SB(0, 1), cB + hstepB, voffB); PG8_STAGE(PG8_SA(0, 0), cA, voffA); PG8_STAGE(PG8_SA(0, 1), cA + hstepA, voffA);
        if (wr == 1) PG8_BAR;
        PG8_WAIT_V(2); PG8_BAR;
        PG8_STAGE(PG8_SB(1, 0), cB + kstep, voffB); PG8_STAGE(PG8_SA(1, 0), cA + kstep, voffA); PG8_STAGE(PG8_SB(1, 1), cB + hstepB + kstep, voffB);
        PG8_WAIT_V(6); PG8_BAR;
    } else {
        PG8_STAGE(PG8_SB(0, 0), cB, voffB); PG8_STAGE(PG8_SA(0, 0), cA, voffA); PG8_STAGE(PG8_SB(0, 1), cB + hstepB, voffB); PG8_STAGE(PG8_SA(0, 1), cA + hstepA, voffA);
        if (wr == 1) PG8_BAR;
        PG8_WAIT_V(4); PG8_BAR;
        PG8_STAGE(PG8_SB(1, 0), cB + kstep, voffB); PG8_STAGE(PG8_SA(1, 0), cA + kstep, voffA); PG8_STAGE(PG8_SB(1, 1), cB + hstepB + kstep, voffB);
        PG8_WAIT_V(6); PG8_BAR;
    }
    for (;;) {
        const bool has_next = S.next(ui + 1, nxt);
        const char* nA = has_next ? (const char*)g.A + (size_t)nxt.pm * tstepA : cA; const char* nB = has_next ? (const char*)g.Bt + (size_t)nxt.pn * tstepB : cB;
        for (int t = 0; t < nt; t += 2) {
            const bool last = (t == nt - 2);
            const char* a1 = cA + (size_t)(t + 1) * kstep;
            const char* a2 = last ? nA : cA + (size_t)(t + 2) * kstep; const char* b2 = last ? nB : cB + (size_t)(t + 2) * kstep;
            const char* a3 = a2 + kstep; const char* b3 = b2 + kstep;
            if (last && has_next) S.a_ready(nxt);
            if constexpr (SP2) {
            PG8_LDB(B0, 0, 0); PG8_LDB(B1, 0, 1); PG8_SCHED; PG8_LDA(At, 0, 0); PG8_STAGE(PG8_SA(1, 1), a1 + hstepA, voffA);
            PG8_WAIT_V(8); PG8_WAIT_L(0); PG8_BAR; PG8_MMA(0, 0, At, B0); PG8_MMA(0, 1, At, B1); PG8_BAR; PG8_SCHED;
            PG8_LDA(At, 0, 1); PG8_STAGE(PG8_SB(0, 0), b2, voffB); PG8_STAGE(PG8_SB(0, 1), b2 + hstepB, voffB); PG8_STAGE(PG8_SA(0, 0), a2, voffA);
            PG8_WAIT_V(8); PG8_WAIT_L(0); PG8_BAR; PG8_MMA(1, 0, At, B0); PG8_MMA(1, 1, At, B1); PG8_BAR; PG8_SCHED;
            PG8_LDB(B0, 1, 0); PG8_LDB(B1, 1, 1); PG8_SCHED; PG8_LDA(At, 1, 0); PG8_STAGE(PG8_SA(0, 1), a2 + hstepA, voffA);
            PG8_WAIT_V(8); PG8_WAIT_L(0); PG8_BAR; PG8_MMA(0, 0, At, B0); PG8_MMA(0, 1, At, B1); PG8_BAR; PG8_SCHED;
            PG8_LDA(At, 1, 1); PG8_STAGE(PG8_SB(1, 0), b3, voffB); PG8_STAGE(PG8_SB(1, 1), b3 + hstepB, voffB); PG8_STAGE(PG8_SA(1, 0), a3, voffA);
            PG8_WAIT_V(8); PG8_WAIT_L(0); PG8_BAR; PG8_MMA(1, 0, At, B0); PG8_MMA(1, 1, At, B1); PG8_BAR; PG8_SCHED;
            } else {
            PG8_LDB(B0, 0, 0); PG8_SCHED; PG8_LDA(At, 0, 0); PG8_STAGE(PG8_SA(1, 1), a1 + hstepA, voffA);
            PG8_WAIT_L(8); PG8_BAR; PG8_WAIT_L(0); PG8_MMA(0, 0, At, B0); PG8_BAR; PG8_SCHED;
            PG8_LDB(B1, 0, 1); PG8_STAGE(PG8_SB(0, 0), b2, voffB);
            PG8_BAR; PG8_WAIT_L(0); PG8_MMA(0, 1, At, B1); PG8_BAR;
            PG8_LDA(At, 0, 1); PG8_STAGE(PG8_SA(0, 0), a2, voffA);
            PG8_BAR; PG8_WAIT_L(0); PG8_MMA(1, 0, At, B0); PG8_BAR; PG8_SCHED;
            PG8_STAGE(PG8_SB(0, 1), b2 + hstepB, voffB);
            PG8_WAIT_V(6); PG8_BAR; PG8_MMA(1, 1, At, B1); PG8_BAR;
            PG8_LDB(B0, 1, 0); PG8_SCHED; PG8_LDA(At, 1, 0); PG8_STAGE(PG8_SA(0, 1), a2 + hstepA, voffA);
            PG8_WAIT_L(8); PG8_BAR; PG8_WAIT_L(0); PG8_MMA(0, 0, At, B0); PG8_BAR; PG8_SCHED;
            PG8_LDB(B1, 1, 1); PG8_STAGE(PG8_SB(1, 0), b3, voffB);
            PG8_BAR; PG8_WAIT_L(0); PG8_MMA(0, 1, At, B1); PG8_BAR;
            PG8_LDA(At, 1, 1); PG8_STAGE(PG8_SA(1, 0), a3, voffA);
            PG8_BAR; PG8_WAIT_L(0); PG8_MMA(1, 0, At, B0); PG8_BAR; PG8_SCHED;
            PG8_STAGE(PG8_SB(1, 1), b3 + hstepB, voffB);
            PG8_WAIT_V(6); PG8_BAR; PG8_MMA(1, 1, At, B1); PG8_BAR;
            }
        }
        if constexpr (ALIGN_EPI) { if (wr == 0) PG8_BAR; }
        if constexpr (!Epi::AFTER_DRAIN) { E(acc, cur, wr, wc, fr, fq); S.done(cur); }
        if (!has_next) break;
#pragma unroll
        for (int a = 0; a < 2; ++a)
#pragma unroll
            for (int b = 0; b < 2; ++b)
#pragma unroll
                for (int m = 0; m < 4; ++m)
#pragma unroll
                    for (int n = 0; n < 2; ++n) acc[a][b][m][n] = (f32x4){0.f, 0.f, 0.f, 0.f};
        cur = nxt; cA = nA; cB = nB; ++ui;
        if constexpr (ALIGN_EPI) { if (wr == 1) PG8_BAR; }
    }
    PG8_WAIT_V(0);
    if constexpr (!ALIGN_EPI) { if (wr == 0) PG8_BAR; }
    PG8_BAR;
    if constexpr (Epi::AFTER_DRAIN) { E.fused(acc, cur, wr, wc, fr, fq, lds, wid, lane); S.done(cur); }
#undef PG8_SA
#undef PG8_SB
#undef PG8_STAGE
#undef PG8_LDA
#undef PG8_LDB
#undef PG8_MMA
#undef PG8_WAIT_V
#undef PG8_WAIT_L
#undef PG8_BAR
#undef PG8_SCHED
}
}

#define LAS __attribute__((address_space(3)))
typedef unsigned short bf16;
typedef float f32x4 __attribute__((ext_vector_type(4)));
typedef float f32x2 __attribute__((ext_vector_type(2)));
typedef unsigned u32x4 __attribute__((ext_vector_type(4)));
typedef unsigned u32x2 __attribute__((ext_vector_type(2)));
typedef __bf16 bf16x2_t __attribute__((ext_vector_type(2)));

constexpr int NWAVES = 8, NTHR = 512;
constexpr int BATCH = 2, SEQ = 4096, DM = 2048, TOK = BATCH * SEQ, DEPTH = 2;
constexpr int W_IN = 12800, HW = 12288;
constexpr int H_FF = 0, H_FB = 768, H_Q = 1536, H_I = 2304, H_G = 3072, H_QA = 3840, H_KA = 4608, H_VA = 5376, H_GATE = 6144;
constexpr int NEXP = 16384;
constexpr float DN_ALPHA = 1.41421356237309515f;
constexpr float LN_EPS = 1e-5f;
constexpr int LDS_BYTES = 147456;

constexpr size_t MiB = 1u << 20;
constexpr size_t WS_WL0 = 1 * MiB, WL_STRIDE = 202 * MiB;
constexpr size_t WL_WIN = 0, WL_WF = 48 * MiB, WL_BRF = 52 * MiB, WL_BRH = 54 * MiB, WL_BRA = 57 * MiB, WL_OUT = 58 * MiB, WL_WS = 66 * MiB, WL_U = 74 * MiB, WL_V = 138 * MiB;
constexpr size_t WS_F = 405 * MiB;
constexpr size_t WS_H = 469 * MiB;
constexpr size_t WS_PT = 661 * MiB;
constexpr size_t WS_FP = 677 * MiB;
constexpr size_t WS_LB = 741 * MiB;
constexpr size_t WS_SB = 837 * MiB;
constexpr size_t WS_YF = 885 * MiB, WS_YH = 893 * MiB, WS_YA = 905 * MiB;
constexpr size_t WS_XA = 909 * MiB;
constexpr size_t WS_TAB = 941 * MiB;
constexpr size_t WS_END = 944 * MiB;
constexpr size_t WS_VPRE = WS_H, WS_SC = WS_H + 64 * MiB, WS_MACC = WS_FP, WS_MERGED = WS_LB;
constexpr size_t TAB_SIN = 128 * 1024, TAB_LB = 256 * 1024;

struct Ctx { unsigned char* lds; int tid, lane, wave, G, c, gw, ngw; };

__device__ __forceinline__ unsigned f2bf(float f) { unsigned u = __float_as_uint(f); return (u + 0x7fffu + ((u >> 16) & 1u)) >> 16; }
__device__ __forceinline__ unsigned pk2(float lo, float hi) { return f2bf(lo) | (f2bf(hi) << 16); }
__device__ __forceinline__ float bf2f(unsigned short b) { return __uint_as_float((unsigned)b << 16); }
__device__ __forceinline__ float bflo(unsigned w) { return __uint_as_float(w << 16); }
__device__ __forceinline__ float bfhi(unsigned w) { return __uint_as_float(w & 0xffff0000u); }
#define LDS_WAIT() asm volatile("s_waitcnt lgkmcnt(0)" ::: "memory")

template <int CTRL> __device__ __forceinline__ float dpp_f(float v) { return __int_as_float(__builtin_amdgcn_update_dpp(0, __float_as_int(v), CTRL, 0xF, 0xF, true)); }
__device__ __forceinline__ float rdlane(float v, int l) { return __int_as_float(__builtin_amdgcn_readlane(__float_as_int(v), l)); }
__device__ __forceinline__ float wave_max(float v) {
    v = fmaxf(v, dpp_f<0xB1>(v)); v = fmaxf(v, dpp_f<0x4E>(v)); v = fmaxf(v, dpp_f<0x141>(v)); v = fmaxf(v, dpp_f<0x140>(v));
    return fmaxf(fmaxf(rdlane(v, 0), rdlane(v, 16)), fmaxf(rdlane(v, 32), rdlane(v, 48)));
}
__device__ __forceinline__ float wave_sum(float v) {
    v += dpp_f<0xB1>(v); v += dpp_f<0x4E>(v); v += dpp_f<0x141>(v); v += dpp_f<0x140>(v);
    return (rdlane(v, 0) + rdlane(v, 16)) + (rdlane(v, 32) + rdlane(v, 48));
}

__device__ __forceinline__ void transpose_item(const float* W, int ldw, int K, int N, bf16* WT, LAS float* scr, int item, int lane) {
    const int nblk = N / 32, kb = item / nblk, nb = item % nblk, k0 = 64 * kb, n0 = 32 * nb;
#pragma unroll 8
    for (int i = 0; i < 32; ++i) { const int kk = 2 * i + (lane >> 5); scr[kk * 33 + (lane & 31)] = W[(size_t)(k0 + kk) * ldw + n0 + (lane & 31)]; }
    LDS_WAIT(); asm volatile("" ::: "memory");
    const int c = lane & 7;
#pragma unroll
    for (int j = 0; j < 4; ++j) { const int n = (lane >> 3) + 8 * j; const LAS float* s = scr + (8 * c) * 33 + n;
        u32x4 o; o.x = pk2(s[0 * 33], s[1 * 33]); o.y = pk2(s[2 * 33], s[3 * 33]); o.z = pk2(s[4 * 33], s[5 * 33]); o.w = pk2(s[6 * 33], s[7 * 33]);
        *(u32x4*)(WT + (size_t)(n0 + n) * K + k0 + 8 * c) = o; }
    LDS_WAIT(); asm volatile("" ::: "memory");
}
__device__ __forceinline__ void ln_row(const float (&v)[32], int lane, const float* g, const float* b, float* of, bf16* ob) {
    float s = 0.f;
#pragma unroll
    for (int i = 0; i < 32; ++i) s += v[i];
    const float mean = wave_sum(s) * (1.f / DM);
    float s2 = 0.f;
#pragma unroll
    for (int i = 0; i < 32; ++i) { const float d = v[i] - mean; s2 += d * d; }
    const float rstd = 1.0f / sqrtf(wave_sum(s2) * (1.f / DM) + LN_EPS);
#pragma unroll
    for (int c = 0; c < 4; ++c) { const int e0 = c * 512 + lane * 8;
        const f32x4 g0 = *(const f32x4*)(g + e0), g1 = *(const f32x4*)(g + e0 + 4), b0 = *(const f32x4*)(b + e0), b1 = *(const f32x4*)(b + e0 + 4);
        f32x4 o0, o1;
#pragma unroll
        for (int e = 0; e < 4; ++e) { o0[e] = (v[c * 8 + e] - mean) * rstd * g0[e] + b0[e]; o1[e] = (v[c * 8 + 4 + e] - mean) * rstd * g1[e] + b1[e]; }
        *(f32x4*)(of + e0) = o0; *(f32x4*)(of + e0 + 4) = o1;
        u32x4 w; w.x = pk2(o0[0], o0[1]); w.y = pk2(o0[2], o0[3]); w.z = pk2(o1[0], o1[1]); w.w = pk2(o1[2], o1[3]);
        *(u32x4*)(ob + e0) = w; }
}
__device__ __forceinline__ void load_row32(const float* src, int lane, float (&v)[32]) {
#pragma unroll
    for (int c = 0; c < 4; ++c) { const f32x4 a = *(const f32x4*)(src + c * 512 + lane * 8), b = *(const f32x4*)(src + c * 512 + lane * 8 + 4);
#pragma unroll
        for (int e = 0; e < 4; ++e) { v[c * 8 + e] = a[e]; v[c * 8 + 4 + e] = b[e]; } }
}

__device__ __forceinline__ void prologue(const Ctx& X, const float* const* in, float* out, unsigned char* ws) {
    const float* x = in[0]; const float* emb_g = in[1]; const float* emb_b = in[2]; const float* w_in = in[3];
    const float* w_brf = in[4]; const float* w_brh = in[5]; const float* w_bra = in[6]; const float* w_out = in[7];
    const float* lb_logits = in[8]; const float* w_query = in[12]; const float* sub_keys = in[13]; const float* peer_u = in[14]; const float* peer_v = in[15];
    const int lane = X.lane, tid = X.tid;
    {
        LAS float* scr = (LAS float*)(X.lds + X.wave * 16384);
        constexpr int I_WIN = (DM / 64) * (HW / 32), I_BRF = (512 / 64) * (DM / 32), I_BRH = (768 / 64) * (DM / 32), I_BRA = (256 / 64) * (DM / 32), I_OUT = (DM / 64) * (DM / 32);
        constexpr int PER_L = I_WIN + I_BRF + I_BRH + I_BRA + I_OUT;
        for (int it = X.gw; it < DEPTH * PER_L; it += X.ngw) {
            const int l = it / PER_L; int r = it % PER_L; unsigned char* wl = ws + WS_WL0 + (size_t)l * WL_STRIDE;
            if (r < I_WIN) { transpose_item(w_in + (size_t)l * DM * W_IN + 512, W_IN, DM, HW, (bf16*)(wl + WL_WIN), scr, r, lane); continue; } r -= I_WIN;
            if (r < I_BRF) { transpose_item(w_brf + (size_t)l * 512 * DM, DM, 512, DM, (bf16*)(wl + WL_BRF), scr, r, lane); continue; } r -= I_BRF;
            if (r < I_BRH) { transpose_item(w_brh + (size_t)l * 768 * DM, DM, 768, DM, (bf16*)(wl + WL_BRH), scr, r, lane); continue; } r -= I_BRH;
            if (r < I_BRA) { transpose_item(w_bra + (size_t)l * 256 * DM, DM, 256, DM, (bf16*)(wl + WL_BRA), scr, r, lane); continue; } r -= I_BRA;
            transpose_item(w_out + (size_t)l * DM * DM, DM, DM, DM, (bf16*)(wl + WL_OUT), scr, r, lane);
        }
    }
    {
        const size_t n8 = (size_t)NEXP * DM / 8; const size_t gt = (size_t)X.c * NTHR + tid, gs = (size_t)X.G * NTHR;
        for (int l = 0; l < DEPTH; ++l) {
            const float* su = peer_u + (size_t)l * NEXP * DM; const float* sv = peer_v + (size_t)l * NEXP * DM;
            bf16* du = (bf16*)(ws + WS_WL0 + (size_t)l * WL_STRIDE + WL_U); bf16* dv = (bf16*)(ws + WS_WL0 + (size_t)l * WL_STRIDE + WL_V);
            for (size_t i = gt; i < n8; i += gs) {
                const f32x4 a = *(const f32x4*)(su + i * 8), b = *(const f32x4*)(su + i * 8 + 4), c = *(const f32x4*)(sv + i * 8), d = *(const f32x4*)(sv + i * 8 + 4);
                u32x4 w; w.x = pk2(a[0], a[1]); w.y = pk2(a[2], a[3]); w.z = pk2(b[0], b[1]); w.w = pk2(b[2], b[3]); *(u32x4*)(du + i * 8) = w;
                u32x4 z; z.x = pk2(c[0], c[1]); z.y = pk2(c[2], c[3]); z.z = pk2(d[0], d[1]); z.w = pk2(d[2], d[3]); *(u32x4*)(dv + i * 8) = z;
            }
        }
    }
    __syncthreads();
    {
        LAS float* wt = (LAS float*)X.lds;
        LAS float* ct = (LAS float*)(X.lds + 64 * 129 * 4);
        for (int it = X.c; it < DEPTH * 4 * 32; it += X.G) {
            const int l = it >> 7, g = (it >> 5) & 3, d0 = (it & 31) * 64;
            __syncthreads();
            if (tid < 128) ct[tid] = cospif((float)tid * (1.0f / 64.0f));
            const float* src = w_in + (size_t)l * DM * W_IN + (size_t)d0 * W_IN + g * 128;
#pragma unroll 4
            for (int i = 0; i < 16; ++i) { const int idx = tid + NTHR * i, dd = idx >> 7, n2 = idx & 127; wt[dd * 129 + n2] = src[(size_t)dd * W_IN + n2]; }
            __syncthreads();
            const int dd = tid & 63, rg = X.wave;
            float acc[32];
#pragma unroll
            for (int i = 0; i < 32; ++i) acc[i] = 0.f;
            const int part = rg >> 2, k2b = (rg & 3) * 32;
            for (int n2 = 0; n2 < 128; ++n2) {
                const float w = wt[dd * 129 + n2];
#pragma unroll
                for (int i = 0; i < 32; ++i) { const int k2 = k2b + i; const int m = (k2 * n2 - part * 32) & 127; acc[i] += ct[m] * w; }
            }
            bf16* dst = (bf16*)(ws + WS_WL0 + (size_t)l * WL_STRIDE + WL_WF);
#pragma unroll
            for (int i = 0; i < 32; ++i) dst[(size_t)(part * 512 + g * 128 + k2b + i) * DM + d0 + dd] = (bf16)f2bf(acc[i]);
        }
    }
    __syncthreads();
    {
        LAS float* wq = (LAS float*)X.lds;
        LAS float* ky = (LAS float*)(X.lds + 64 * 129 * 4 + 64);
        for (int it = X.c; it < DEPTH * 16 * 32; it += X.G) {
            const int l = it >> 9, hp = (it >> 5) & 15, dm0 = (it & 31) * 64, p = hp & 1;
            __syncthreads();
            const float* ksrc = sub_keys + ((size_t)l * 2 + p) * 128 * 128;
#pragma unroll 4
            for (int i = 0; i < 32; ++i) ky[tid + NTHR * i] = ksrc[tid + NTHR * i];
            const float* src = w_query + (size_t)l * DM * DM + (size_t)dm0 * DM + hp * 128;
#pragma unroll 4
            for (int i = 0; i < 16; ++i) { const int idx = tid + NTHR * i, dd = idx >> 7, d = idx & 127; wq[dd * 129 + d] = src[(size_t)dd * DM + d]; }
            __syncthreads();
            const int dd = tid & 63, k0 = X.wave * 16;
            float acc[16];
#pragma unroll
            for (int i = 0; i < 16; ++i) acc[i] = 0.f;
            for (int d = 0; d < 128; ++d) {
                const float w = wq[dd * 129 + d];
#pragma unroll
                for (int i = 0; i < 16; ++i) acc[i] += ky[(k0 + i) * 128 + d] * w;
            }
            bf16* dst = (bf16*)(ws + WS_WL0 + (size_t)l * WL_STRIDE + WL_WS);
#pragma unroll
            for (int i = 0; i < 16; ++i) dst[(size_t)(hp * 128 + k0 + i) * DM + dm0 + dd] = (bf16)f2bf(acc[i]);
        }
    }
    __syncthreads();
    {
        LAS float* ct = (LAS float*)X.lds;
        const float norm = 1.0f / sqrtf((float)SEQ * 128.0f);
        for (int i = tid; i < 4096; i += NTHR) ct[i] = cospif((float)i * (1.0f / 2048.0f)) * norm;
        __syncthreads();
        bf16* Fm = (bf16*)(ws + WS_F);
        for (int k1 = X.c; k1 < SEQ; k1 += X.G) {
#pragma unroll
            for (int rep = 0; rep < 2; ++rep) {
                const int e0 = (tid + rep * NTHR) * 8;
                const int part = e0 >> 12, n1 = e0 & 4095;
                float v[8];
#pragma unroll
                for (int j = 0; j < 8; ++j) { const int idx = (k1 * (n1 + j)) & 4095; v[j] = part ? -ct[(idx - 1024) & 4095] : ct[idx]; }
                u32x4 w; w.x = pk2(v[0], v[1]); w.y = pk2(v[2], v[3]); w.z = pk2(v[4], v[5]); w.w = pk2(v[6], v[7]);
                *(u32x4*)(Fm + (size_t)k1 * 8192 + e0) = w;
            }
        }
    }
    __syncthreads();
    {
        const int gt = X.c * NTHR + tid;
        if (gt < SEQ * 8) { const int pos = gt >> 3, i = gt & 7; const float invf = powf(500000.0f, -(float)i * 0.125f); const float ang = (float)pos * invf;
            ((float*)(ws + WS_TAB))[gt] = cosf(ang); ((float*)(ws + WS_TAB + TAB_SIN))[gt] = sinf(ang); }
        if (gt < 2 * 768) { const int dir = gt / 768, col = gt % 768; const float l0 = lb_logits[(dir * DEPTH + 0) * 768 + col], l1 = lb_logits[(dir * DEPTH + 1) * 768 + col];
            float* lb = (float*)(ws + WS_TAB + TAB_LB);
            lb[(dir * DEPTH + 0) * 768 + col] = 0.f;
            lb[(dir * DEPTH + 1) * 768 + col] = 1.0f / (1.0f + expf(l0 - l1)); }
    }
    for (int m = X.gw; m < TOK; m += X.ngw) { float v[32]; load_row32(x + (size_t)m * DM, lane, v); ln_row(v, lane, emb_g, emb_b, out + (size_t)m * DM, (bf16*)(ws + WS_XA) + (size_t)m * DM); }
}

__device__ __forceinline__ void attn_naive(const Ctx& X, const bf16* h, const float* rc, const float* rs, bf16* ya) {
    for (int idx = X.c * NTHR + X.tid; idx < TOK * 4; idx += X.G * NTHR) {
        const int tk = idx >> 2, hh = idx & 3, b = tk / SEQ, p = tk % SEQ;
        float mx = -1e30f, l = 0.f; float o[64];
#pragma unroll
        for (int d = 0; d < 64; ++d) o[d] = 0.f;
        for (int g = 0; g < 3; ++g) {
            const int dil = (g == 0) ? 1 : (g == 1 ? 4 : 16), head = g * 4 + hh;
            float q[64];
            { const bf16* qp = h + (size_t)tk * HW + H_QA + head * 64;
#pragma unroll
              for (int i = 0; i < 8; ++i) { const u32x4 w = *(const u32x4*)(qp + i * 8); q[i * 8 + 0] = bflo(w.x); q[i * 8 + 1] = bfhi(w.x); q[i * 8 + 2] = bflo(w.y); q[i * 8 + 3] = bfhi(w.y);
                  q[i * 8 + 4] = bflo(w.z); q[i * 8 + 5] = bfhi(w.z); q[i * 8 + 6] = bflo(w.w); q[i * 8 + 7] = bfhi(w.w); }
#pragma unroll
              for (int i = 0; i < 8; ++i) { const float c = rc[p * 8 + i], s = rs[p * 8 + i], t1 = q[i], t2 = q[8 + i]; q[i] = t1 * c - t2 * s; q[8 + i] = t2 * c + t1 * s; }
#pragma unroll
              for (int d = 0; d < 64; ++d) q[d] *= 0.125f; }
            for (int j = -64; j <= 64; ++j) {
                const int kp = p + j * dil; if (kp < 0 || kp >= SEQ) continue;
                const bf16* kr = h + (size_t)(b * SEQ + kp) * HW + H_KA + head * 64;
                float s = 0.f;
                { const u32x4 w0 = *(const u32x4*)(kr), w1 = *(const u32x4*)(kr + 8);
                  const float k1[8] = {bflo(w0.x), bfhi(w0.x), bflo(w0.y), bfhi(w0.y), bflo(w0.z), bfhi(w0.z), bflo(w0.w), bfhi(w0.w)};
                  const float k2[8] = {bflo(w1.x), bfhi(w1.x), bflo(w1.y), bfhi(w1.y), bflo(w1.z), bfhi(w1.z), bflo(w1.w), bfhi(w1.w)};
#pragma unroll
                  for (int i = 0; i < 8; ++i) { const float c = rc[kp * 8 + i], sn = rs[kp * 8 + i]; s += q[i] * (k1[i] * c - k2[i] * sn) + q[8 + i] * (k2[i] * c + k1[i] * sn); } }
#pragma unroll
                for (int i = 2; i < 8; ++i) { const u32x4 w = *(const u32x4*)(kr + i * 8);
                    s += q[i * 8 + 0] * bflo(w.x) + q[i * 8 + 1] * bfhi(w.x) + q[i * 8 + 2] * bflo(w.y) + q[i * 8 + 3] * bfhi(w.y) + q[i * 8 + 4] * bflo(w.z) + q[i * 8 + 5] * bfhi(w.z) + q[i * 8 + 6] * bflo(w.w) + q[i * 8 + 7] * bfhi(w.w); }
                const float mn = fmaxf(mx, s), corr = __expf(mx - mn), pr = __expf(s - mn);
                l = l * corr + pr; mx = mn;
                const bf16* vr = h + (size_t)(b * SEQ + kp) * HW + H_VA + head * 64;
#pragma unroll
                for (int i = 0; i < 8; ++i) { const u32x4 w = *(const u32x4*)(vr + i * 8);
                    o[i * 8 + 0] = o[i * 8 + 0] * corr + pr * bflo(w.x); o[i * 8 + 1] = o[i * 8 + 1] * corr + pr * bfhi(w.x); o[i * 8 + 2] = o[i * 8 + 2] * corr + pr * bflo(w.y); o[i * 8 + 3] = o[i * 8 + 3] * corr + pr * bfhi(w.y);
                    o[i * 8 + 4] = o[i * 8 + 4] * corr + pr * bflo(w.z); o[i * 8 + 5] = o[i * 8 + 5] * corr + pr * bfhi(w.z); o[i * 8 + 6] = o[i * 8 + 6] * corr + pr * bflo(w.w); o[i * 8 + 7] = o[i * 8 + 7] * corr + pr * bfhi(w.w); }
            }
        }
        const float il = 1.0f / l; bf16* op = ya + (size_t)tk * 256 + hh * 64;
#pragma unroll
        for (int i = 0; i < 8; ++i) { u32x4 w; w.x = pk2(o[i * 8] * il, o[i * 8 + 1] * il); w.y = pk2(o[i * 8 + 2] * il, o[i * 8 + 3] * il); w.z = pk2(o[i * 8 + 4] * il, o[i * 8 + 5] * il); w.w = pk2(o[i * 8 + 6] * il, o[i * 8 + 7] * il);
            *(u32x4*)(op + i * 8) = w; }
    }
}
__device__ __forceinline__ void hgrn_prep_naive(const Ctx& X, const bf16* h, const float* lbl  , float* FD, float* KY) {
    const size_t n = (size_t)2 * TOK * 768;
    for (size_t i = (size_t)X.c * NTHR + X.tid; i < n; i += (size_t)X.G * NTHR) {
        const int dir = (int)(i / ((size_t)TOK * 768)); const size_t r = i % ((size_t)TOK * 768); const int tk = (int)(r / 768), col = (int)(r % 768);
        const float z = bf2f(h[(size_t)tk * HW + (dir ? H_FB : H_FF) + col]); const float lb = lbl[dir * DEPTH * 768 + col];
        const float s = 1.0f / (1.0f + expf(-z));
        FD[i] = lb + (1.0f - lb) * s; KY[i] = (1.0f - lb) * (1.0f - s);
    }
}
__device__ __forceinline__ void hgrn_scan_naive(const Ctx& X, const bf16* h, const float* FD, const float* KY, float* O  ) {
    LAS float* sf = (LAS float*)X.lds; LAS float* sk = sf + 512; LAS float* sq = sk + 512;
    for (int it = X.c; it < 6; it += X.G) {
        const int grp = X.tid >> 7, v = X.tid & 127, ch = it * 4 + grp;
        const int dir = ch / 12, b = (ch % 12) / 6, hd = ch % 6;
        float S[128];
#pragma unroll
        for (int k = 0; k < 128; ++k) S[k] = 0.f;
        for (int st = 0; st < SEQ; ++st) {
            const int t = dir ? (SEQ - 1 - st) : st; const size_t tk = (size_t)b * SEQ + t;
            const size_t e = ((size_t)dir * TOK + tk) * 768 + hd * 128 + v;
            const float f = FD[e], ky = KY[e], qv = bf2f(h[tk * HW + H_Q + hd * 128 + v]), vv = bf2f(h[tk * HW + H_I + hd * 128 + v]);
            __syncthreads();
            sf[X.tid] = f; sk[X.tid] = ky; sq[X.tid] = qv;
            __syncthreads();
            float o = 0.f;
            const LAS f32x4* pf = (const LAS f32x4*)(sf + grp * 128); const LAS f32x4* pk = (const LAS f32x4*)(sk + grp * 128); const LAS f32x4* pq = (const LAS f32x4*)(sq + grp * 128);
#pragma unroll
            for (int k4 = 0; k4 < 32; ++k4) { const f32x4 a = pf[k4], c = pk[k4], d = pq[k4];
#pragma unroll
                for (int e2 = 0; e2 < 4; ++e2) { S[k4 * 4 + e2] = a[e2] * S[k4 * 4 + e2] + c[e2] * vv; o += d[e2] * S[k4 * 4 + e2]; } }
            O[e] = o;
        }
    }
}
__device__ __forceinline__ void hgrn_combine_naive(const Ctx& X, const bf16* h, const float* O, const float* norm_g, bf16* yh) {
    for (int it = X.gw; it < TOK * 6; it += X.ngw) {
        const int tk = it / 6, hd = it % 6; const size_t e = (size_t)tk * 768 + hd * 128 + X.lane * 2;
        const f32x2 a = *(const f32x2*)(O + e), b = *(const f32x2*)(O + (size_t)TOK * 768 + e);
        const float o0 = a[0] + b[0], o1 = a[1] + b[1];
        const float ms = wave_sum(o0 * o0 + o1 * o1) * (1.0f / 128.0f); const float r = 1.0f / sqrtf(ms + 1e-6f);
        const unsigned gw = *(const unsigned*)(h + (size_t)tk * HW + H_G + hd * 128 + X.lane * 2); const float g0 = bflo(gw), g1 = bfhi(gw);
        const f32x2 ng = *(const f32x2*)(norm_g + hd * 128 + X.lane * 2);
        const float y0 = o0 * r * ng[0] * (g0 / (1.0f + expf(-g0))), y1 = o1 * r * ng[1] * (g1 / (1.0f + expf(-g1)));
        *(unsigned*)(yh + e) = pk2(y0, y1);
    }
}
__device__ __forceinline__ void fourier_reduce(const Ctx& X, const float* FP, bf16* yf) {
    for (int i = X.c * NTHR + X.tid; i < SEQ * 1024 / 4; i += X.G * NTHR) {
        const int k1 = i >> 8, c4 = (i & 255) * 4;
        f32x4 s = *(const f32x4*)(FP + (size_t)k1 * 1024 + c4);
#pragma unroll
        for (int ks = 1; ks < 4; ++ks) s = s + *(const f32x4*)(FP + (size_t)ks * SEQ * 1024 + (size_t)k1 * 1024 + c4);
        const int b = c4 >> 9, j = c4 & 511; u32x2 w; w.x = pk2(s[0], s[1]); w.y = pk2(s[2], s[3]);
        *(u32x2*)(yf + (size_t)(b * SEQ + k1) * 512 + j) = w;
    }
}
__device__ __forceinline__ void ln_phase(const Ctx& X, const float* vpre, const float* g, const float* b, float* xres, bf16* xa) {
    for (int m = X.gw; m < TOK; m += X.ngw) { float v[32]; load_row32(vpre + (size_t)m * DM, X.lane, v); ln_row(v, X.lane, g, b, xres + (size_t)m * DM, xa + (size_t)m * DM); }
}

__device__ __forceinline__ float dot2bf(unsigned w, unsigned x, float acc) { return __builtin_amdgcn_fdot2_f32_bf16(__builtin_bit_cast(bf16x2_t, w), __builtin_bit_cast(bf16x2_t, x), acc, false); }
__device__ __forceinline__ float gelu_erf(float x) { return 0.5f * x * (1.0f + erff(x * 0.70710678118654752f)); }
__device__ __forceinline__ void peer_phase(const Ctx& X, const float* scores, const bf16* Ub, const bf16* Vb, float* xres, bf16* xa, const float* lng, const float* lnb,
                                           const float* Uf, const float* Vf, const float* Wq, const float* Kf) {
    const int lane = X.lane;
        LAS float* sc = (LAS float*)(X.lds + X.wave * 12288);
    LAS float* tops = sc + 2048;
    LAS int* topi = (LAS int*)(tops + 256);
    LAS int* le = topi + 256;
    LAS float* lg = (LAS float*)(le + 128);
    const float NEG = -3.0e38f;
    for (int tk = X.gw; tk < TOK; tk += X.ngw) {
        const float* srow = scores + (size_t)tk * 2048;
#if defined(PEER_NAIVE_SC)
        { (void)srow;
          float qa[32];
#pragma unroll
          for (int i = 0; i < 32; ++i) qa[i] = 0.f;
          for (int dm = 0; dm < DM; ++dm) { const float xv = xres[(size_t)tk * DM + dm];
#pragma unroll
              for (int i = 0; i < 32; ++i) qa[i] += xv * Wq[(size_t)dm * DM + i * 64 + lane]; }
#pragma unroll
          for (int i = 0; i < 32; ++i) sc[i * 64 + lane] = qa[i];
          LDS_WAIT();
          float sv[32];
#pragma unroll
          for (int r = 0; r < 16; ++r) { const int p = r & 1;
              float s0 = 0.f, s1 = 0.f;
              for (int d = 0; d < 128; ++d) { const float qv = sc[r * 128 + d]; s0 += qv * Kf[((size_t)p * 128 + lane) * 128 + d]; s1 += qv * Kf[((size_t)p * 128 + 64 + lane) * 128 + d]; }
              sv[2 * r] = s0; sv[2 * r + 1] = s1; }
          LDS_WAIT();
#pragma unroll
          for (int r = 0; r < 16; ++r) { sc[r * 128 + lane] = sv[2 * r]; sc[r * 128 + 64 + lane] = sv[2 * r + 1]; }
          LDS_WAIT(); }
#else
#pragma unroll
        for (int i = 0; i < 8; ++i) *(LAS f32x4*)(sc + i * 256 + lane * 4) = *(const f32x4*)(srow + i * 256 + lane * 4);
        LDS_WAIT();
#endif
#if defined(PEER_NAIVE_SEL)
        for (int r = 0; r < 16; ++r) {
            const float a = sc[r * 128 + lane], b = sc[r * 128 + 64 + lane]; int ca = 0, cb = 0;
            for (int k = 0; k < 128; ++k) { const float v = sc[r * 128 + k]; ca += (v > a || (v == a && k < lane)) ? 1 : 0; cb += (v > b || (v == b && k < 64 + lane)) ? 1 : 0; }
            if (ca < 16) { tops[r * 16 + ca] = a; topi[r * 16 + ca] = lane; }
            if (cb < 16) { tops[r * 16 + cb] = b; topi[r * 16 + cb] = 64 + lane; }
        }
        LDS_WAIT();
        for (int hd = 0; hd < 8; ++hd) {
            LAS float* cand = sc;
            const float a0 = tops[(2 * hd) * 16 + (lane >> 2)]; float cv[4];
#pragma unroll
            for (int jj = 0; jj < 4; ++jj) { cv[jj] = a0 + tops[(2 * hd + 1) * 16 + (lane & 3) * 4 + jj]; cand[lane * 4 + jj] = cv[jj]; }
            LDS_WAIT();
            int cn[4] = {0, 0, 0, 0};
            for (int k = 0; k < 256; ++k) { const float v = cand[k];
#pragma unroll
                for (int jj = 0; jj < 4; ++jj) cn[jj] += (v > cv[jj] || (v == cv[jj] && k < lane * 4 + jj)) ? 1 : 0; }
            LAS float* bsl = sc + 256; LAS int* bcl = (LAS int*)(sc + 272);
#pragma unroll
            for (int jj = 0; jj < 4; ++jj) if (cn[jj] < 16) { bsl[cn[jj]] = cv[jj]; bcl[cn[jj]] = lane * 4 + jj; }
            LDS_WAIT();
            const float M0 = bsl[0]; const float bs = (lane < 16) ? bsl[lane] : 0.f; const int bc = (lane < 16) ? bcl[lane] : 0;
            const float ex = (lane < 16) ? __expf(bs - M0) : 0.f; const float sum = wave_sum(ex);
            if (lane < 16) { const int i1 = topi[(2 * hd) * 16 + (bc >> 4)], i2 = topi[(2 * hd + 1) * 16 + (bc & 15)]; le[hd * 16 + lane] = i1 * 128 + i2; lg[hd * 16 + lane] = ex / sum; }
            LDS_WAIT();
        }
        LDS_WAIT();
#else
        for (int r = 0; r < 16; ++r) {
            float a = sc[r * 128 + lane], b = sc[r * 128 + 64 + lane]; float tv = 0.f; int ti = 0;
#pragma unroll
            for (int it = 0; it < 16; ++it) {
                const float M = wave_max(fmaxf(a, b));
                const unsigned long long ba = __ballot(a == M); int idx;
                if (ba != 0ull) { const int ln = __ffsll((long long)ba) - 1; idx = ln; if (lane == ln) a = NEG; }
                else { const unsigned long long bb = __ballot(b == M); const int ln = __ffsll((long long)bb) - 1; idx = 64 + ln; if (lane == ln) b = NEG; }
                if (lane == it) { tv = M; ti = idx; }
            }
            if (lane < 16) { tops[r * 16 + lane] = tv; topi[r * 16 + lane] = ti; }
        }
        LDS_WAIT();
        for (int hd = 0; hd < 8; ++hd) {
            const float a0 = tops[(2 * hd) * 16 + (lane >> 2)];
            float c0 = a0 + tops[(2 * hd + 1) * 16 + (lane & 3) * 4 + 0], c1 = a0 + tops[(2 * hd + 1) * 16 + (lane & 3) * 4 + 1];
            float c2 = a0 + tops[(2 * hd + 1) * 16 + (lane & 3) * 4 + 2], c3 = a0 + tops[(2 * hd + 1) * 16 + (lane & 3) * 4 + 3];
            float bs = NEG; int bc = 0;
#pragma unroll
            for (int it = 0; it < 16; ++it) {
                const float M = wave_max(fmaxf(fmaxf(c0, c1), fmaxf(c2, c3)));
                const int fj = (c0 == M) ? 0 : (c1 == M) ? 1 : (c2 == M) ? 2 : (c3 == M) ? 3 : -1;
                const unsigned long long bal = __ballot(fj >= 0); const int ln = __ffsll((long long)bal) - 1;
                const int fjw = __builtin_amdgcn_readlane(fj, ln);
                if (lane == ln) { if (fjw == 0) c0 = NEG; else if (fjw == 1) c1 = NEG; else if (fjw == 2) c2 = NEG; else c3 = NEG; }
                if (lane == it) { bs = M; bc = ln * 4 + fjw; }
            }
            const float M0 = rdlane(bs, 0);
            const float ex = (lane < 16) ? __expf(bs - M0) : 0.f; const float sum = wave_sum(ex);
            if (lane < 16) { const int i1 = topi[(2 * hd) * 16 + (bc >> 4)], i2 = topi[(2 * hd + 1) * 16 + (bc & 15)]; le[hd * 16 + lane] = i1 * 128 + i2; lg[hd * 16 + lane] = ex / sum; }
        }
        LDS_WAIT();
#endif
        unsigned xp[16];
        { float xr[32]; load_row32(xres + (size_t)tk * DM, lane, xr);
#pragma unroll
          for (int i = 0; i < 16; ++i) xp[i] = pk2(xr[2 * i], xr[2 * i + 1]); }
        float y[32];
#pragma unroll
        for (int i = 0; i < 32; ++i) y[i] = 0.f;
        constexpr int EG = 2;
        for (int g4 = 0; g4 < 128 / EG; ++g4) {
#if defined(PEER_F32_GATHER)
            { float xr2[32]; load_row32(xres + (size_t)tk * DM, lane, xr2);
              for (int k = 0; k < EG; ++k) { const int e = __builtin_amdgcn_readfirstlane(le[g4 * EG + k]); const float gtk = lg[g4 * EG + k];
                  float ur[32];
#if defined(PEER_BF_TABLE)
#pragma unroll
                  for (int c = 0; c < 4; ++c) { const u32x4 w = *(const u32x4*)(Ub + (size_t)e * DM + lane * 8 + c * 512);
                      ur[c * 8 + 0] = bflo(w.x); ur[c * 8 + 1] = bfhi(w.x); ur[c * 8 + 2] = bflo(w.y); ur[c * 8 + 3] = bfhi(w.y); ur[c * 8 + 4] = bflo(w.z); ur[c * 8 + 5] = bfhi(w.z); ur[c * 8 + 6] = bflo(w.w); ur[c * 8 + 7] = bfhi(w.w); }
#else
                  load_row32(Uf + (size_t)e * DM, lane, ur);
#endif
                  float s = 0.f;
#pragma unroll
                  for (int i = 0; i < 32; ++i) s += ur[i] * xr2[i];
                  const float hvk = gelu_erf(wave_sum(s)) * gtk;
                  float vr[32];
#if defined(PEER_BF_TABLE)
#pragma unroll
                  for (int c = 0; c < 4; ++c) { const u32x4 w = *(const u32x4*)(Vb + (size_t)e * DM + lane * 8 + c * 512);
                      vr[c * 8 + 0] = bflo(w.x); vr[c * 8 + 1] = bfhi(w.x); vr[c * 8 + 2] = bflo(w.y); vr[c * 8 + 3] = bfhi(w.y); vr[c * 8 + 4] = bflo(w.z); vr[c * 8 + 5] = bfhi(w.z); vr[c * 8 + 6] = bflo(w.w); vr[c * 8 + 7] = bfhi(w.w); }
#else
                  load_row32(Vf + (size_t)e * DM, lane, vr);
#endif
#pragma unroll
                  for (int i = 0; i < 32; ++i) y[i] += hvk * vr[i]; } }
            continue;
#endif
            u32x4 U[EG][4], V[EG][4]; float gt[EG];
#pragma unroll
            for (int k = 0; k < EG; ++k) { const int e = __builtin_amdgcn_readfirstlane(le[g4 * EG + k]); gt[k] = lg[g4 * EG + k];
                const bf16* up = Ub + (size_t)e * DM + lane * 8; const bf16* vp = Vb + (size_t)e * DM + lane * 8;
#pragma unroll
                for (int c = 0; c < 4; ++c) { U[k][c] = *(const u32x4*)(up + c * 512); V[k][c] = *(const u32x4*)(vp + c * 512); } }
            float hv[EG];
#pragma unroll
            for (int k = 0; k < EG; ++k) { float s = 0.f;
#pragma unroll
                for (int c = 0; c < 4; ++c) {
                    s = dot2bf(U[k][c].x, xp[c * 4 + 0], s);
                    s = dot2bf(U[k][c].y, xp[c * 4 + 1], s);
                    s = dot2bf(U[k][c].z, xp[c * 4 + 2], s);
                    s = dot2bf(U[k][c].w, xp[c * 4 + 3], s); }
                hv[k] = gelu_erf(wave_sum(s)) * gt[k]; }
#pragma unroll
            for (int k = 0; k < EG; ++k)
#pragma unroll
                for (int c = 0; c < 4; ++c) { const u32x4 w = V[k][c];
                    y[c * 8 + 0] += hv[k] * bflo(w.x); y[c * 8 + 1] += hv[k] * bfhi(w.x); y[c * 8 + 2] += hv[k] * bflo(w.y); y[c * 8 + 3] += hv[k] * bfhi(w.y);
                    y[c * 8 + 4] += hv[k] * bflo(w.z); y[c * 8 + 5] += hv[k] * bfhi(w.z); y[c * 8 + 6] += hv[k] * bflo(w.w); y[c * 8 + 7] += hv[k] * bfhi(w.w); }
        }
#if defined(EXP_ZERO_PEER)
#pragma unroll
        for (int i = 0; i < 32; ++i) y[i] = 0.f;
#endif
        asm volatile("" ::: "memory");
        { float xr[32]; load_row32(xres + (size_t)tk * DM, lane, xr);
#pragma unroll
          for (int i = 0; i < 32; ++i) y[i] += DN_ALPHA * xr[i]; }
        ln_row(y, lane, lng, lnb, xres + (size_t)tk * DM, xa + (size_t)tk * DM);
    }
}

#ifndef MK_ONE_LAUNCH
#define MK_ONE_LAUNCH 1
#endif
constexpr int N_PHASES = 1 + 9 * DEPTH;
__device__ __forceinline__ bool fresh(Ctx& X) { asm volatile("" : "+v"(X.tid), "+v"(X.lane)); return true; }
struct Args { const float* in[18]; float* out; unsigned char* ws; int ph_lo, ph_hi; };
typedef pg8::bf16_t pbf;

__global__ void __launch_bounds__(NTHR, 2) fwd_kernel(Args args) {
    extern __shared__ __attribute__((aligned(16))) unsigned char lds[];
    cg::grid_group grid = cg::this_grid();
    Ctx X; X.lds = lds; X.tid = threadIdx.x; X.lane = X.tid & 63; X.wave = __builtin_amdgcn_readfirstlane(X.tid >> 6);
    X.G = gridDim.x; X.c = blockIdx.x; X.gw = X.c * NWAVES + X.wave; X.ngw = X.G * NWAVES;
    unsigned char* ws = args.ws; float* out = args.out;
    LAS unsigned char* ldsl = (LAS unsigned char*)lds;
    const int lo = args.ph_lo, hi = args.ph_hi;
#define IN(k) (lo <= (k) && (k) < hi && fresh(X))
#define INR(k) (lo <= (k) && (k) < hi)
#define SEAM(k) do { if (INR(k) && INR((k) + 1)) grid.sync(); else __syncthreads(); } while (0)

    #ifndef SKIP_P0
    if (IN(0)) { prologue(X, args.in, out, ws); SEAM(0); }
#endif

    const float* ropec = (const float*)(ws + WS_TAB); const float* ropes = (const float*)(ws + WS_TAB + TAB_SIN); const float* lbt = (const float*)(ws + WS_TAB + TAB_LB);
    pbf* XA = (pbf*)(ws + WS_XA); pbf* Hb = (pbf*)(ws + WS_H); pbf* PT = (pbf*)(ws + WS_PT); float* FP = (float*)(ws + WS_FP);
    pbf* YF = (pbf*)(ws + WS_YF); pbf* YH = (pbf*)(ws + WS_YH); pbf* YA = (pbf*)(ws + WS_YA);
    float* MACC = (float*)(ws + WS_MACC); pbf* MERGED = (pbf*)(ws + WS_MERGED); float* VPRE = (float*)(ws + WS_VPRE); float* SC = (float*)(ws + WS_SC);
    float* FD = (float*)(ws + WS_LB); float* KY = FD + (size_t)2 * TOK * 768; float* OH = (float*)(ws + WS_SB);

    for (int l = 0; l < DEPTH; ++l) {
        const int pb = 1 + 9 * l;
        unsigned char* wl = ws + WS_WL0 + (size_t)l * WL_STRIDE;
        pbf* WinT = (pbf*)(wl + WL_WIN); pbf* WfT = (pbf*)(wl + WL_WF); pbf* BRF = (pbf*)(wl + WL_BRF); pbf* BRH = (pbf*)(wl + WL_BRH); pbf* BRA = (pbf*)(wl + WL_BRA);
        pbf* WoutT = (pbf*)(wl + WL_OUT); pbf* WsT = (pbf*)(wl + WL_WS); const pbf* Ub = (const pbf*)(wl + WL_U); const pbf* Vb = (const pbf*)(wl + WL_V);
        if (IN(pb + 0)) {
#ifndef SKIP_G1
            { pg8::Gemm g{XA, WinT, TOK, HW, DM, DM, DM}; pg8::StaticOrder S; S.init(TOK, HW, X.G, X.c); pg8::EpiBf16<0> E{Hb, HW, nullptr, 0, 0, 1.f};
              pg8::gemm_phase<pg8::EpiBf16<0>, pg8::StaticOrder, true, true>(ldsl, g, S, E); }
#endif
#ifndef SKIP_G2
            { pg8::Gemm g{WfT, XA, 1024, TOK, DM, DM, DM}; pg8::StaticOrder S; S.init(1024, TOK, X.G, X.c); pg8::EpiPT E{PT};
              pg8::gemm_phase<pg8::EpiPT, pg8::StaticOrder, true, true>(ldsl, g, S, E); }
#endif
            SEAM(pb + 0);
        }
        if (IN(pb + 1)) {
#ifndef SKIP_G3
            for (int it = X.c; it < 256; it += X.G) { const int ks = it >> 6, tile = it & 63;
                pg8::Gemm g{(const pbf*)(ws + WS_F) + ks * 2048, PT + ks * 2048, SEQ, 1024, 2048, 8192, 8192}; pg8::OneUnit S{tile >> 2, tile & 3}; pg8::EpiF32 E{FP + (size_t)ks * SEQ * 1024, 1024};
                pg8::gemm_phase<pg8::EpiF32, pg8::OneUnit, false, true>(ldsl, g, S, E); }
#endif
            __syncthreads();
#ifndef SKIP_ATTN
            attn_naive(X, Hb, ropec, ropes, YA);
#endif
#ifndef SKIP_HPREP
            hgrn_prep_naive(X, Hb, lbt + l * 768, FD, KY);
#endif
            SEAM(pb + 1);
        }
        if (IN(pb + 2)) {
#ifndef SKIP_HSCAN
            hgrn_scan_naive(X, Hb, FD, KY, OH);
#endif
            fourier_reduce(X, FP, YF); SEAM(pb + 2); }
        if (IN(pb + 3)) { hgrn_combine_naive(X, Hb, OH, args.in[9] + (size_t)l * 768, YH); SEAM(pb + 3); }
        if (IN(pb + 4)) {
#ifndef SKIP_G4
            { pg8::Gemm g{YF, BRF, TOK, DM, 512, 512, 512}; pg8::StaticOrder S; S.init(TOK, DM, X.G, X.c); pg8::EpiGate<0> E{Hb + H_GATE, HW, MACC, MERGED, DM};
              pg8::gemm_phase<pg8::EpiGate<0>, pg8::StaticOrder, true, true>(ldsl, g, S, E); }
#endif
#ifndef SKIP_G5
            { pg8::Gemm g{YH, BRH, TOK, DM, 768, 768, 768}; pg8::StaticOrder S; S.init(TOK, DM, X.G, X.c); pg8::EpiGate<1> E{Hb + H_GATE + DM, HW, MACC, MERGED, DM};
              pg8::gemm_phase<pg8::EpiGate<1>, pg8::StaticOrder, true, true>(ldsl, g, S, E); }
#endif
#ifndef SKIP_G6
            { pg8::Gemm g{YA, BRA, TOK, DM, 256, 256, 256}; pg8::StaticOrder S; S.init(TOK, DM, X.G, X.c); pg8::EpiGate<2> E{Hb + H_GATE + 2 * DM, HW, MACC, MERGED, DM};
              pg8::gemm_phase<pg8::EpiGate<2>, pg8::StaticOrder, true, true>(ldsl, g, S, E); }
#endif
            SEAM(pb + 4);
        }
        if (IN(pb + 5)) {
#ifndef SKIP_G7
            pg8::Gemm g{MERGED, WoutT, TOK, DM, DM, DM, DM}; pg8::StaticOrder S; S.init(TOK, DM, X.G, X.c); pg8::EpiResid E{out, VPRE, DM, DN_ALPHA};
            pg8::gemm_phase<pg8::EpiResid, pg8::StaticOrder, true, true>(ldsl, g, S, E);
#endif
            SEAM(pb + 5);
        }
        if (IN(pb + 6)) { ln_phase(X, VPRE, args.in[10] + (size_t)l * DM, args.in[11] + (size_t)l * DM, out, XA); SEAM(pb + 6); }
        if (IN(pb + 7)) {
#ifndef SKIP_G8
            pg8::Gemm g{XA, WsT, TOK, DM, DM, DM, DM}; pg8::StaticOrder S; S.init(TOK, DM, X.G, X.c); pg8::EpiF32 E{SC, DM};
            pg8::gemm_phase<pg8::EpiF32, pg8::StaticOrder, true, true>(ldsl, g, S, E);
#endif
            SEAM(pb + 7);
        }
        if (IN(pb + 8)) {
#ifndef SKIP_PEER
            peer_phase(X, SC, Ub, Vb, out, XA, args.in[16] + (size_t)l * DM, args.in[17] + (size_t)l * DM,
                       args.in[14] + (size_t)l * NEXP * DM, args.in[15] + (size_t)l * NEXP * DM, args.in[12] + (size_t)l * DM * DM, args.in[13] + (size_t)l * 2 * 128 * 128);
#endif
            if (pb + 8 + 1 < N_PHASES) SEAM(pb + 8); }
    }
#undef IN
#undef SEAM
}

extern "C" void kernel_launch(void* const* d_in, const int* in_sizes, int n_in, void* d_out, int out_size, void* d_ws, size_t ws_size, hipStream_t stream) {
    static int grid = 0;
    if (grid == 0) {
        if (n_in != 18 || in_sizes[0] != TOK * DM || out_size != TOK * DM || ws_size < WS_END) {
            fprintf(stderr, "kernel_launch: unexpected shapes (n_in %d, in0 %d, out %d, ws %zu, need %zu); nothing launched\n", n_in, n_in > 0 ? in_sizes[0] : -1, out_size, ws_size, (size_t)WS_END); grid = -1; return; }
        int dev = 0, cus = 0, per_cu = 0;
        if (hipGetDevice(&dev) != hipSuccess || hipDeviceGetAttribute(&cus, hipDeviceAttributeMultiprocessorCount, dev) != hipSuccess) { grid = -1; return; }
        if (hipFuncSetAttribute((const void*)fwd_kernel, hipFuncAttributeMaxDynamicSharedMemorySize, LDS_BYTES) != hipSuccess) { fprintf(stderr, "kernel_launch: hipFuncSetAttribute failed\n"); grid = -1; return; }
        if (hipOccupancyMaxActiveBlocksPerMultiprocessor(&per_cu, (const void*)fwd_kernel, NTHR, LDS_BYTES) != hipSuccess || per_cu < 1) { fprintf(stderr, "kernel_launch: occupancy query says %d blocks per CU\n", per_cu); grid = -1; (void)hipGetLastError(); return; }
        grid = cus * 1;
    }
    if (grid < 0) return;
    Args a{};
    for (int i = 0; i < 18; ++i) a.in[i] = (const float*)d_in[i];
    a.out = (float*)d_out; a.ws = (unsigned char*)d_ws;
#if MK_ONE_LAUNCH
    a.ph_lo = 0; a.ph_hi = N_PHASES;
    void* kargs[] = {&a};
    hipError_t e = hipLaunchCooperativeKernel((const void*)fwd_kernel, dim3(grid), dim3(NTHR), kargs, LDS_BYTES, stream);
    if (e != hipSuccess) fprintf(stderr, "kernel_launch: cooperative launch failed: %s (grid %d)\n", hipGetErrorString(e), grid);
#else
    for (int ph = 0; ph < N_PHASES; ++ph) { a.ph_lo = ph; a.ph_hi = ph + 1; hipLaunchKernelGGL(fwd_kernel, dim3(grid), dim3(NTHR), LDS_BYTES, stream, a); }
#endif
}
```

```cpp
#include <hip/hip_runtime.h>
#include <hip/hip_cooperative_groups.h>
#include <cstdio>
#include <cstdint>
namespace cg = cooperative_groups;
namespace pg8 {
#define PG8_LAS __attribute__((address_space(3)))
typedef unsigned short bf16_t;
typedef short bf16x8 __attribute__((ext_vector_type(8)));
typedef float f32x4 __attribute__((ext_vector_type(4)));
typedef unsigned u32x4 __attribute__((ext_vector_type(4)));
constexpr int BM = 256, BK = 64, HALF = 128, HTB = HALF * BK * 2  , STAGE_BYTES = 8 * HTB, NXCD = 8, WGM = 8;

__host__ __device__ __forceinline__ int lds_byte(int r, int c) { const int st = (r >> 4) * 2 + (c >> 5), rr = r & 15, cc = c & 31, ob = rr * 64 + cc * 2; return st * 1024 + (ob ^ (((ob >> 9) & 1) << 5)); }
__host__ __device__ __forceinline__ void stage_rc(int b, int& R, int& C) { const int st = b / 1024, sb = b % 1024, swz = sb ^ (((sb >> 9) & 1) << 5); R = (st >> 1) * 16 + swz / 64; C = (st & 1) * 32 + (swz % 64) / 2; }
__host__ __device__ __forceinline__ int perm32(int rho) { const int n = rho >> 4, i = rho & 15; return 8 * (i >> 2) + 4 * n + (i & 3); }

struct Unit { int pm, pn; };
struct Gemm { const bf16_t* A; const bf16_t* Bt; int M, N, K, lda, ldb; };

struct StaticOrder {
    int nM, nN, nwg, G, c;
    __host__ __device__ void init(int M, int N, int G_, int c_) { nM = M / BM; nN = N / BM; nwg = nM * nN; G = G_; c = c_; }
    __host__ __device__ bool next(int i, Unit& u) const {
        const long L = (long)i * G + c; if (L >= nwg) return false;
        int wgid = (int)L; { const int q = nwg / NXCD, r = nwg % NXCD, xcd = wgid % NXCD, off = wgid / NXCD; wgid = (xcd < r ? xcd * (q + 1) : r * (q + 1) + (xcd - r) * q) + off; }
        const int nig = WGM * nN, gid = wgid / nig, fm = gid * WGM, gsz = (nM - fm) < WGM ? (nM - fm) : WGM;
        u.pm = fm + ((wgid % nig) % gsz); u.pn = (wgid % nig) / gsz; return true;
    }
    __device__ __forceinline__ void a_ready(const Unit&) const {}
    __device__ __forceinline__ void done(const Unit&) const {}
};

__device__ __forceinline__ unsigned cvt_pk_bf16(float lo, float hi) { unsigned r; asm volatile("v_cvt_pk_bf16_f32 %0, %1, %2" : "=v"(r) : "v"(lo), "v"(hi)); return r; }
typedef float f32x2 __attribute__((ext_vector_type(2)));
__device__ __forceinline__ f32x2 gelu_pk(f32x2 v) {
    const f32x2 av = __builtin_elementwise_abs(v), d = av * 0.2316418882f + 1.0f;
    f32x2 t; t.x = __builtin_amdgcn_rcpf(d.x); t.y = __builtin_amdgcn_rcpf(d.y);
    f32x2 q = t * 0.5307027145f + (-0.7265760135f); q = q * t + 0.7107068705f; q = q * t + (-0.142248368f); q = q * t + 0.127414796f; q = q * t;
    const f32x2 s = (v * v) * (-0.72134752044f);
    f32x2 e; e.x = __builtin_amdgcn_exp2f(s.x); e.y = __builtin_amdgcn_exp2f(s.y);
    const f32x2 m = v * (q * e), r = v - m;
    f32x2 o; o.x = v.x < 0.f ? m.x : r.x; o.y = v.y < 0.f ? m.y : r.y; return o;
}

template <int ACT  > struct EpiBf16 {
    static constexpr bool PERM = true, AFTER_DRAIN = false; static_assert(ACT == 0 || ACT == 1, "EpiBf16: ACT is 0 (none) or 1 (gelu_pk)");
    bf16_t* O; int ldc; const float* bias; int split_cols; size_t split_stride; float scale0;
    __device__ __forceinline__ void operator()(const f32x4 (&acc)[2][2][4][2], const Unit& u, int wr, int wc, int fr, int fq) const {
        const int row0 = u.pm * BM + wr * 64 + fr; int colt = u.pn * BM; bf16_t* base = O;
        float sc = 1.f; if (split_cols) { const int t = colt / split_cols; base += (size_t)t * split_stride; colt -= t * split_cols; if (t == 0) sc = scale0; }
        const int col0 = colt + wc * 32 + 8 * fq, bcol0 = u.pn * BM + wc * 32 + 8 * fq;
        f32x4 bv[2][2];
#pragma unroll
        for (int bj = 0; bj < 2; ++bj)
#pragma unroll
            for (int n = 0; n < 2; ++n) bv[bj][n] = bias ? *(const f32x4*)(bias + bcol0 + bj * HALF + 4 * n) : (f32x4){0.f, 0.f, 0.f, 0.f};
#pragma unroll
        for (int ai = 0; ai < 2; ++ai)
#pragma unroll
            for (int m = 0; m < 4; ++m) { bf16_t* rowp = base + (size_t)(row0 + ai * HALF + m * 16) * ldc + col0;
#pragma unroll
                for (int bj = 0; bj < 2; ++bj) { f32x4 v0 = acc[ai][bj][m][0] + bv[bj][0], v1 = acc[ai][bj][m][1] + bv[bj][1];
                    if (ACT == 1) { f32x2 a = gelu_pk((f32x2){v0[0], v0[1]}), b = gelu_pk((f32x2){v0[2], v0[3]}), c = gelu_pk((f32x2){v1[0], v1[1]}), d = gelu_pk((f32x2){v1[2], v1[3]});
                        v0 = (f32x4){a.x, a.y, b.x, b.y}; v1 = (f32x4){c.x, c.y, d.x, d.y}; }
                    v0 = v0 * sc; v1 = v1 * sc; u32x4 w; w.x = cvt_pk_bf16(v0[0], v0[1]); w.y = cvt_pk_bf16(v0[2], v0[3]); w.z = cvt_pk_bf16(v1[0], v1[1]); w.w = cvt_pk_bf16(v1[2], v1[3]);
                    *(u32x4*)(rowp + bj * HALF) = w; } }
    }
};
#ifndef EXP_MIX_SCALE
#define EXP_MIX_SCALE 1.0f
#endif

struct EpiF32 {
    static constexpr bool PERM = false, AFTER_DRAIN = false;
    float* C; int ldc;
    __device__ __forceinline__ void operator()(const f32x4 (&acc)[2][2][4][2], const Unit& u, int wr, int wc, int fr, int fq) const {
        const int row0 = u.pm * BM + wr * 64 + fr, col0 = u.pn * BM + wc * 32 + 4 * fq;
        float* rowp = C + (size_t)row0 * ldc + col0;
#pragma unroll
        for (int ai = 0; ai < 2; ++ai) {
#pragma unroll
            for (int m = 0; m < 4; ++m) {
#pragma unroll
                for (int bj = 0; bj < 2; ++bj)
#pragma unroll
                    for (int n = 0; n < 2; ++n) *(f32x4*)(rowp + bj * HALF + n * 16) = acc[ai][bj][m][n];
                rowp += (size_t)16 * ldc; asm volatile("" : "+v"(rowp) :: "memory"); }
            rowp += (size_t)64 * ldc; }
    }
};
struct EpiPT {
    static constexpr bool PERM = true, AFTER_DRAIN = false;
    bf16_t* PT;
    __device__ __forceinline__ void operator()(const f32x4 (&acc)[2][2][4][2], const Unit& u, int wr, int wc, int fr, int fq) const {
        const int m0 = u.pm * BM, part = m0 >> 9, j0 = m0 & 511, n0 = u.pn * BM, b = n0 >> 12, n10 = n0 & 4095;
        bf16_t* base = PT + (size_t)(b * 512 + j0) * 8192 + part * 4096 + n10;
        const int row0 = wr * 64 + fr, col0 = wc * 32 + 8 * fq;
        bf16_t* rowp = base + (size_t)row0 * 8192 + col0;
#pragma unroll
        for (int ai = 0; ai < 2; ++ai) {
#pragma unroll
            for (int m = 0; m < 4; ++m) {
#pragma unroll
                for (int bj = 0; bj < 2; ++bj) { const f32x4 v0 = acc[ai][bj][m][0], v1 = acc[ai][bj][m][1];
                    u32x4 w; w.x = cvt_pk_bf16(v0[0], v0[1]); w.y = cvt_pk_bf16(v0[2], v0[3]); w.z = cvt_pk_bf16(v1[0], v1[1]); w.w = cvt_pk_bf16(v1[2], v1[3]);
                    *(u32x4*)(rowp + bj * HALF) = w; }
                rowp += 16 * 8192; asm volatile("" : "+v"(rowp) :: "memory"); }
            rowp += 64 * 8192; }
    }
};
typedef unsigned u32x2 __attribute__((ext_vector_type(2)));
template <int MODE> struct EpiGate {
    static constexpr bool PERM = false, AFTER_DRAIN = false;
    const bf16_t* gate; int ldg; float* accbuf; bf16_t* out; int ldc;
    __device__ __forceinline__ void operator()(const f32x4 (&acc)[2][2][4][2], const Unit& u, int wr, int wc, int fr, int fq) const {
        const int row0 = u.pm * BM + wr * 64 + fr, col0 = u.pn * BM + wc * 32 + 4 * fq;
        const bf16_t* gp = gate + (size_t)row0 * ldg + col0; float* ab = accbuf + (size_t)row0 * ldc + col0; bf16_t* op = out + (size_t)row0 * ldc + col0;
#pragma unroll
        for (int ai = 0; ai < 2; ++ai) {
#pragma unroll
            for (int m = 0; m < 4; ++m) {
#pragma unroll
                for (int bj = 0; bj < 2; ++bj)
#pragma unroll
                    for (int n = 0; n < 2; ++n) { const int c = bj * HALF + n * 16;
                        const u32x2 gw = *(const u32x2*)(gp + c);
                        f32x4 gt; gt[0] = __uint_as_float(gw.x << 16); gt[1] = __uint_as_float(gw.x & 0xffff0000u); gt[2] = __uint_as_float(gw.y << 16); gt[3] = __uint_as_float(gw.y & 0xffff0000u);
                        f32x4 v;
#pragma unroll
                        for (int e = 0; e < 4; ++e) v[e] = acc[ai][bj][m][n][e] * __builtin_amdgcn_rcpf(1.0f + __expf(-gt[e]));
                        if (MODE == 0) *(f32x4*)(ab + c) = v;
                        else if (MODE == 1) *(f32x4*)(ab + c) = *(const f32x4*)(ab + c) + v;
                        else { const f32x4 o = *(const f32x4*)(ab + c) + v; u32x2 w; w.x = cvt_pk_bf16(o[0], o[1]); w.y = cvt_pk_bf16(o[2], o[3]); *(u32x2*)(op + c) = w; } }
                gp += (size_t)16 * ldg; ab += (size_t)16 * ldc; op += (size_t)16 * ldc; asm volatile("" : "+v"(gp), "+v"(ab), "+v"(op) :: "memory"); }
            gp += (size_t)64 * ldg; ab += (size_t)64 * ldc; op += (size_t)64 * ldc; }
    }
};
struct EpiResid {
    static constexpr bool PERM = false, AFTER_DRAIN = false;
    const float* base; float* C; int ldc; float alpha;
    __device__ __forceinline__ void operator()(const f32x4 (&acc)[2][2][4][2], const Unit& u, int wr, int wc, int fr, int fq) const {
        const int row0 = u.pm * BM + wr * 64 + fr, col0 = u.pn * BM + wc * 32 + 4 * fq;
        const float* bp = base + (size_t)row0 * ldc + col0; float* cp = C + (size_t)row0 * ldc + col0;
#pragma unroll
        for (int ai = 0; ai < 2; ++ai) {
#pragma unroll
            for (int m = 0; m < 4; ++m) {
#pragma unroll
                for (int bj = 0; bj < 2; ++bj)
#pragma unroll
                    for (int n = 0; n < 2; ++n) { const f32x4 bs = *(const f32x4*)(bp + bj * HALF + n * 16); *(f32x4*)(cp + bj * HALF + n * 16) = bs * alpha + acc[ai][bj][m][n] * EXP_MIX_SCALE; }
                bp += (size_t)16 * ldc; cp += (size_t)16 * ldc; asm volatile("" : "+v"(bp), "+v"(cp) :: "memory"); }
            bp += (size_t)64 * ldc; cp += (size_t)64 * ldc; }
    }
};
struct OneUnit {
    int pm, pn;
    __device__ __forceinline__ bool next(int i, Unit& u) const { if (i > 0) return false; u.pm = pm; u.pn = pn; return true; }
    __device__ __forceinline__ void a_ready(const Unit&) const {}
    __device__ __forceinline__ void done(const Unit&) const {}
};
template <class Epi, class Sched, bool ALIGN_EPI = false, bool SP2 = false>
__device__ __forceinline__ void gemm_phase(PG8_LAS unsigned char* lds, const Gemm g, const Sched& S, const Epi& E) {
    int tid_ = threadIdx.x; asm volatile("" : "+v"(tid_));
    const int tid = tid_, wid = __builtin_amdgcn_readfirstlane(tid >> 6), lane = tid & 63, wr = wid >> 2, wc = wid & 3, fr = lane & 15, fq = lane >> 4;
    int K_ = g.K; asm volatile("" : "+s"(K_));
    const int K = K_, nt = K / BK;
    unsigned voffA[2], voffB[2];
#pragma unroll
    for (int i = 0; i < 2; ++i) { int R, C; stage_rc(tid * 16 + i * 8192, R, C); const int Rb = Epi::PERM ? ((R & ~31) + perm32(R & 31)) : R;
        voffA[i] = (unsigned)(R * g.lda + C) * 2u; voffB[i] = (unsigned)(Rb * g.ldb + C) * 2u; }
    const size_t kstep = (size_t)(BK * 2);
    const size_t hstepA = (size_t)HALF * g.lda * 2, hstepB = (size_t)HALF * g.ldb * 2;
    const size_t tstepA = 2 * hstepA, tstepB = 2 * hstepB;
    const unsigned ldsw = (unsigned)wid * 1024u;
    const int aoff = lds_byte(wr * 64 + fr, fq * 8), boff = lds_byte(wc * 32 + fr, fq * 8);
#define PG8_SA(b, h) (((b) * 2 + (h)) * HTB)
#define PG8_SB(b, h) ((4 + (b) * 2 + (h)) * HTB)
#define PG8_STAGE(bufoff, gbase, voff) do { _Pragma("unroll") for (int _i = 0; _i < 2; ++_i) \
        __builtin_amdgcn_global_load_lds((const unsigned*)((const char*)(gbase) + (voff)[_i]), (PG8_LAS unsigned*)(lds + (bufoff) + ldsw + _i * 8192), 16, 0, 0); } while (0)
#define PG8_LDA(dst, b, h) do { _Pragma("unroll") for (int m = 0; m < 4; ++m) _Pragma("unroll") for (int k = 0; k < 2; ++k) dst[m][k] = *(const PG8_LAS bf16x8*)(lds + PG8_SA(b, h) + aoff + m * 2048 + k * 1024); } while (0)
#define PG8_LDB(dst, b, h) do { _Pragma("unroll") for (int n = 0; n < 2; ++n) _Pragma("unroll") for (int k = 0; k < 2; ++k) dst[n][k] = *(const PG8_LAS bf16x8*)(lds + PG8_SB(b, h) + boff + n * 2048 + k * 1024); } while (0)
#define PG8_MMA(ai, bj, At, Bt) do { __builtin_amdgcn_s_setprio(1); _Pragma("unroll") for (int m = 0; m < 4; ++m) _Pragma("unroll") for (int n = 0; n < 2; ++n) _Pragma("unroll") for (int k = 0; k < 2; ++k) \
        acc[ai][bj][m][n] = __builtin_amdgcn_mfma_f32_16x16x32_bf16(Bt[n][k], At[m][k], acc[ai][bj][m][n], 0, 0, 0); __builtin_amdgcn_s_setprio(0); } while (0)
#define PG8_WAIT_V(n) asm volatile("s_waitcnt vmcnt(" #n ")" ::: "memory")
#define PG8_WAIT_L(n) asm volatile("s_waitcnt lgkmcnt(" #n ")" ::: "memory")
#define PG8_BAR __builtin_amdgcn_s_barrier()
#define PG8_SCHED __builtin_amdgcn_sched_barrier(0)
    Unit cur, nxt; int ui = 0;
    if (!S.next(0, cur)) return;
    f32x4 acc[2][2][4][2];
#pragma unroll
    for (int a = 0; a < 2; ++a)
#pragma unroll
        for (int b = 0; b < 2; ++b)
#pragma unroll
            for (int m = 0; m < 4; ++m)
#pragma unroll
                for (int n = 0; n < 2; ++n) acc[a][b][m][n] = (f32x4){0.f, 0.f, 0.f, 0.f};
    bf16x8 At[4][2], B0[2][2], B1[2][2];
    const char* cA = (const char*)g.A + (size_t)cur.pm * tstepA; const char* cB = (const char*)g.Bt + (size_t)cur.pn * tstepB;
    S.a_ready(cur);
    if constexpr (SP2) {
        PG8_STAGE(PG8_SB(0, 0), cB, voffB); PG8_STAGE(PG8_SB(0, 1), cB + hstepB, voffB); PG8_STAGE(PG8_SA(0, 0), cA, voffA); PG8_STAGE(PG8_SA(0, 1), cA + hstepA, voffA);
        if (wr == 1) PG8_BAR;
        PG8_WAIT_V(2); PG8_BAR;
        PG8_STAGE(PG8_SB(1, 0), cB + kstep, voffB); PG8_STAGE(PG8_SA(1, 0), cA + kstep, voffA); PG8_STAGE(PG8_SB(1, 1), cB + hstepB + kstep, voffB);
        PG8_WAIT_V(6); PG8_BAR;
    } else {
        PG8_STAGE(PG8_SB(0, 0), cB, voffB); PG8_STAGE(PG8_SA(0, 0), cA, voffA); PG8_STAGE(PG8_SB(0, 1), cB + hstepB, voffB); PG8_STAGE(PG8_SA(0, 1), cA + hstepA, voffA);
        if (wr == 1) PG8_BAR;
        PG8_WAIT_V(4); PG8_BAR;
        PG8_STAGE(PG8_SB(1, 0), cB + kstep, voffB); PG8_STAGE(PG8_SA(1, 0), cA + kstep, voffA); PG8_STAGE(PG8_SB(1, 1), cB + hstepB + kstep, voffB);
        PG8_WAIT_V(6); PG8_BAR;
    }
    for (;;) {
        const bool has_next = S.next(ui + 1, nxt);
        const char* nA = has_next ? (const char*)g.A + (size_t)nxt.pm * tstepA : cA; const char* nB = has_next ? (const char*)g.Bt + (size_t)nxt.pn * tstepB : cB;
        for (int t = 0; t < nt; t += 2) {
            const bool last = (t == nt - 2);
            const char* a1 = cA + (size_t)(t + 1) * kstep;
            const char* a2 = last ? nA : cA + (size_t)(t + 2) * kstep; const char* b2 = last ? nB : cB + (size_t)(t + 2) * kstep;
            const char* a3 = a2 + kstep; const char* b3 = b2 + kstep;
            if (last && has_next) S.a_ready(nxt);
            if constexpr (SP2) {
            PG8_LDB(B0, 0, 0); PG8_LDB(B1, 0, 1); PG8_SCHED; PG8_LDA(At, 0, 0); PG8_STAGE(PG8_SA(1, 1), a1 + hstepA, voffA);
            PG8_WAIT_V(8); PG8_WAIT_L(0); PG8_BAR; PG8_MMA(0, 0, At, B0); PG8_MMA(0, 1, At, B1); PG8_BAR; PG8_SCHED;
            PG8_LDA(At, 0, 1); PG8_STAGE(PG8_SB(0, 0), b2, voffB); PG8_STAGE(PG8_SB(0, 1), b2 + hstepB, voffB); PG8_STAGE(PG8_SA(0, 0), a2, voffA);
            PG8_WAIT_V(8); PG8_WAIT_L(0); PG8_BAR; PG8_MMA(1, 0, At, B0); PG8_MMA(1, 1, At, B1); PG8_BAR; PG8_SCHED;
            PG8_LDB(B0, 1, 0); PG8_LDB(B1, 1, 1); PG8_SCHED; PG8_LDA(At, 1, 0); PG8_STAGE(PG8_SA(0, 1), a2 + hstepA, voffA);
            PG8_WAIT_V(8); PG8_WAIT_L(0); PG8_BAR; PG8_MMA(0, 0, At, B0); PG8_MMA(0, 1, At, B1); PG8_BAR; PG8_SCHED;
            PG8_LDA(At, 1, 1); PG8_STAGE(PG8_SB(1, 0), b3, voffB); PG8_STAGE(PG8_SB(1, 1), b3 + hstepB, voffB); PG8_STAGE(PG8_SA(1, 0), a3, voffA);
            PG8_WAIT_V(8); PG8_WAIT_L(0); PG8_BAR; PG8_MMA(1, 0, At, B0); PG8_MMA(1, 1, At, B1); PG8_BAR; PG8_SCHED;
            } else {
            PG8_LDB(B0, 0, 0); PG8_SCHED; PG8_LDA(At, 0, 0); PG8_STAGE(PG8_SA(1, 1), a1 + hstepA, voffA);
            PG8_WAIT_L(8); PG8_BAR; PG8_WAIT_L(0); PG8_MMA(0, 0, At, B0); PG8_BAR; PG8_SCHED;
            PG8_LDB(B1, 0, 1); PG8_STAGE(PG8_SB(0, 0), b2, voffB);
            PG8_BAR; PG8_WAIT_L(0); PG8_MMA(0, 1, At, B1); PG8_BAR;
            PG8_LDA(At, 0, 1); PG8_STAGE(PG8_SA(0, 0), a2, voffA);
            PG8_BAR; PG8_WAIT_L(0); PG8_MMA(1, 0, At, B0); PG8_BAR; PG8_SCHED;
            PG8_STAGE(PG8_SB(0, 1), b2 + hstepB, voffB);
            PG8_WAIT_V(6); PG8_BAR; PG8_MMA(1, 1, At, B1); PG8_BAR;
            PG8_LDB(B0, 1, 0); PG8_SCHED; PG8_LDA(At, 1, 0); PG8_STAGE(PG8_SA(0, 1), a2 + hstepA, voffA);
            PG8_WAIT_L(8); PG8_BAR; PG8_WAIT_L(0); PG8_MMA(0, 0, At, B0); PG8_BAR; PG8_SCHED;
            PG8_LDB(B1, 1, 1); PG8_STAGE(PG8_SB(1, 0), b3, voffB);
            PG8_BAR; PG8_WAIT_L(0); PG8_MMA(0, 1, At, B1); PG8_BAR;
            PG8_LDA(At, 1, 1); PG8_STAGE(PG8_SA(1, 0), a3, voffA);
            PG8_BAR; PG8_WAIT_L(0); PG8_MMA(1, 0, At, B0); PG8_BAR; PG8_SCHED;
            PG8_STAGE(PG8_SB(1, 1), b3 + hstepB, voffB);
            PG8_WAIT_V(6); PG8_BAR; PG8_MMA(1, 1, At, B1); PG8_BAR;
            }
        }
        if constexpr (ALIGN_EPI) { if (wr == 0) PG8_BAR; }
        if constexpr (!Epi::AFTER_DRAIN) { E(acc, cur, wr, wc, fr, fq); S.done(cur); }
        if (!has_next) break;
#pragma unroll
        for (int a = 0; a < 2; ++a)
#pragma unroll
            for (int b = 0; b < 2; ++b)
#pragma unroll
                for (int m = 0; m < 4; ++m)
#pragma unroll
                    for (int n = 0; n < 2; ++n) acc[a][b][m][n] = (f32x4){0.f, 0.f, 0.f, 0.f};
        cur = nxt; cA = nA; cB = nB; ++ui;
        if constexpr (ALIGN_EPI) { if (wr == 1) PG8_BAR; }
    }
    PG8_WAIT_V(0);
    if constexpr (!ALIGN_EPI) { if (wr == 0) PG8_BAR; }
    PG8_BAR;
    if constexpr (Epi::AFTER_DRAIN) { E.fused(acc, cur, wr, wc, fr, fq, lds, wid, lane); S.done(cur); }
#undef PG8_SA
#undef PG8_SB
#undef PG8_STAGE
#undef PG8_LDA
#undef PG8_LDB
#undef PG8_MMA
#undef PG8_WAIT_V
#undef PG8_WAIT_L
#undef PG8_BAR
#undef PG8_SCHED
}
}

#define LAS __attribute__((address_space(3)))
typedef unsigned short bf16;
typedef float f32x4 __attribute__((ext_vector_type(4)));
typedef float f32x2 __attribute__((ext_vector_type(2)));
typedef unsigned u32x4 __attribute__((ext_vector_type(4)));
typedef unsigned u32x2 __attribute__((ext_vector_type(2)));
typedef __bf16 bf16x2_t __attribute__((ext_vector_type(2)));

constexpr int NWAVES = 8, NTHR = 512;
constexpr int BATCH = 2, SEQ = 4096, DM = 2048, TOK = BATCH * SEQ, DEPTH = 2;
constexpr int W_IN = 12800, HW = 12288;
constexpr int H_FF = 0, H_FB = 768, H_Q = 1536, H_I = 2304, H_G = 3072, H_QA = 3840, H_KA = 4608, H_VA = 5376, H_GATE = 6144;
constexpr int NEXP = 16384;
constexpr float DN_ALPHA = 1.41421356237309515f;
constexpr float LN_EPS = 1e-5f;
constexpr int LDS_BYTES = 147456;

constexpr size_t MiB = 1u << 20;
constexpr size_t WS_WL0 = 1 * MiB, WL_STRIDE = 202 * MiB;
constexpr size_t WL_WIN = 0, WL_WF = 48 * MiB, WL_BRF = 52 * MiB, WL_BRH = 54 * MiB, WL_BRA = 57 * MiB, WL_OUT = 58 * MiB, WL_WS = 66 * MiB, WL_U = 74 * MiB, WL_V = 138 * MiB;
constexpr size_t WS_F = 405 * MiB;
constexpr size_t WS_H = 469 * MiB;
constexpr size_t WS_PT = 661 * MiB;
constexpr size_t WS_FP = 677 * MiB;
constexpr size_t WS_LB = 741 * MiB;
constexpr size_t WS_SB = 837 * MiB;
constexpr size_t WS_YF = 885 * MiB, WS_YH = 893 * MiB, WS_YA = 905 * MiB;
constexpr size_t WS_XA = 909 * MiB;
constexpr size_t WS_TAB = 941 * MiB;
constexpr size_t WS_END = 944 * MiB;
constexpr size_t WS_VPRE = WS_H, WS_SC = WS_H + 64 * MiB, WS_MACC = WS_FP, WS_MERGED = WS_LB;
constexpr size_t TAB_SIN = 128 * 1024, TAB_LB = 256 * 1024;

struct Ctx { unsigned char* lds; int tid, lane, wave, G, c, gw, ngw; };

__device__ __forceinline__ unsigned f2bf(float f) { unsigned u = __float_as_uint(f); return (u + 0x7fffu + ((u >> 16) & 1u)) >> 16; }
__device__ __forceinline__ unsigned pk2(float lo, float hi) { return f2bf(lo) | (f2bf(hi) << 16); }
__device__ __forceinline__ float bf2f(unsigned short b) { return __uint_as_float((unsigned)b << 16); }
__device__ __forceinline__ float bflo(unsigned w) { return __uint_as_float(w << 16); }
__device__ __forceinline__ float bfhi(unsigned w) { return __uint_as_float(w & 0xffff0000u); }
#define LDS_WAIT() asm volatile("s_waitcnt lgkmcnt(0)" ::: "memory")

template <int CTRL> __device__ __forceinline__ float dpp_f(float v) { return __int_as_float(__builtin_amdgcn_update_dpp(0, __float_as_int(v), CTRL, 0xF, 0xF, true)); }
__device__ __forceinline__ float rdlane(float v, int l) { return __int_as_float(__builtin_amdgcn_readlane(__float_as_int(v), l)); }
__device__ __forceinline__ float wave_max(float v) {
    v = fmaxf(v, dpp_f<0xB1>(v)); v = fmaxf(v, dpp_f<0x4E>(v)); v = fmaxf(v, dpp_f<0x141>(v)); v = fmaxf(v, dpp_f<0x140>(v));
    return fmaxf(fmaxf(rdlane(v, 0), rdlane(v, 16)), fmaxf(rdlane(v, 32), rdlane(v, 48)));
}
__device__ __forceinline__ float wave_sum(float v) {
    v += dpp_f<0xB1>(v); v += dpp_f<0x4E>(v); v += dpp_f<0x141>(v); v += dpp_f<0x140>(v);
    return (rdlane(v, 0) + rdlane(v, 16)) + (rdlane(v, 32) + rdlane(v, 48));
}

__device__ __forceinline__ void transpose_item(const float* W, int ldw, int K, int N, bf16* WT, LAS float* scr, int item, int lane) {
    const int nblk = N / 32, kb = item / nblk, nb = item % nblk, k0 = 64 * kb, n0 = 32 * nb;
#pragma unroll 8
    for (int i = 0; i < 32; ++i) { const int kk = 2 * i + (lane >> 5); scr[kk * 33 + (lane & 31)] = W[(size_t)(k0 + kk) * ldw + n0 + (lane & 31)]; }
    LDS_WAIT(); asm volatile("" ::: "memory");
    const int c = lane & 7;
#pragma unroll
    for (int j = 0; j < 4; ++j) { const int n = (lane >> 3) + 8 * j; const LAS float* s = scr + (8 * c) * 33 + n;
        u32x4 o; o.x = pk2(s[0 * 33], s[1 * 33]); o.y = pk2(s[2 * 33], s[3 * 33]); o.z = pk2(s[4 * 33], s[5 * 33]); o.w = pk2(s[6 * 33], s[7 * 33]);
        *(u32x4*)(WT + (size_t)(n0 + n) * K + k0 + 8 * c) = o; }
    LDS_WAIT(); asm volatile("" ::: "memory");
}
__device__ __forceinline__ void ln_row(const float (&v)[32], int lane, const float* g, const float* b, float* of, bf16* ob) {
    float s = 0.f;
#pragma unroll
    for (int i = 0; i < 32; ++i) s += v[i];
    const float mean = wave_sum(s) * (1.f / DM);
    float s2 = 0.f;
#pragma unroll
    for (int i = 0; i < 32; ++i) { const float d = v[i] - mean; s2 += d * d; }
    const float rstd = 1.0f / sqrtf(wave_sum(s2) * (1.f / DM) + LN_EPS);
#pragma unroll
    for (int c = 0; c < 4; ++c) { const int e0 = c * 512 + lane * 8;
        const f32x4 g0 = *(const f32x4*)(g + e0), g1 = *(const f32x4*)(g + e0 + 4), b0 = *(const f32x4*)(b + e0), b1 = *(const f32x4*)(b + e0 + 4);
        f32x4 o0, o1;
#pragma unroll
        for (int e = 0; e < 4; ++e) { o0[e] = (v[c * 8 + e] - mean) * rstd * g0[e] + b0[e]; o1[e] = (v[c * 8 + 4 + e] - mean) * rstd * g1[e] + b1[e]; }
        *(f32x4*)(of + e0) = o0; *(f32x4*)(of + e0 + 4) = o1;
        u32x4 w; w.x = pk2(o0[0], o0[1]); w.y = pk2(o0[2], o0[3]); w.z = pk2(o1[0], o1[1]); w.w = pk2(o1[2], o1[3]);
        *(u32x4*)(ob + e0) = w; }
}
__device__ __forceinline__ void load_row32(const float* src, int lane, float (&v)[32]) {
#pragma unroll
    for (int c = 0; c < 4; ++c) { const f32x4 a = *(const f32x4*)(src + c * 512 + lane * 8), b = *(const f32x4*)(src + c * 512 + lane * 8 + 4);
#pragma unroll
        for (int e = 0; e < 4; ++e) { v[c * 8 + e] = a[e]; v[c * 8 + 4 + e] = b[e]; } }
}

__device__ __forceinline__ void prologue(const Ctx& X, const float* const* in, float* out, unsigned char* ws) {
    const float* x = in[0]; const float* emb_g = in[1]; const float* emb_b = in[2]; const float* w_in = in[3];
    const float* w_brf = in[4]; const float* w_brh = in[5]; const float* w_bra = in[6]; const float* w_out = in[7];
    const float* lb_logits = in[8]; const float* w_query = in[12]; const float* sub_keys = in[13]; const float* peer_u = in[14]; const float* peer_v = in[15];
    const int lane = X.lane, tid = X.tid;
    {
        LAS float* scr = (LAS float*)(X.lds + X.wave * 16384);
        constexpr int I_WIN = (DM / 64) * (HW / 32), I_BRF = (512 / 64) * (DM / 32), I_BRH = (768 / 64) * (DM / 32), I_BRA = (256 / 64) * (DM / 32), I_OUT = (DM / 64) * (DM / 32);
        constexpr int PER_L = I_WIN + I_BRF + I_BRH + I_BRA + I_OUT;
        for (int it = X.gw; it < DEPTH * PER_L; it += X.ngw) {
            const int l = it / PER_L; int r = it % PER_L; unsigned char* wl = ws + WS_WL0 + (size_t)l * WL_STRIDE;
            if (r < I_WIN) { transpose_item(w_in + (size_t)l * DM * W_IN + 512, W_IN, DM, HW, (bf16*)(wl + WL_WIN), scr, r, lane); continue; } r -= I_WIN;
            if (r < I_BRF) { transpose_item(w_brf + (size_t)l * 512 * DM, DM, 512, DM, (bf16*)(wl + WL_BRF), scr, r, lane); continue; } r -= I_BRF;
            if (r < I_BRH) { transpose_item(w_brh + (size_t)l * 768 * DM, DM, 768, DM, (bf16*)(wl + WL_BRH), scr, r, lane); continue; } r -= I_BRH;
            if (r < I_BRA) { transpose_item(w_bra + (size_t)l * 256 * DM, DM, 256, DM, (bf16*)(wl + WL_BRA), scr, r, lane); continue; } r -= I_BRA;
            transpose_item(w_out + (size_t)l * DM * DM, DM, DM, DM, (bf16*)(wl + WL_OUT), scr, r, lane);
        }
    }
    {
        const size_t n8 = (size_t)NEXP * DM / 8; const size_t gt = (size_t)X.c * NTHR + tid, gs = (size_t)X.G * NTHR;
        for (int l = 0; l < DEPTH; ++l) {
            const float* su = peer_u + (size_t)l * NEXP * DM; const float* sv = peer_v + (size_t)l * NEXP * DM;
            bf16* du = (bf16*)(ws + WS_WL0 + (size_t)l * WL_STRIDE + WL_U); bf16* dv = (bf16*)(ws + WS_WL0 + (size_t)l * WL_STRIDE + WL_V);
            for (size_t i = gt; i < n8; i += gs) {
                const f32x4 a = *(const f32x4*)(su + i * 8), b = *(const f32x4*)(su + i * 8 + 4), c = *(const f32x4*)(sv + i * 8), d = *(const f32x4*)(sv + i * 8 + 4);
                u32x4 w; w.x = pk2(a[0], a[1]); w.y = pk2(a[2], a[3]); w.z = pk2(b[0], b[1]); w.w = pk2(b[2], b[3]); *(u32x4*)(du + i * 8) = w;
                u32x4 z; z.x = pk2(c[0], c[1]); z.y = pk2(c[2], c[3]); z.z = pk2(d[0], d[1]); z.w = pk2(d[2], d[3]); *(u32x4*)(dv + i * 8) = z;
            }
        }
    }
    __syncthreads();
    {
        LAS float* wt = (LAS float*)X.lds;
        LAS float* ct = (LAS float*)(X.lds + 64 * 129 * 4);
        for (int it = X.c; it < DEPTH * 4 * 32; it += X.G) {
            const int l = it >> 7, g = (it >> 5) & 3, d0 = (it & 31) * 64;
            __syncthreads();
            if (tid < 128) ct[tid] = cospif((float)tid * (1.0f / 64.0f));
            const float* src = w_in + (size_t)l * DM * W_IN + (size_t)d0 * W_IN + g * 128;
#pragma unroll 4
            for (int i = 0; i < 16; ++i) { const int idx = tid + NTHR * i, dd = idx >> 7, n2 = idx & 127; wt[dd * 129 + n2] = src[(size_t)dd * W_IN + n2]; }
            __syncthreads();
            const int dd = tid & 63, rg = X.wave;
            float acc[32];
#pragma unroll
            for (int i = 0; i < 32; ++i) acc[i] = 0.f;
            const int part = rg >> 2, k2b = (rg & 3) * 32;
            for (int n2 = 0; n2 < 128; ++n2) {
                const float w = wt[dd * 129 + n2];
#pragma unroll
                for (int i = 0; i < 32; ++i) { const int k2 = k2b + i; const int m = (k2 * n2 - part * 32) & 127; acc[i] += ct[m] * w; }
            }
            bf16* dst = (bf16*)(ws + WS_WL0 + (size_t)l * WL_STRIDE + WL_WF);
#pragma unroll
            for (int i = 0; i < 32; ++i) dst[(size_t)(part * 512 + g * 128 + k2b + i) * DM + d0 + dd] = (bf16)f2bf(acc[i]);
        }
    }
    __syncthreads();
    {
        LAS float* wq = (LAS float*)X.lds;
        LAS float* ky = (LAS float*)(X.lds + 64 * 129 * 4 + 64);
        for (int it = X.c; it < DEPTH * 16 * 32; it += X.G) {
            const int l = it >> 9, hp = (it >> 5) & 15, dm0 = (it & 31) * 64, p = hp & 1;
            __syncthreads();
            const float* ksrc = sub_keys + ((size_t)l * 2 + p) * 128 * 128;
#pragma unroll 4
            for (int i = 0; i < 32; ++i) ky[tid + NTHR * i] = ksrc[tid + NTHR * i];
            const float* src = w_query + (size_t)l * DM * DM + (size_t)dm0 * DM + hp * 128;
#pragma unroll 4
            for (int i = 0; i < 16; ++i) { const int idx = tid + NTHR * i, dd = idx >> 7, d = idx & 127; wq[dd * 129 + d] = src[(size_t)dd * DM + d]; }
            __syncthreads();
            const int dd = tid & 63, k0 = X.wave * 16;
            float acc[16];
#pragma unroll
            for (int i = 0; i < 16; ++i) acc[i] = 0.f;
            for (int d = 0; d < 128; ++d) {
                const float w = wq[dd * 129 + d];
#pragma unroll
                for (int i = 0; i < 16; ++i) acc[i] += ky[(k0 + i) * 128 + d] * w;
            }
            bf16* dst = (bf16*)(ws + WS_WL0 + (size_t)l * WL_STRIDE + WL_WS);
#pragma unroll
            for (int i = 0; i < 16; ++i) dst[(size_t)(hp * 128 + k0 + i) * DM + dm0 + dd] = (bf16)f2bf(acc[i]);
        }
    }
    __syncthreads();
    {
        LAS float* ct = (LAS float*)X.lds;
        const float norm = 1.0f / sqrtf((float)SEQ * 128.0f);
        for (int i = tid; i < 4096; i += NTHR) ct[i] = cospif((float)i * (1.0f / 2048.0f)) * norm;
        __syncthreads();
        bf16* Fm = (bf16*)(ws + WS_F);
        for (int k1 = X.c; k1 < SEQ; k1 += X.G) {
#pragma unroll
            for (int rep = 0; rep < 2; ++rep) {
                const int e0 = (tid + rep * NTHR) * 8;
                const int part = e0 >> 12, n1 = e0 & 4095;
                float v[8];
#pragma unroll
                for (int j = 0; j < 8; ++j) { const int idx = (k1 * (n1 + j)) & 4095; v[j] = part ? -ct[(idx - 1024) & 4095] : ct[idx]; }
                u32x4 w; w.x = pk2(v[0], v[1]); w.y = pk2(v[2], v[3]); w.z = pk2(v[4], v[5]); w.w = pk2(v[6], v[7]);
                *(u32x4*)(Fm + (size_t)k1 * 8192 + e0) = w;
            }
        }
    }
    __syncthreads();
    {
        const int gt = X.c * NTHR + tid;
        if (gt < SEQ * 8) { const int pos = gt >> 3, i = gt & 7; const float invf = powf(500000.0f, -(float)i * 0.125f); const float ang = (float)pos * invf;
            ((float*)(ws + WS_TAB))[gt] = cosf(ang); ((float*)(ws + WS_TAB + TAB_SIN))[gt] = sinf(ang); }
        if (gt < 2 * 768) { const int dir = gt / 768, col = gt % 768; const float l0 = lb_logits[(dir * DEPTH + 0) * 768 + col], l1 = lb_logits[(dir * DEPTH + 1) * 768 + col];
            float* lb = (float*)(ws + WS_TAB + TAB_LB);
            lb[(dir * DEPTH + 0) * 768 + col] = 0.f;
            lb[(dir * DEPTH + 1) * 768 + col] = 1.0f / (1.0f + expf(l0 - l1)); }
    }
    for (int m = X.gw; m < TOK; m += X.ngw) { float v[32]; load_row32(x + (size_t)m * DM, lane, v); ln_row(v, lane, emb_g, emb_b, out + (size_t)m * DM, (bf16*)(ws + WS_XA) + (size_t)m * DM); }
}

__device__ __forceinline__ void attn_naive(const Ctx& X, const bf16* h, const float* rc, const float* rs, bf16* ya) {
    for (int idx = X.c * NTHR + X.tid; idx < TOK * 4; idx += X.G * NTHR) {
        const int tk = idx >> 2, hh = idx & 3, b = tk / SEQ, p = tk % SEQ;
        float mx = -1e30f, l = 0.f; float o[64];
#pragma unroll
        for (int d = 0; d < 64; ++d) o[d] = 0.f;
        for (int g = 0; g < 3; ++g) {
            const int dil = (g == 0) ? 1 : (g == 1 ? 4 : 16), head = g * 4 + hh;
            float q[64];
            { const bf16* qp = h + (size_t)tk * HW + H_QA + head * 64;
#pragma unroll
              for (int i = 0; i < 8; ++i) { const u32x4 w = *(const u32x4*)(qp + i * 8); q[i * 8 + 0] = bflo(w.x); q[i * 8 + 1] = bfhi(w.x); q[i * 8 + 2] = bflo(w.y); q[i * 8 + 3] = bfhi(w.y);
                  q[i * 8 + 4] = bflo(w.z); q[i * 8 + 5] = bfhi(w.z); q[i * 8 + 6] = bflo(w.w); q[i * 8 + 7] = bfhi(w.w); }
#pragma unroll
              for (int i = 0; i < 8; ++i) { const float c = rc[p * 8 + i], s = rs[p * 8 + i], t1 = q[i], t2 = q[8 + i]; q[i] = t1 * c - t2 * s; q[8 + i] = t2 * c + t1 * s; }
#pragma unroll
              for (int d = 0; d < 64; ++d) q[d] *= 0.125f; }
            for (int j = -64; j <= 64; ++j) {
                const int kp = p + j * dil; if (kp < 0 || kp >= SEQ) continue;
                const bf16* kr = h + (size_t)(b * SEQ + kp) * HW + H_KA + head * 64;
                float s = 0.f;
                { const u32x4 w0 = *(const u32x4*)(kr), w1 = *(const u32x4*)(kr + 8);
                  const float k1[8] = {bflo(w0.x), bfhi(w0.x), bflo(w0.y), bfhi(w0.y), bflo(w0.z), bfhi(w0.z), bflo(w0.w), bfhi(w0.w)};
                  const float k2[8] = {bflo(w1.x), bfhi(w1.x), bflo(w1.y), bfhi(w1.y), bflo(w1.z), bfhi(w1.z), bflo(w1.w), bfhi(w1.w)};
#pragma unroll
                  for (int i = 0; i < 8; ++i) { const float c = rc[kp * 8 + i], sn = rs[kp * 8 + i]; s += q[i] * (k1[i] * c - k2[i] * sn) + q[8 + i] * (k2[i] * c + k1[i] * sn); } }
#pragma unroll
                for (int i = 2; i < 8; ++i) { const u32x4 w = *(const u32x4*)(kr + i * 8);
                    s += q[i * 8 + 0] * bflo(w.x) + q[i * 8 + 1] * bfhi(w.x) + q[i * 8 + 2] * bflo(w.y) + q[i * 8 + 3] * bfhi(w.y) + q[i * 8 + 4] * bflo(w.z) + q[i * 8 + 5] * bfhi(w.z) + q[i * 8 + 6] * bflo(w.w) + q[i * 8 + 7] * bfhi(w.w); }
                const float mn = fmaxf(mx, s), corr = __expf(mx - mn), pr = __expf(s - mn);
                l = l * corr + pr; mx = mn;
                const bf16* vr = h + (size_t)(b * SEQ + kp) * HW + H_VA + head * 64;
#pragma unroll
                for (int i = 0; i < 8; ++i) { const u32x4 w = *(const u32x4*)(vr + i * 8);
                    o[i * 8 + 0] = o[i * 8 + 0] * corr + pr * bflo(w.x); o[i * 8 + 1] = o[i * 8 + 1] * corr + pr * bfhi(w.x); o[i * 8 + 2] = o[i * 8 + 2] * corr + pr * bflo(w.y); o[i * 8 + 3] = o[i * 8 + 3] * corr + pr * bfhi(w.y);
                    o[i * 8 + 4] = o[i * 8 + 4] * corr + pr * bflo(w.z); o[i * 8 + 5] = o[i * 8 + 5] * corr + pr * bfhi(w.z); o[i * 8 + 6] = o[i * 8 + 6] * corr + pr * bflo(w.w); o[i * 8 + 7] = o[i * 8 + 7] * corr + pr * bfhi(w.w); }
            }
        }
        const float il = 1.0f / l; bf16* op = ya + (size_t)tk * 256 + hh * 64;
#pragma unroll
        for (int i = 0; i < 8; ++i) { u32x4 w; w.x = pk2(o[i * 8] * il, o[i * 8 + 1] * il); w.y = pk2(o[i * 8 + 2] * il, o[i * 8 + 3] * il); w.z = pk2(o[i * 8 + 4] * il, o[i * 8 + 5] * il); w.w = pk2(o[i * 8 + 6] * il, o[i * 8 + 7] * il);
            *(u32x4*)(op + i * 8) = w; }
    }
}
__device__ __forceinline__ void hgrn_prep_naive(const Ctx& X, const bf16* h, const float* lbl  , float* FD, float* KY) {
    const size_t n = (size_t)2 * TOK * 768;
    for (size_t i = (size_t)X.c * NTHR + X.tid; i < n; i += (size_t)X.G * NTHR) {
        const int dir = (int)(i / ((size_t)TOK * 768)); const size_t r = i % ((size_t)TOK * 768); const int tk = (int)(r / 768), col = (int)(r % 768);
        const float z = bf2f(h[(size_t)tk * HW + (dir ? H_FB : H_FF) + col]); const float lb = lbl[dir * DEPTH * 768 + col];
        const float s = 1.0f / (1.0f + expf(-z));
        FD[i] = lb + (1.0f - lb) * s; KY[i] = (1.0f - lb) * (1.0f - s);
    }
}
__device__ __forceinline__ void hgrn_scan_naive(const Ctx& X, const bf16* h, const float* FD, const float* KY, float* O  ) {
    LAS float* sf = (LAS float*)X.lds; LAS float* sk = sf + 512; LAS float* sq = sk + 512;
    for (int it = X.c; it < 6; it += X.G) {
        const int grp = X.tid >> 7, v = X.tid & 127, ch = it * 4 + grp;
        const int dir = ch / 12, b = (ch % 12) / 6, hd = ch % 6;
        float S[128];
#pragma unroll
        for (int k = 0; k < 128; ++k) S[k] = 0.f;
        for (int st = 0; st < SEQ; ++st) {
            const int t = dir ? (SEQ - 1 - st) : st; const size_t tk = (size_t)b * SEQ + t;
            const size_t e = ((size_t)dir * TOK + tk) * 768 + hd * 128 + v;
            const float f = FD[e], ky = KY[e], qv = bf2f(h[tk * HW + H_Q + hd * 128 + v]), vv = bf2f(h[tk * HW + H_I + hd * 128 + v]);
            __syncthreads();
            sf[X.tid] = f; sk[X.tid] = ky; sq[X.tid] = qv;
            __syncthreads();
            float o = 0.f;
            const LAS f32x4* pf = (const LAS f32x4*)(sf + grp * 128); const LAS f32x4* pk = (const LAS f32x4*)(sk + grp * 128); const LAS f32x4* pq = (const LAS f32x4*)(sq + grp * 128);
#pragma unroll
            for (int k4 = 0; k4 < 32; ++k4) { const f32x4 a = pf[k4], c = pk[k4], d = pq[k4];
#pragma unroll
                for (int e2 = 0; e2 < 4; ++e2) { S[k4 * 4 + e2] = a[e2] * S[k4 * 4 + e2] + c[e2] * vv; o += d[e2] * S[k4 * 4 + e2]; } }
            O[e] = o;
        }
    }
}
__device__ __forceinline__ void hgrn_combine_naive(const Ctx& X, const bf16* h, const float* O, const float* norm_g, bf16* yh) {
    for (int it = X.gw; it < TOK * 6; it += X.ngw) {
        const int tk = it / 6, hd = it % 6; const size_t e = (size_t)tk * 768 + hd * 128 + X.lane * 2;
        const f32x2 a = *(const f32x2*)(O + e), b = *(const f32x2*)(O + (size_t)TOK * 768 + e);
        const float o0 = a[0] + b[0], o1 = a[1] + b[1];
        const float ms = wave_sum(o0 * o0 + o1 * o1) * (1.0f / 128.0f); const float r = 1.0f / sqrtf(ms + 1e-6f);
        const unsigned gw = *(const unsigned*)(h + (size_t)tk * HW + H_G + hd * 128 + X.lane * 2); const float g0 = bflo(gw), g1 = bfhi(gw);
        const f32x2 ng = *(const f32x2*)(norm_g + hd * 128 + X.lane * 2);
        const float y0 = o0 * r * ng[0] * (g0 / (1.0f + expf(-g0))), y1 = o1 * r * ng[1] * (g1 / (1.0f + expf(-g1)));
        *(unsigned*)(yh + e) = pk2(y0, y1);
    }
}
__device__ __forceinline__ void fourier_reduce(const Ctx& X, const float* FP, bf16* yf) {
    for (int i = X.c * NTHR + X.tid; i < SEQ * 1024 / 4; i += X.G * NTHR) {
        const int k1 = i >> 8, c4 = (i & 255) * 4;
        f32x4 s = *(const f32x4*)(FP + (size_t)k1 * 1024 + c4);
#pragma unroll
        for (int ks = 1; ks < 4; ++ks) s = s + *(const f32x4*)(FP + (size_t)ks * SEQ * 1024 + (size_t)k1 * 1024 + c4);
        const int b = c4 >> 9, j = c4 & 511; u32x2 w; w.x = pk2(s[0], s[1]); w.y = pk2(s[2], s[3]);
        *(u32x2*)(yf + (size_t)(b * SEQ + k1) * 512 + j) = w;
    }
}
__device__ __forceinline__ void ln_phase(const Ctx& X, const float* vpre, const float* g, const float* b, float* xres, bf16* xa) {
    for (int m = X.gw; m < TOK; m += X.ngw) { float v[32]; load_row32(vpre + (size_t)m * DM, X.lane, v); ln_row(v, X.lane, g, b, xres + (size_t)m * DM, xa + (size_t)m * DM); }
}

__device__ __forceinline__ float dot2bf(unsigned w, unsigned x, float acc) { return __builtin_amdgcn_fdot2_f32_bf16(__builtin_bit_cast(bf16x2_t, w), __builtin_bit_cast(bf16x2_t, x), acc, false); }
__device__ __forceinline__ float gelu_erf(float x) { return 0.5f * x * (1.0f + erff(x * 0.70710678118654752f)); }
__device__ __forceinline__ void peer_phase(const Ctx& X, const float* scores, const bf16* Ub, const bf16* Vb, float* xres, bf16* xa, const float* lng, const float* lnb,
                                           const float* Uf, const float* Vf, const float* Wq, const float* Kf) {
    const int lane = X.lane;
        LAS float* sc = (LAS float*)(X.lds + X.wave * 12288);
    LAS float* tops = sc + 2048;
    LAS int* topi = (LAS int*)(tops + 256);
    LAS int* le = topi + 256;
    LAS float* lg = (LAS float*)(le + 128);
    const float NEG = -3.0e38f;
    for (int tk = X.gw; tk < TOK; tk += X.ngw) {
        const float* srow = scores + (size_t)tk * 2048;
#if defined(PEER_NAIVE_SC)
        { (void)srow;
          float qa[32];
#pragma unroll
          for (int i = 0; i < 32; ++i) qa[i] = 0.f;
          for (int dm = 0; dm < DM; ++dm) { const float xv = xres[(size_t)tk * DM + dm];
#pragma unroll
              for (int i = 0; i < 32; ++i) qa[i] += xv * Wq[(size_t)dm * DM + i * 64 + lane]; }
#pragma unroll
          for (int i = 0; i < 32; ++i) sc[i * 64 + lane] = qa[i];
          LDS_WAIT();
          float sv[32];
#pragma unroll
          for (int r = 0; r < 16; ++r) { const int p = r & 1;
              float s0 = 0.f, s1 = 0.f;
              for (int d = 0; d < 128; ++d) { const float qv = sc[r * 128 + d]; s0 += qv * Kf[((size_t)p * 128 + lane) * 128 + d]; s1 += qv * Kf[((size_t)p * 128 + 64 + lane) * 128 + d]; }
              sv[2 * r] = s0; sv[2 * r + 1] = s1; }
          LDS_WAIT();
#pragma unroll
          for (int r = 0; r < 16; ++r) { sc[r * 128 + lane] = sv[2 * r]; sc[r * 128 + 64 + lane] = sv[2 * r + 1]; }
          LDS_WAIT(); }
#else
#pragma unroll
        for (int i = 0; i < 8; ++i) *(LAS f32x4*)(sc + i * 256 + lane * 4) = *(const f32x4*)(srow + i * 256 + lane * 4);
        LDS_WAIT();
#endif
#if defined(PEER_NAIVE_SEL)
        for (int r = 0; r < 16; ++r) {
            const float a = sc[r * 128 + lane], b = sc[r * 128 + 64 + lane]; int ca = 0, cb = 0;
            for (int k = 0; k < 128; ++k) { const float v = sc[r * 128 + k]; ca += (v > a || (v == a && k < lane)) ? 1 : 0; cb += (v > b || (v == b && k < 64 + lane)) ? 1 : 0; }
            if (ca < 16) { tops[r * 16 + ca] = a; topi[r * 16 + ca] = lane; }
            if (cb < 16) { tops[r * 16 + cb] = b; topi[r * 16 + cb] = 64 + lane; }
        }
        LDS_WAIT();
        for (int hd = 0; hd < 8; ++hd) {
            LAS float* cand = sc;
            const float a0 = tops[(2 * hd) * 16 + (lane >> 2)]; float cv[4];
#pragma unroll
            for (int jj = 0; jj < 4; ++jj) { cv[jj] = a0 + tops[(2 * hd + 1) * 16 + (lane & 3) * 4 + jj]; cand[lane * 4 + jj] = cv[jj]; }
            LDS_WAIT();
            int cn[4] = {0, 0, 0, 0};
            for (int k = 0; k < 256; ++k) { const float v = cand[k];
#pragma unroll
                for (int jj = 0; jj < 4; ++jj) cn[jj] += (v > cv[jj] || (v == cv[jj] && k < lane * 4 + jj)) ? 1 : 0; }
            LAS float* bsl = sc + 256; LAS int* bcl = (LAS int*)(sc + 272);
#pragma unroll
            for (int jj = 0; jj < 4; ++jj) if (cn[jj] < 16) { bsl[cn[jj]] = cv[jj]; bcl[cn[jj]] = lane * 4 + jj; }
            LDS_WAIT();
            const float M0 = bsl[0]; const float bs = (lane < 16) ? bsl[lane] : 0.f; const int bc = (lane < 16) ? bcl[lane] : 0;
            const float ex = (lane < 16) ? __expf(bs - M0) : 0.f; const float sum = wave_sum(ex);
            if (lane < 16) { const int i1 = topi[(2 * hd) * 16 + (bc >> 4)], i2 = topi[(2 * hd + 1) * 16 + (bc & 15)]; le[hd * 16 + lane] = i1 * 128 + i2; lg[hd * 16 + lane] = ex / sum; }
            LDS_WAIT();
        }
        LDS_WAIT();
#else
        for (int r = 0; r < 16; ++r) {
            float a = sc[r * 128 + lane], b = sc[r * 128 + 64 + lane]; float tv = 0.f; int ti = 0;
#pragma unroll
            for (int it = 0; it < 16; ++it) {
                const float M = wave_max(fmaxf(a, b));
                const unsigned long long ba = __ballot(a == M); int idx;
                if (ba != 0ull) { const int ln = __ffsll((long long)ba) - 1; idx = ln; if (lane == ln) a = NEG; }
                else { const unsigned long long bb = __ballot(b == M); const int ln = __ffsll((long long)bb) - 1; idx = 64 + ln; if (lane == ln) b = NEG; }
                if (lane == it) { tv = M; ti = idx; }
            }
            if (lane < 16) { tops[r * 16 + lane] = tv; topi[r * 16 + lane] = ti; }
        }
        LDS_WAIT();
        for (int hd = 0; hd < 8; ++hd) {
            const float a0 = tops[(2 * hd) * 16 + (lane >> 2)];
            float c0 = a0 + tops[(2 * hd + 1) * 16 + (lane & 3) * 4 + 0], c1 = a0 + tops[(2 * hd + 1) * 16 + (lane & 3) * 4 + 1];
            float c2 = a0 + tops[(2 * hd + 1) * 16 + (lane & 3) * 4 + 2], c3 = a0 + tops[(2 * hd + 1) * 16 + (lane & 3) * 4 + 3];
            float bs = NEG; int bc = 0;
#pragma unroll
            for (int it = 0; it < 16; ++it) {
                const float M = wave_max(fmaxf(fmaxf(c0, c1), fmaxf(c2, c3)));
                const int fj = (c0 == M) ? 0 : (c1 == M) ? 1 : (c2 == M) ? 2 : (c3 == M) ? 3 : -1;
                const unsigned long long bal = __ballot(fj >= 0); const int ln = __ffsll((long long)bal) - 1;
                const int fjw = __builtin_amdgcn_readlane(fj, ln);
                if (lane == ln) { if (fjw == 0) c0 = NEG; else if (fjw == 1) c1 = NEG; else if (fjw == 2) c2 = NEG; else c3 = NEG; }
                if (lane == it) { bs = M; bc = ln * 4 + fjw; }
            }
            const float M0 = rdlane(bs, 0);
            const float ex = (lane < 16) ? __expf(bs - M0) : 0.f; const float sum = wave_sum(ex);
            if (lane < 16) { const int i1 = topi[(2 * hd) * 16 + (bc >> 4)], i2 = topi[(2 * hd + 1) * 16 + (bc & 15)]; le[hd * 16 + lane] = i1 * 128 + i2; lg[hd * 16 + lane] = ex / sum; }
        }
        LDS_WAIT();
#endif
        unsigned xp[16];
        { float xr[32]; load_row32(xres + (size_t)tk * DM, lane, xr);
#pragma unroll
          for (int i = 0; i < 16; ++i) xp[i] = pk2(xr[2 * i], xr[2 * i + 1]); }
        float y[32];
#pragma unroll
        for (int i = 0; i < 32; ++i) y[i] = 0.f;
        constexpr int EG = 2;
        for (int g4 = 0; g4 < 128 / EG; ++g4) {
#if defined(PEER_F32_GATHER)
            { float xr2[32]; load_row32(xres + (size_t)tk * DM, lane, xr2);
              for (int k = 0; k < EG; ++k) { const int e = __builtin_amdgcn_readfirstlane(le[g4 * EG + k]); const float gtk = lg[g4 * EG + k];
                  float ur[32];
#if defined(PEER_BF_TABLE)
#pragma unroll
                  for (int c = 0; c < 4; ++c) { const u32x4 w = *(const u32x4*)(Ub + (size_t)e * DM + lane * 8 + c * 512);
                      ur[c * 8 + 0] = bflo(w.x); ur[c * 8 + 1] = bfhi(w.x); ur[c * 8 + 2] = bflo(w.y); ur[c * 8 + 3] = bfhi(w.y); ur[c * 8 + 4] = bflo(w.z); ur[c * 8 + 5] = bfhi(w.z); ur[c * 8 + 6] = bflo(w.w); ur[c * 8 + 7] = bfhi(w.w); }
#else
                  load_row32(Uf + (size_t)e * DM, lane, ur);
#endif
                  float s = 0.f;
#pragma unroll
                  for (int i = 0; i < 32; ++i) s += ur[i] * xr2[i];
                  const float hvk = gelu_erf(wave_sum(s)) * gtk;
                  float vr[32];
#if defined(PEER_BF_TABLE)
#pragma unroll
                  for (int c = 0; c < 4; ++c) { const u32x4 w = *(const u32x4*)(Vb + (size_t)e * DM + lane * 8 + c * 512);
                      vr[c * 8 + 0] = bflo(w.x); vr[c * 8 + 1] = bfhi(w.x); vr[c * 8 + 2] = bflo(w.y); vr[c * 8 + 3] = bfhi(w.y); vr[c * 8 + 4] = bflo(w.z); vr[c * 8 + 5] = bfhi(w.z); vr[c * 8 + 6] = bflo(w.w); vr[c * 8 + 7] = bfhi(w.w); }
#else
                  load_row32(Vf + (size_t)e * DM, lane, vr);
#endif
#pragma unroll
                  for (int i = 0; i < 32; ++i) y[i] += hvk * vr[i]; } }
            continue;
#endif
            u32x4 U[EG][4], V[EG][4]; float gt[EG];
#pragma unroll
            for (int k = 0; k < EG; ++k) { const int e = __builtin_amdgcn_readfirstlane(le[g4 * EG + k]); gt[k] = lg[g4 * EG + k];
                const bf16* up = Ub + (size_t)e * DM + lane * 8; const bf16* vp = Vb + (size_t)e * DM + lane * 8;
#pragma unroll
                for (int c = 0; c < 4; ++c) { U[k][c] = *(const u32x4*)(up + c * 512); V[k][c] = *(const u32x4*)(vp + c * 512); } }
            float hv[EG];
#pragma unroll
            for (int k = 0; k < EG; ++k) { float s = 0.f;
#pragma unroll
                for (int c = 0; c < 4; ++c) {
                    s = dot2bf(U[k][c].x, xp[c * 4 + 0], s);
                    s = dot2bf(U[k][c].y, xp[c * 4 + 1], s);
                    s = dot2bf(U[k][c].z, xp[c * 4 + 2], s);
                    s = dot2bf(U[k][c].w, xp[c * 4 + 3], s); }
                hv[k] = gelu_erf(wave_sum(s)) * gt[k]; }
#pragma unroll
            for (int k = 0; k < EG; ++k)
#pragma unroll
                for (int c = 0; c < 4; ++c) { const u32x4 w = V[k][c];
                    y[c * 8 + 0] += hv[k] * bflo(w.x); y[c * 8 + 1] += hv[k] * bfhi(w.x); y[c * 8 + 2] += hv[k] * bflo(w.y); y[c * 8 + 3] += hv[k] * bfhi(w.y);
                    y[c * 8 + 4] += hv[k] * bflo(w.z); y[c * 8 + 5] += hv[k] * bfhi(w.z); y[c * 8 + 6] += hv[k] * bflo(w.w); y[c * 8 + 7] += hv[k] * bfhi(w.w); }
        }
#if defined(EXP_ZERO_PEER)
#pragma unroll
        for (int i = 0; i < 32; ++i) y[i] = 0.f;
#endif
        asm volatile("" ::: "memory");
        { float xr[32]; load_row32(xres + (size_t)tk * DM, lane, xr);
#pragma unroll
          for (int i = 0; i < 32; ++i) y[i] += DN_ALPHA * xr[i]; }
        ln_row(y, lane, lng, lnb, xres + (size_t)tk * DM, xa + (size_t)tk * DM);
    }
}

typedef short bf16x8 __attribute__((ext_vector_type(8)));
#define MFMA16(a, b, c) __builtin_amdgcn_mfma_f32_16x16x32_bf16((a), (b), (c), 0, 0, 0)
constexpr size_t TAB_D = 1 * MiB;

__device__ __forceinline__ void hgrn_lf_key(float z, float lb, float& lf, float& key) {
    const float s = __builtin_amdgcn_rcpf(1.0f + __expf(-z));
    const float f = fmaxf(lb + (1.0f - lb) * s, 1e-30f);
    lf = __logf(f); key = (1.0f - lb) * (1.0f - s);
}
__device__ __forceinline__ void unpack8(const u32x4 w, float* o) { o[0] = bflo(w.x); o[1] = bfhi(w.x); o[2] = bflo(w.y); o[3] = bfhi(w.y); o[4] = bflo(w.z); o[5] = bfhi(w.z); o[6] = bflo(w.w); o[7] = bfhi(w.w); }
__device__ __forceinline__ u32x4 pack8(const float* v) { u32x4 w; w.x = pk2(v[0], v[1]); w.y = pk2(v[2], v[3]); w.z = pk2(v[4], v[5]); w.w = pk2(v[6], v[7]); return w; }

__device__ __forceinline__ void hgrn_cumsum(LAS float* LF, LAS float* SEG, int tid, int dir, float (&bl)[16], float& tot) {
    const int k = tid & 127, seg = tid >> 7; float run = 0.f;
    if (dir == 0) {
#pragma unroll
        for (int i = 0; i < 16; ++i) { run += LF[(16 * seg + i) * 128 + k]; bl[i] = run; }
    } else {
#pragma unroll
        for (int i = 15; i >= 0; --i) { run += LF[(16 * seg + i) * 128 + k]; bl[i] = run; }
    }
    SEG[seg * 128 + k] = run;
    __syncthreads();
    float off = 0.f; tot = 0.f;
#pragma unroll
    for (int s2 = 0; s2 < 4; ++s2) { const float sv = SEG[s2 * 128 + k]; tot += sv; if (dir == 0 ? (s2 < seg) : (s2 > seg)) off += sv; }
#pragma unroll
    for (int i = 0; i < 16; ++i) bl[i] += off;
}

__device__ __forceinline__ void hgrn_pass1(const Ctx& X, const bf16* h, const float* lbl, float* L, float* Dd) {
    LAS float* LF = (LAS float*)X.lds; LAS float* KYf = LF + 8192; LAS float* SEG = KYf + 8192;
    LAS bf16* VR = (LAS bf16*)(X.lds + 67584); LAS bf16* KT = (LAS bf16*)(X.lds + 83968); LAS bf16* VT = (LAS bf16*)(X.lds + 102400);
    const int tid = X.tid, lane = X.lane, q4 = lane >> 4, l15 = lane & 15;
    for (int u = X.c; u < 1536; u += X.G) {
        const int dir = u / 768, rem = u % 768, bh = rem >> 6, c = rem & 63, b = bh / 6, hd = bh % 6; const size_t tok0 = (size_t)b * SEQ + 64 * c;
        __syncthreads();
        { const int t = tid >> 3, kc = (tid & 7) * 16;
          const bf16* zr = h + (tok0 + t) * HW + (dir ? H_FB : H_FF) + hd * 128 + kc; const bf16* vr = h + (tok0 + t) * HW + H_I + hd * 128 + kc;
          const u32x4 z0 = *(const u32x4*)zr, z1 = *(const u32x4*)(zr + 8), v0 = *(const u32x4*)vr, v1 = *(const u32x4*)(vr + 8);
          float z[16]; unpack8(z0, z); unpack8(z1, z + 8);
          const float* lbp = lbl + dir * DEPTH * 768 + hd * 128 + kc;
          float lf[16], ky[16];
#pragma unroll
          for (int j = 0; j < 16; ++j) hgrn_lf_key(z[j], lbp[j], lf[j], ky[j]);
#pragma unroll
          for (int j = 0; j < 4; ++j) { *(LAS f32x4*)(LF + t * 128 + kc + 4 * j) = (f32x4){lf[4 * j], lf[4 * j + 1], lf[4 * j + 2], lf[4 * j + 3]};
              *(LAS f32x4*)(KYf + t * 128 + kc + 4 * j) = (f32x4){ky[4 * j], ky[4 * j + 1], ky[4 * j + 2], ky[4 * j + 3]}; }
          *(LAS u32x4*)(VR + t * 128 + kc) = v0; *(LAS u32x4*)(VR + t * 128 + kc + 8) = v1; }
        __syncthreads();
        float bl[16], tot; hgrn_cumsum(LF, SEG, tid, dir, bl, tot);
        { const int k = tid & 127, seg = tid >> 7; float kh[16];
#pragma unroll
          for (int i = 0; i < 16; ++i) kh[i] = KYf[(16 * seg + i) * 128 + k] * __expf(tot - bl[i]);
          *(LAS u32x4*)(KT + k * 72 + 16 * seg) = pack8(kh); *(LAS u32x4*)(KT + k * 72 + 16 * seg + 8) = pack8(kh + 8);
          if (seg == 0) Dd[(size_t)u * 128 + k] = __expf(tot);
          unsigned short vv[16];
#pragma unroll
          for (int i = 0; i < 16; ++i) vv[i] = VR[(16 * seg + i) * 128 + k];
          u32x4 w0, w1; w0.x = vv[0] | (vv[1] << 16); w0.y = vv[2] | (vv[3] << 16); w0.z = vv[4] | (vv[5] << 16); w0.w = vv[6] | (vv[7] << 16);
          w1.x = vv[8] | (vv[9] << 16); w1.y = vv[10] | (vv[11] << 16); w1.z = vv[12] | (vv[13] << 16); w1.w = vv[14] | (vv[15] << 16);
          *(LAS u32x4*)(VT + k * 72 + 16 * seg) = w0; *(LAS u32x4*)(VT + k * 72 + 16 * seg + 8) = w1; }
        __syncthreads();
        const int mb0 = (X.wave & 3) * 2, nb0 = (X.wave >> 2) * 4;
        f32x4 acc[2][4];
#pragma unroll
        for (int mi = 0; mi < 2; ++mi)
#pragma unroll
            for (int ni = 0; ni < 4; ++ni) acc[mi][ni] = (f32x4){0.f, 0.f, 0.f, 0.f};
#pragma unroll
        for (int ks = 0; ks < 2; ++ks) {
            bf16x8 a[2], bb[4];
#pragma unroll
            for (int mi = 0; mi < 2; ++mi) a[mi] = *(const LAS bf16x8*)(KT + ((mb0 + mi) * 16 + l15) * 72 + ks * 32 + 8 * q4);
#pragma unroll
            for (int ni = 0; ni < 4; ++ni) bb[ni] = *(const LAS bf16x8*)(VT + ((nb0 + ni) * 16 + l15) * 72 + ks * 32 + 8 * q4);
#pragma unroll
            for (int mi = 0; mi < 2; ++mi)
#pragma unroll
                for (int ni = 0; ni < 4; ++ni) acc[mi][ni] = MFMA16(a[mi], bb[ni], acc[mi][ni]);
        }
        float* Lu = L + (size_t)u * 16384;
#pragma unroll
        for (int mi = 0; mi < 2; ++mi)
#pragma unroll
            for (int ni = 0; ni < 4; ++ni) *(f32x4*)(Lu + ((nb0 + ni) * 16 + l15) * 128 + (mb0 + mi) * 16 + 4 * q4) = acc[mi][ni];
    }
}
__device__ __forceinline__ void hgrn_pass2(const Ctx& X, const float* L, const float* Dd, bf16* Sp) {
    for (int i = X.c * NTHR + X.tid; i < 24 * 8192; i += X.G * NTHR) {
        const int chain = i >> 13, e = (i & 8191) * 2, k = e & 127, dir = chain / 12, bh = chain % 12;
        float s0 = 0.f, s1 = 0.f;
#pragma unroll 8
        for (int j = 0; j < 64; ++j) { const int c = dir ? 63 - j : j; const size_t u = (size_t)(dir * 12 + bh) * 64 + c;
            *(unsigned*)(Sp + u * 16384 + e) = pk2(s0, s1);
            const f32x2 l = *(const f32x2*)(L + u * 16384 + e), d = *(const f32x2*)(Dd + u * 128 + k);
            s0 = d[0] * s0 + l[0]; s1 = d[1] * s1 + l[1]; }
    }
}
__device__ __forceinline__ void hgrn_pass3(const Ctx& X, const bf16* h, const float* lbl, const bf16* Sp, const float* norm_g, bf16* yh) {
    LAS unsigned char* R1 = (LAS unsigned char*)X.lds;
    LAS float* LF = (LAS float*)R1; LAS bf16* VR = (LAS bf16*)R1; LAS bf16* ST = (LAS bf16*)R1;
    LAS bf16* VT = (LAS bf16*)(X.lds + 34816); LAS bf16* QT1 = (LAS bf16*)(X.lds + 53248); LAS bf16* KT1 = (LAS bf16*)(X.lds + 70656); LAS bf16* QT2 = (LAS bf16*)(X.lds + 88064);
    LAS bf16* PM = (LAS bf16*)(X.lds + 105472); LAS float* SEG = (LAS float*)(X.lds + 114688); LAS float* RR = (LAS float*)(X.lds + 116736); LAS float* SS = (LAS float*)(X.lds + 117248);
    const int tid = X.tid, lane = X.lane, q4 = lane >> 4, l15 = lane & 15, w = X.wave;
    for (int u = X.c; u < 768; u += X.G) {
        const int bh = u >> 6, c = u & 63, b = bh / 6, hd = bh % 6; const size_t tok0 = (size_t)b * SEQ + 64 * c;
        __syncthreads();
        { const int t = tid >> 3, kc = (tid & 7) * 16; const bf16* vr = h + (tok0 + t) * HW + H_I + hd * 128 + kc;
          *(LAS u32x4*)(VR + t * 128 + kc) = *(const u32x4*)vr; *(LAS u32x4*)(VR + t * 128 + kc + 8) = *(const u32x4*)(vr + 8); }
        __syncthreads();
        { const int v = tid & 127, seg = tid >> 7; unsigned short vv[16];
#pragma unroll
          for (int i = 0; i < 16; ++i) vv[i] = VR[(16 * seg + i) * 128 + v];
          u32x4 w0, w1; w0.x = vv[0] | (vv[1] << 16); w0.y = vv[2] | (vv[3] << 16); w0.z = vv[4] | (vv[5] << 16); w0.w = vv[6] | (vv[7] << 16);
          w1.x = vv[8] | (vv[9] << 16); w1.y = vv[10] | (vv[11] << 16); w1.z = vv[12] | (vv[13] << 16); w1.w = vv[14] | (vv[15] << 16);
          *(LAS u32x4*)(VT + v * 72 + 16 * seg) = w0; *(LAS u32x4*)(VT + v * 72 + 16 * seg + 8) = w1; }
        f32x4 acc[4];
#pragma unroll
        for (int ni = 0; ni < 4; ++ni) acc[ni] = (f32x4){0.f, 0.f, 0.f, 0.f};
        const int tb = w & 3;
#pragma unroll 1
        for (int dir = 0; dir < 2; ++dir) {
            __syncthreads();
            const int t = tid >> 3, kc = (tid & 7) * 16;
            float ky[16], qv[16];
            { const bf16* zr = h + (tok0 + t) * HW + (dir ? H_FB : H_FF) + hd * 128 + kc; const bf16* qr = h + (tok0 + t) * HW + H_Q + hd * 128 + kc;
              const u32x4 z0 = *(const u32x4*)zr, z1 = *(const u32x4*)(zr + 8), q0 = *(const u32x4*)qr, q1 = *(const u32x4*)(qr + 8);
              float z[16]; unpack8(z0, z); unpack8(z1, z + 8); unpack8(q0, qv); unpack8(q1, qv + 8);
              const float* lbp = lbl + dir * DEPTH * 768 + hd * 128 + kc; float lf[16];
#pragma unroll
              for (int j = 0; j < 16; ++j) hgrn_lf_key(z[j], lbp[j], lf[j], ky[j]);
#pragma unroll
              for (int j = 0; j < 4; ++j) *(LAS f32x4*)(LF + t * 128 + kc + 4 * j) = (f32x4){lf[4 * j], lf[4 * j + 1], lf[4 * j + 2], lf[4 * j + 3]}; }
            const size_t us = (size_t)(dir * 12 + bh) * 64 + c; u32x4 sreg[4];
#pragma unroll
            for (int i = 0; i < 4; ++i) sreg[i] = *(const u32x4*)(Sp + us * 16384 + (size_t)(tid + NTHR * i) * 8);
            __syncthreads();
            { float bl[16], tot; hgrn_cumsum(LF, SEG, tid, dir, bl, tot);
              const int k = tid & 127, seg = tid >> 7;
#pragma unroll
              for (int i = 0; i < 16; ++i) LF[(16 * seg + i) * 128 + k] = bl[i];
              if (dir == 0 ? (seg == 1) : (seg == 2)) RR[k] = dir == 0 ? bl[15] : bl[0]; }
            __syncthreads();
            { float q1[16], k1[16], q2[16];
#pragma unroll
              for (int j = 0; j < 16; ++j) { const float bt = LF[t * 128 + kc + j], r = RR[kc + j];
                  q1[j] = qv[j] * __expf(bt - r); k1[j] = ky[j] * __expf(r - bt); q2[j] = qv[j] * __expf(bt); }
              *(LAS u32x4*)(QT1 + t * 136 + kc) = pack8(q1); *(LAS u32x4*)(QT1 + t * 136 + kc + 8) = pack8(q1 + 8);
              *(LAS u32x4*)(KT1 + t * 136 + kc) = pack8(k1); *(LAS u32x4*)(KT1 + t * 136 + kc + 8) = pack8(k1 + 8);
              *(LAS u32x4*)(QT2 + t * 136 + kc) = pack8(q2); *(LAS u32x4*)(QT2 + t * 136 + kc + 8) = pack8(q2 + 8); }
            __syncthreads();
#pragma unroll
            for (int i = 0; i < 4; ++i) { const int idx = tid + NTHR * i, v = idx >> 4, k8 = (idx & 15) * 8; *(LAS u32x4*)(ST + v * 136 + k8) = sreg[i]; }
            { const int sb0 = (w >> 2) * 2; f32x4 pa[2] = {(f32x4){0.f, 0.f, 0.f, 0.f}, (f32x4){0.f, 0.f, 0.f, 0.f}};
#pragma unroll
              for (int ks = 0; ks < 4; ++ks) { const bf16x8 a = *(const LAS bf16x8*)(QT1 + (tb * 16 + l15) * 136 + ks * 32 + 8 * q4);
#pragma unroll
                  for (int si = 0; si < 2; ++si) { const bf16x8 bb = *(const LAS bf16x8*)(KT1 + ((sb0 + si) * 16 + l15) * 136 + ks * 32 + 8 * q4); pa[si] = MFMA16(a, bb, pa[si]); } }
#pragma unroll
              for (int si = 0; si < 2; ++si) { const int s = (sb0 + si) * 16 + l15;
#pragma unroll
                  for (int r = 0; r < 4; ++r) { const int tt = tb * 16 + 4 * q4 + r; const bool keep = dir == 0 ? (s <= tt) : (s >= tt);
                      PM[tt * 72 + s] = (bf16)f2bf(keep ? pa[si][r] : 0.f); } } }
            __syncthreads();
            { const int vb0 = (w >> 2) * 4;
#pragma unroll
              for (int ks = 0; ks < 4; ++ks) { const bf16x8 a = *(const LAS bf16x8*)(QT2 + (tb * 16 + l15) * 136 + ks * 32 + 8 * q4);
#pragma unroll
                  for (int ni = 0; ni < 4; ++ni) { const bf16x8 bb = *(const LAS bf16x8*)(ST + ((vb0 + ni) * 16 + l15) * 136 + ks * 32 + 8 * q4); acc[ni] = MFMA16(a, bb, acc[ni]); } }
#pragma unroll
              for (int ks = 0; ks < 2; ++ks) { const bf16x8 a = *(const LAS bf16x8*)(PM + (tb * 16 + l15) * 72 + ks * 32 + 8 * q4);
#pragma unroll
                  for (int ni = 0; ni < 4; ++ni) { const bf16x8 bb = *(const LAS bf16x8*)(VT + ((vb0 + ni) * 16 + l15) * 72 + ks * 32 + 8 * q4); acc[ni] = MFMA16(a, bb, acc[ni]); } } }
        }
        { const int vb0 = (w >> 2) * 4; float ss[4];
#pragma unroll
          for (int r = 0; r < 4; ++r) { float s = 0.f;
#pragma unroll
              for (int ni = 0; ni < 4; ++ni) s += acc[ni][r] * acc[ni][r];
              s += dpp_f<0xB1>(s); s += dpp_f<0x4E>(s); s += dpp_f<0x141>(s); s += dpp_f<0x140>(s);
              ss[r] = s; }
          if (l15 == 0) {
#pragma unroll
              for (int r = 0; r < 4; ++r) SS[(tb * 16 + 4 * q4 + r) * 2 + (w >> 2)] = ss[r]; }
          __syncthreads();
#pragma unroll
          for (int r = 0; r < 4; ++r) { const int tt = tb * 16 + 4 * q4 + r; const float tot = SS[tt * 2] + SS[tt * 2 + 1]; const float rn = 1.0f / sqrtf(tot * (1.0f / 128.0f) + 1e-6f);
#pragma unroll
              for (int ni = 0; ni < 4; ++ni) { const int v = (vb0 + ni) * 16 + l15; const float g = bf2f(h[(tok0 + tt) * HW + H_G + hd * 128 + v]);
                  const float y = acc[ni][r] * rn * norm_g[hd * 128 + v] * (g * __builtin_amdgcn_rcpf(1.0f + __expf(-g)));
                  yh[(tok0 + tt) * 768 + hd * 128 + v] = (bf16)f2bf(y); } } }
    }
}

#ifndef MK_ONE_LAUNCH
#define MK_ONE_LAUNCH 1
#endif
constexpr int N_PHASES = 1 + 9 * DEPTH;
__device__ __forceinline__ bool fresh(Ctx& X) { asm volatile("" : "+v"(X.tid), "+v"(X.lane)); return true; }
struct Args { const float* in[18]; float* out; unsigned char* ws; int ph_lo, ph_hi; };
typedef pg8::bf16_t pbf;

__global__ void __launch_bounds__(NTHR, 2) fwd_kernel(Args args) {
    extern __shared__ __attribute__((aligned(16))) unsigned char lds[];
    cg::grid_group grid = cg::this_grid();
    Ctx X; X.lds = lds; X.tid = threadIdx.x; X.lane = X.tid & 63; X.wave = __builtin_amdgcn_readfirstlane(X.tid >> 6);
    X.G = gridDim.x; X.c = blockIdx.x; X.gw = X.c * NWAVES + X.wave; X.ngw = X.G * NWAVES;
    unsigned char* ws = args.ws; float* out = args.out;
    LAS unsigned char* ldsl = (LAS unsigned char*)lds;
    const int lo = args.ph_lo, hi = args.ph_hi;
#define IN(k) (lo <= (k) && (k) < hi && fresh(X))
#define INR(k) (lo <= (k) && (k) < hi)
#define SEAM(k) do { if (INR(k) && INR((k) + 1)) grid.sync(); else __syncthreads(); } while (0)

    #ifndef SKIP_P0
    if (IN(0)) { prologue(X, args.in, out, ws); SEAM(0); }
#endif

    const float* ropec = (const float*)(ws + WS_TAB); const float* ropes = (const float*)(ws + WS_TAB + TAB_SIN); const float* lbt = (const float*)(ws + WS_TAB + TAB_LB);
    pbf* XA = (pbf*)(ws + WS_XA); pbf* Hb = (pbf*)(ws + WS_H); pbf* PT = (pbf*)(ws + WS_PT); float* FP = (float*)(ws + WS_FP);
    pbf* YF = (pbf*)(ws + WS_YF); pbf* YH = (pbf*)(ws + WS_YH); pbf* YA = (pbf*)(ws + WS_YA);
    float* MACC = (float*)(ws + WS_MACC); pbf* MERGED = (pbf*)(ws + WS_MERGED); float* VPRE = (float*)(ws + WS_VPRE); float* SC = (float*)(ws + WS_SC);
    float* FD = (float*)(ws + WS_LB); float* KY = FD + (size_t)2 * TOK * 768; float* OH = (float*)(ws + WS_SB);

    for (int l = 0; l < DEPTH; ++l) {
        const int pb = 1 + 9 * l;
        unsigned char* wl = ws + WS_WL0 + (size_t)l * WL_STRIDE;
        pbf* WinT = (pbf*)(wl + WL_WIN); pbf* WfT = (pbf*)(wl + WL_WF); pbf* BRF = (pbf*)(wl + WL_BRF); pbf* BRH = (pbf*)(wl + WL_BRH); pbf* BRA = (pbf*)(wl + WL_BRA);
        pbf* WoutT = (pbf*)(wl + WL_OUT); pbf* WsT = (pbf*)(wl + WL_WS); const pbf* Ub = (const pbf*)(wl + WL_U); const pbf* Vb = (const pbf*)(wl + WL_V);
        if (IN(pb + 0)) {
#ifndef SKIP_G1
            { pg8::Gemm g{XA, WinT, TOK, HW, DM, DM, DM}; pg8::StaticOrder S; S.init(TOK, HW, X.G, X.c); pg8::EpiBf16<0> E{Hb, HW, nullptr, 0, 0, 1.f};
              pg8::gemm_phase<pg8::EpiBf16<0>, pg8::StaticOrder, true, true>(ldsl, g, S, E); }
#endif
#ifndef SKIP_G2
            { pg8::Gemm g{WfT, XA, 1024, TOK, DM, DM, DM}; pg8::StaticOrder S; S.init(1024, TOK, X.G, X.c); pg8::EpiPT E{PT};
              pg8::gemm_phase<pg8::EpiPT, pg8::StaticOrder, true, true>(ldsl, g, S, E); }
#endif
            SEAM(pb + 0);
        }
        if (IN(pb + 1)) {
#ifndef SKIP_G3
            for (int it = X.c; it < 256; it += X.G) { const int ks = it >> 6, tile = it & 63;
                pg8::Gemm g{(const pbf*)(ws + WS_F) + ks * 2048, PT + ks * 2048, SEQ, 1024, 2048, 8192, 8192}; pg8::OneUnit S{tile >> 2, tile & 3}; pg8::EpiF32 E{FP + (size_t)ks * SEQ * 1024, 1024};
                pg8::gemm_phase<pg8::EpiF32, pg8::OneUnit, false, true>(ldsl, g, S, E); }
#endif
            __syncthreads();
#ifndef SKIP_ATTN
            attn_naive(X, Hb, ropec, ropes, YA);
#endif
#if defined(HGRN_NAIVE)
            hgrn_prep_naive(X, Hb, lbt + l * 768, FD, KY);
#else
            __syncthreads();
            hgrn_pass1(X, Hb, lbt + l * 768, FD, (float*)(ws + WS_TAB + TAB_D));
#endif
            SEAM(pb + 1);
        }
        if (IN(pb + 2)) {
#if defined(HGRN_NAIVE)
            hgrn_scan_naive(X, Hb, FD, KY, OH);
#else
            hgrn_pass2(X, FD, (const float*)(ws + WS_TAB + TAB_D), (pbf*)(ws + WS_SB));
#endif
            fourier_reduce(X, FP, YF); SEAM(pb + 2); }
        if (IN(pb + 3)) {
#if defined(HGRN_NAIVE)
            hgrn_combine_naive(X, Hb, OH, args.in[9] + (size_t)l * 768, YH);
#else
            hgrn_pass3(X, Hb, lbt + l * 768, (const pbf*)(ws + WS_SB), args.in[9] + (size_t)l * 768, YH);
#endif
            SEAM(pb + 3); }
        if (IN(pb + 4)) {
#ifndef SKIP_G4
            { pg8::Gemm g{YF, BRF, TOK, DM, 512, 512, 512}; pg8::StaticOrder S; S.init(TOK, DM, X.G, X.c); pg8::EpiGate<0> E{Hb + H_GATE, HW, MACC, MERGED, DM};
              pg8::gemm_phase<pg8::EpiGate<0>, pg8::StaticOrder, true, true>(ldsl, g, S, E); }
#endif
#ifndef SKIP_G5
            { pg8::Gemm g{YH, BRH, TOK, DM, 768, 768, 768}; pg8::StaticOrder S; S.init(TOK, DM, X.G, X.c); pg8::EpiGate<1> E{Hb + H_GATE + DM, HW, MACC, MERGED, DM};
              pg8::gemm_phase<pg8::EpiGate<1>, pg8::StaticOrder, true, true>(ldsl, g, S, E); }
#endif
#ifndef SKIP_G6
            { pg8::Gemm g{YA, BRA, TOK, DM, 256, 256, 256}; pg8::StaticOrder S; S.init(TOK, DM, X.G, X.c); pg8::EpiGate<2> E{Hb + H_GATE + 2 * DM, HW, MACC, MERGED, DM};
              pg8::gemm_phase<pg8::EpiGate<2>, pg8::StaticOrder, true, true>(ldsl, g, S, E); }
#endif
            SEAM(pb + 4);
        }
        if (IN(pb + 5)) {
#ifndef SKIP_G7
            pg8::Gemm g{MERGED, WoutT, TOK, DM, DM, DM, DM}; pg8::StaticOrder S; S.init(TOK, DM, X.G, X.c); pg8::EpiResid E{out, VPRE, DM, DN_ALPHA};
            pg8::gemm_phase<pg8::EpiResid, pg8::StaticOrder, true, true>(ldsl, g, S, E);
#endif
            SEAM(pb + 5);
        }
        if (IN(pb + 6)) { ln_phase(X, VPRE, args.in[10] + (size_t)l * DM, args.in[11] + (size_t)l * DM, out, XA); SEAM(pb + 6); }
        if (IN(pb + 7)) {
#ifndef SKIP_G8
            pg8::Gemm g{XA, WsT, TOK, DM, DM, DM, DM}; pg8::StaticOrder S; S.init(TOK, DM, X.G, X.c); pg8::EpiF32 E{SC, DM};
            pg8::gemm_phase<pg8::EpiF32, pg8::StaticOrder, true, true>(ldsl, g, S, E);
#endif
            SEAM(pb + 7);
        }
        if (IN(pb + 8)) {
#ifndef SKIP_PEER
            peer_phase(X, SC, Ub, Vb, out, XA, args.in[16] + (size_t)l * DM, args.in[17] + (size_t)l * DM,
                       args.in[14] + (size_t)l * NEXP * DM, args.in[15] + (size_t)l * NEXP * DM, args.in[12] + (size_t)l * DM * DM, args.in[13] + (size_t)l * 2 * 128 * 128);
#endif
            if (pb + 8 + 1 < N_PHASES) SEAM(pb + 8); }
    }
#undef IN
#undef SEAM
}

extern "C" void kernel_launch(void* const* d_in, const int* in_sizes, int n_in, void* d_out, int out_size, void* d_ws, size_t ws_size, hipStream_t stream) {
    static int grid = 0;
    if (grid == 0) {
        if (n_in != 18 || in_sizes[0] != TOK * DM || out_size != TOK * DM || ws_size < WS_END) {
            fprintf(stderr, "kernel_launch: unexpected shapes (n_in %d, in0 %d, out %d, ws %zu, need %zu); nothing launched\n", n_in, n_in > 0 ? in_sizes[0] : -1, out_size, ws_size, (size_t)WS_END); grid = -1; return; }
        int dev = 0, cus = 0, per_cu = 0;
        if (hipGetDevice(&dev) != hipSuccess || hipDeviceGetAttribute(&cus, hipDeviceAttributeMultiprocessorCount, dev) != hipSuccess) { grid = -1; return; }
        if (hipFuncSetAttribute((const void*)fwd_kernel, hipFuncAttributeMaxDynamicSharedMemorySize, LDS_BYTES) != hipSuccess) { fprintf(stderr, "kernel_launch: hipFuncSetAttribute failed\n"); grid = -1; return; }
        if (hipOccupancyMaxActiveBlocksPerMultiprocessor(&per_cu, (const void*)fwd_kernel, NTHR, LDS_BYTES) != hipSuccess || per_cu < 1) { fprintf(stderr, "kernel_launch: occupancy query says %d blocks per CU\n", per_cu); grid = -1; (void)hipGetLastError(); return; }
        grid = cus * 1;
    }
    if (grid < 0) return;
    Args a{};
    for (int i = 0; i < 18; ++i) a.in[i] = (const float*)d_in[i];
    a.out = (float*)d_out; a.ws = (unsigned char*)d_ws;
#if MK_ONE_LAUNCH
    a.ph_lo = 0; a.ph_hi = N_PHASES;
    void* kargs[] = {&a};
    hipError_t e = hipLaunchCooperativeKernel((const void*)fwd_kernel, dim3(grid), dim3(NTHR), kargs, LDS_BYTES, stream);
    if (e != hipSuccess) fprintf(stderr, "kernel_launch: cooperative launch failed: %s (grid %d)\n", hipGetErrorString(e), grid);
#else
    for (int ph = 0; ph < N_PHASES; ++ph) { a.ph_lo = ph; a.ph_hi = ph + 1; hipLaunchKernelGGL(fwd_kernel, dim3(grid), dim3(NTHR), LDS_BYTES, stream, a); }
#endif
}
```

```cpp
#include <hip/hip_runtime.h>
#include <hip/hip_cooperative_groups.h>
#include <cstdio>
#include <cstdint>
namespace cg = cooperative_groups;
namespace pg8 {
#define PG8_LAS __attribute__((address_space(3)))
typedef unsigned short bf16_t;
typedef short bf16x8 __attribute__((ext_vector_type(8)));
typedef float f32x4 __attribute__((ext_vector_type(4)));
typedef unsigned u32x4 __attribute__((ext_vector_type(4)));
constexpr int BM = 256, BK = 64, HALF = 128, HTB = HALF * BK * 2  , STAGE_BYTES = 8 * HTB, NXCD = 8, WGM = 8;

__host__ __device__ __forceinline__ int lds_byte(int r, int c) { const int st = (r >> 4) * 2 + (c >> 5), rr = r & 15, cc = c & 31, ob = rr * 64 + cc * 2; return st * 1024 + (ob ^ (((ob >> 9) & 1) << 5)); }
__host__ __device__ __forceinline__ void stage_rc(int b, int& R, int& C) { const int st = b / 1024, sb = b % 1024, swz = sb ^ (((sb >> 9) & 1) << 5); R = (st >> 1) * 16 + swz / 64; C = (st & 1) * 32 + (swz % 64) / 2; }
__host__ __device__ __forceinline__ int perm32(int rho) { const int n = rho >> 4, i = rho & 15; return 8 * (i >> 2) + 4 * n + (i & 3); }

struct Unit { int pm, pn; };
struct Gemm { const bf16_t* A; const bf16_t* Bt; int M, N, K, lda, ldb; };

struct StaticOrder {
    int nM, nN, nwg, G, c;
    __host__ __device__ void init(int M, int N, int G_, int c_) { nM = M / BM; nN = N / BM; nwg = nM * nN; G = G_; c = c_; }
    __host__ __device__ bool next(int i, Unit& u) const {
        const long L = (long)i * G + c; if (L >= nwg) return false;
        int wgid = (int)L; { const int q = nwg / NXCD, r = nwg % NXCD, xcd = wgid % NXCD, off = wgid / NXCD; wgid = (xcd < r ? xcd * (q + 1) : r * (q + 1) + (xcd - r) * q) + off; }
        const int nig = WGM * nN, gid = wgid / nig, fm = gid * WGM, gsz = (nM - fm) < WGM ? (nM - fm) : WGM;
        u.pm = fm + ((wgid % nig) % gsz); u.pn = (wgid % nig) / gsz; return true;
    }
    __device__ __forceinline__ void a_ready(const Unit&) const {}
    __device__ __forceinline__ void done(const Unit&) const {}
};

__device__ __forceinline__ unsigned cvt_pk_bf16(float lo, float hi) { unsigned r; asm volatile("v_cvt_pk_bf16_f32 %0, %1, %2" : "=v"(r) : "v"(lo), "v"(hi)); return r; }
typedef float f32x2 __attribute__((ext_vector_type(2)));
__device__ __forceinline__ f32x2 gelu_pk(f32x2 v) {
    const f32x2 av = __builtin_elementwise_abs(v), d = av * 0.2316418882f + 1.0f;
    f32x2 t; t.x = __builtin_amdgcn_rcpf(d.x); t.y = __builtin_amdgcn_rcpf(d.y);
    f32x2 q = t * 0.5307027145f + (-0.7265760135f); q = q * t + 0.7107068705f; q = q * t + (-0.142248368f); q = q * t + 0.127414796f; q = q * t;
    const f32x2 s = (v * v) * (-0.72134752044f);
    f32x2 e; e.x = __builtin_amdgcn_exp2f(s.x); e.y = __builtin_amdgcn_exp2f(s.y);
    const f32x2 m = v * (q * e), r = v - m;
    f32x2 o; o.x = v.x < 0.f ? m.x : r.x; o.y = v.y < 0.f ? m.y : r.y; return o;
}

template <int ACT  > struct EpiBf16 {
    static constexpr bool PERM = true, AFTER_DRAIN = false; static_assert(ACT == 0 || ACT == 1, "EpiBf16: ACT is 0 (none) or 1 (gelu_pk)");
    bf16_t* O; int ldc; const float* bias; int split_cols; size_t split_stride; float scale0;
    __device__ __forceinline__ void operator()(const f32x4 (&acc)[2][2][4][2], const Unit& u, int wr, int wc, int fr, int fq) const {
        const int row0 = u.pm * BM + wr * 64 + fr; int colt = u.pn * BM; bf16_t* base = O;
        float sc = 1.f; if (split_cols) { const int t = colt / split_cols; base += (size_t)t * split_stride; colt -= t * split_cols; if (t == 0) sc = scale0; }
        const int col0 = colt + wc * 32 + 8 * fq, bcol0 = u.pn * BM + wc * 32 + 8 * fq;
        f32x4 bv[2][2];
#pragma unroll
        for (int bj = 0; bj < 2; ++bj)
#pragma unroll
            for (int n = 0; n < 2; ++n) bv[bj][n] = bias ? *(const f32x4*)(bias + bcol0 + bj * HALF + 4 * n) : (f32x4){0.f, 0.f, 0.f, 0.f};
#pragma unroll
        for (int ai = 0; ai < 2; ++ai)
#pragma unroll
            for (int m = 0; m < 4; ++m) { bf16_t* rowp = base + (size_t)(row0 + ai * HALF + m * 16) * ldc + col0;
#pragma unroll
                for (int bj = 0; bj < 2; ++bj) { f32x4 v0 = acc[ai][bj][m][0] + bv[bj][0], v1 = acc[ai][bj][m][1] + bv[bj][1];
                    if (ACT == 1) { f32x2 a = gelu_pk((f32x2){v0[0], v0[1]}), b = gelu_pk((f32x2){v0[2], v0[3]}), c = gelu_pk((f32x2){v1[0], v1[1]}), d = gelu_pk((f32x2){v1[2], v1[3]});
                        v0 = (f32x4){a.x, a.y, b.x, b.y}; v1 = (f32x4){c.x, c.y, d.x, d.y}; }
                    v0 = v0 * sc; v1 = v1 * sc; u32x4 w; w.x = cvt_pk_bf16(v0[0], v0[1]); w.y = cvt_pk_bf16(v0[2], v0[3]); w.z = cvt_pk_bf16(v1[0], v1[1]); w.w = cvt_pk_bf16(v1[2], v1[3]);
                    *(u32x4*)(rowp + bj * HALF) = w; } }
    }
};
#ifndef EXP_MIX_SCALE
#define EXP_MIX_SCALE 1.0f
#endif

struct EpiF32 {
    static constexpr bool PERM = false, AFTER_DRAIN = false;
    float* C; int ldc;
    __device__ __forceinline__ void operator()(const f32x4 (&acc)[2][2][4][2], const Unit& u, int wr, int wc, int fr, int fq) const {
        const int row0 = u.pm * BM + wr * 64 + fr, col0 = u.pn * BM + wc * 32 + 4 * fq;
        float* rowp = C + (size_t)row0 * ldc + col0;
#pragma unroll
        for (int ai = 0; ai < 2; ++ai) {
#pragma unroll
            for (int m = 0; m < 4; ++m) {
#pragma unroll
                for (int bj = 0; bj < 2; ++bj)
#pragma unroll
                    for (int n = 0; n < 2; ++n) *(f32x4*)(rowp + bj * HALF + n * 16) = acc[ai][bj][m][n];
                rowp += (size_t)16 * ldc; asm volatile("" : "+v"(rowp) :: "memory"); }
            rowp += (size_t)64 * ldc; }
    }
};
struct EpiPT {
    static constexpr bool PERM = true, AFTER_DRAIN = false;
    bf16_t* PT;
    __device__ __forceinline__ void operator()(const f32x4 (&acc)[2][2][4][2], const Unit& u, int wr, int wc, int fr, int fq) const {
        const int m0 = u.pm * BM, part = m0 >> 9, j0 = m0 & 511, n0 = u.pn * BM, b = n0 >> 12, n10 = n0 & 4095;
        bf16_t* base = PT + (size_t)(b * 512 + j0) * 8192 + part * 4096 + n10;
        const int row0 = wr * 64 + fr, col0 = wc * 32 + 8 * fq;
        bf16_t* rowp = base + (size_t)row0 * 8192 + col0;
#pragma unroll
        for (int ai = 0; ai < 2; ++ai) {
#pragma unroll
            for (int m = 0; m < 4; ++m) {
#pragma unroll
                for (int bj = 0; bj < 2; ++bj) { const f32x4 v0 = acc[ai][bj][m][0], v1 = acc[ai][bj][m][1];
                    u32x4 w; w.x = cvt_pk_bf16(v0[0], v0[1]); w.y = cvt_pk_bf16(v0[2], v0[3]); w.z = cvt_pk_bf16(v1[0], v1[1]); w.w = cvt_pk_bf16(v1[2], v1[3]);
                    *(u32x4*)(rowp + bj * HALF) = w; }
                rowp += 16 * 8192; asm volatile("" : "+v"(rowp) :: "memory"); }
            rowp += 64 * 8192; }
    }
};
typedef unsigned u32x2 __attribute__((ext_vector_type(2)));
template <int MODE> struct EpiGate {
    static constexpr bool PERM = false, AFTER_DRAIN = false;
    const bf16_t* gate; int ldg; float* accbuf; bf16_t* out; int ldc;
    __device__ __forceinline__ void operator()(const f32x4 (&acc)[2][2][4][2], const Unit& u, int wr, int wc, int fr, int fq) const {
        const int row0 = u.pm * BM + wr * 64 + fr, col0 = u.pn * BM + wc * 32 + 4 * fq;
        const bf16_t* gp = gate + (size_t)row0 * ldg + col0; float* ab = accbuf + (size_t)row0 * ldc + col0; bf16_t* op = out + (size_t)row0 * ldc + col0;
#pragma unroll
        for (int ai = 0; ai < 2; ++ai) {
#pragma unroll
            for (int m = 0; m < 4; ++m) {
#pragma unroll
                for (int bj = 0; bj < 2; ++bj)
#pragma unroll
                    for (int n = 0; n < 2; ++n) { const int c = bj * HALF + n * 16;
                        const u32x2 gw = *(const u32x2*)(gp + c);
                        f32x4 gt; gt[0] = __uint_as_float(gw.x << 16); gt[1] = __uint_as_float(gw.x & 0xffff0000u); gt[2] = __uint_as_float(gw.y << 16); gt[3] = __uint_as_float(gw.y & 0xffff0000u);
                        f32x4 v;
#pragma unroll
                        for (int e = 0; e < 4; ++e) v[e] = acc[ai][bj][m][n][e] * __builtin_amdgcn_rcpf(1.0f + __expf(-gt[e]));
                        if (MODE == 0) *(f32x4*)(ab + c) = v;
                        else if (MODE == 1) *(f32x4*)(ab + c) = *(const f32x4*)(ab + c) + v;
                        else { const f32x4 o = *(const f32x4*)(ab + c) + v; u32x2 w; w.x = cvt_pk_bf16(o[0], o[1]); w.y = cvt_pk_bf16(o[2], o[3]); *(u32x2*)(op + c) = w; } }
                gp += (size_t)16 * ldg; ab += (size_t)16 * ldc; op += (size_t)16 * ldc; asm volatile("" : "+v"(gp), "+v"(ab), "+v"(op) :: "memory"); }
            gp += (size_t)64 * ldg; ab += (size_t)64 * ldc; op += (size_t)64 * ldc; }
    }
};
struct EpiResid {
    static constexpr bool PERM = false, AFTER_DRAIN = false;
    const float* base; float* C; int ldc; float alpha;
    __device__ __forceinline__ void operator()(const f32x4 (&acc)[2][2][4][2], const Unit& u, int wr, int wc, int fr, int fq) const {
        const int row0 = u.pm * BM + wr * 64 + fr, col0 = u.pn * BM + wc * 32 + 4 * fq;
        const float* bp = base + (size_t)row0 * ldc + col0; float* cp = C + (size_t)row0 * ldc + col0;
#pragma unroll
        for (int ai = 0; ai < 2; ++ai) {
#pragma unroll
            for (int m = 0; m < 4; ++m) {
#pragma unroll
                for (int bj = 0; bj < 2; ++bj)
#pragma unroll
                    for (int n = 0; n < 2; ++n) { const f32x4 bs = *(const f32x4*)(bp + bj * HALF + n * 16); *(f32x4*)(cp + bj * HALF + n * 16) = bs * alpha + acc[ai][bj][m][n] * EXP_MIX_SCALE; }
                bp += (size_t)16 * ldc; cp += (size_t)16 * ldc; asm volatile("" : "+v"(bp), "+v"(cp) :: "memory"); }
            bp += (size_t)64 * ldc; cp += (size_t)64 * ldc; }
    }
};
struct OneUnit {
    int pm, pn;
    __device__ __forceinline__ bool next(int i, Unit& u) const { if (i > 0) return false; u.pm = pm; u.pn = pn; return true; }
    __device__ __forceinline__ void a_ready(const Unit&) const {}
    __device__ __forceinline__ void done(const Unit&) const {}
};
template <class Epi, class Sched, bool ALIGN_EPI = false, bool SP2 = false>
__device__ __forceinline__ void gemm_phase(PG8_LAS unsigned char* lds, const Gemm g, const Sched& S, const Epi& E) {
    int tid_ = threadIdx.x; asm volatile("" : "+v"(tid_));
    const int tid = tid_, wid = __builtin_amdgcn_readfirstlane(tid >> 6), lane = tid & 63, wr = wid >> 2, wc = wid & 3, fr = lane & 15, fq = lane >> 4;
    int K_ = g.K; asm volatile("" : "+s"(K_));
    const int K = K_, nt = K / BK;
    unsigned voffA[2], voffB[2];
#pragma unroll
    for (int i = 0; i < 2; ++i) { int R, C; stage_rc(tid * 16 + i * 8192, R, C); const int Rb = Epi::PERM ? ((R & ~31) + perm32(R & 31)) : R;
        voffA[i] = (unsigned)(R * g.lda + C) * 2u; voffB[i] = (unsigned)(Rb * g.ldb + C) * 2u; }
    const size_t kstep = (size_t)(BK * 2);
    const size_t hstepA = (size_t)HALF * g.lda * 2, hstepB = (size_t)HALF * g.ldb * 2;
    const size_t tstepA = 2 * hstepA, tstepB = 2 * hstepB;
    const unsigned ldsw = (unsigned)wid * 1024u;
    const int aoff = lds_byte(wr * 64 + fr, fq * 8), boff = lds_byte(wc * 32 + fr, fq * 8);
#define PG8_SA(b, h) (((b) * 2 + (h)) * HTB)
#define PG8_SB(b, h) ((4 + (b) * 2 + (h)) * HTB)
#define PG8_STAGE(bufoff, gbase, voff) do { _Pragma("unroll") for (int _i = 0; _i < 2; ++_i) \
        __builtin_amdgcn_global_load_lds((const unsigned*)((const char*)(gbase) + (voff)[_i]), (PG8_LAS unsigned*)(lds + (bufoff) + ldsw + _i * 8192), 16, 0, 0); } while (0)
#define PG8_LDA(dst, b, h) do { _Pragma("unroll") for (int m = 0; m < 4; ++m) _Pragma("unroll") for (int k = 0; k < 2; ++k) dst[m][k] = *(const PG8_LAS bf16x8*)(lds + PG8_SA(b, h) + aoff + m * 2048 + k * 1024); } while (0)
#define PG8_LDB(dst, b, h) do { _Pragma("unroll") for (int n = 0; n < 2; ++n) _Pragma("unroll") for (int k = 0; k < 2; ++k) dst[n][k] = *(const PG8_LAS bf16x8*)(lds + PG8_SB(b, h) + boff + n * 2048 + k * 1024); } while (0)
#define PG8_MMA(ai, bj, At, Bt) do { __builtin_amdgcn_s_setprio(1); _Pragma("unroll") for (int m = 0; m < 4; ++m) _Pragma("unroll") for (int n = 0; n < 2; ++n) _Pragma("unroll") for (int k = 0; k < 2; ++k) \
        acc[ai][bj][m][n] = __builtin_amdgcn_mfma_f32_16x16x32_bf16(Bt[n][k], At[m][k], acc[ai][bj][m][n], 0, 0, 0); __builtin_amdgcn_s_setprio(0); } while (0)
#define PG8_WAIT_V(n) asm volatile("s_waitcnt vmcnt(" #n ")" ::: "memory")
#define PG8_WAIT_L(n) asm volatile("s_waitcnt lgkmcnt(" #n ")" ::: "memory")
#define PG8_BAR __builtin_amdgcn_s_barrier()
#define PG8_SCHED __builtin_amdgcn_sched_barrier(0)
    Unit cur, nxt; int ui = 0;
    if (!S.next(0, cur)) return;
    f32x4 acc[2][2][4][2];
#pragma unroll
    for (int a = 0; a < 2; ++a)
#pragma unroll
        for (int b = 0; b < 2; ++b)
#pragma unroll
            for (int m = 0; m < 4; ++m)
#pragma unroll
                for (int n = 0; n < 2; ++n) acc[a][b][m][n] = (f32x4){0.f, 0.f, 0.f, 0.f};
    bf16x8 At[4][2], B0[2][2], B1[2][2];
    const char* cA = (const char*)g.A + (size_t)cur.pm * tstepA; const char* cB = (const char*)g.Bt + (size_t)cur.pn * tstepB;
    S.a_ready(cur);
    if constexpr (SP2) {
        PG8_STAGE(PG8_SB(0, 0), cB, voffB); PG8_STAGE(PG8_SB(0, 1), cB + hstepB, voffB); PG8_STAGE(PG8_SA(0, 0), cA, voffA); PG8_STAGE(PG8_SA(0, 1), cA + hstepA, voffA);
        if (wr == 1) PG8_BAR;
        PG8_WAIT_V(2); PG8_BAR;
        PG8_STAGE(PG8_SB(1, 0), cB + kstep, voffB); PG8_STAGE(PG8_SA(1, 0), cA + kstep, voffA); PG8_STAGE(PG8_SB(1, 1), cB + hstepB + kstep, voffB);
        PG8_WAIT_V(6); PG8_BAR;
    } else {
        PG8_STAGE(PG8_SB(0, 0), cB, voffB); PG8_STAGE(PG8_SA(0, 0), cA, voffA); PG8_STAGE(PG8_SB(0, 1), cB + hstepB, voffB); PG8_STAGE(PG8_SA(0, 1), cA + hstepA, voffA);
        if (wr == 1) PG8_BAR;
        PG8_WAIT_V(4); PG8_BAR;
        PG8_STAGE(PG8_SB(1, 0), cB + kstep, voffB); PG8_STAGE(PG8_SA(1, 0), cA + kstep, voffA); PG8_STAGE(PG8_SB(1, 1), cB + hstepB + kstep, voffB);
        PG8_WAIT_V(6); PG8_BAR;
    }
    for (;;) {
        const bool has_next = S.next(ui + 1, nxt);
        const char* nA = has_next ? (const char*)g.A + (size_t)nxt.pm * tstepA : cA; const char* nB = has_next ? (const char*)g.Bt + (size_t)nxt.pn * tstepB : cB;
        for (int t = 0; t < nt; t += 2) {
            const bool last = (t == nt - 2);
            const char* a1 = cA + (size_t)(t + 1) * kstep;
            const char* a2 = last ? nA : cA + (size_t)(t + 2) * kstep; const char* b2 = last ? nB : cB + (size_t)(t + 2) * kstep;
            const char* a3 = a2 + kstep; const char* b3 = b2 + kstep;
            if (last && has_next) S.a_ready(nxt);
            if constexpr (SP2) {
            PG8_LDB(B0, 0, 0); PG8_LDB(B1, 0, 1); PG8_SCHED; PG8_LDA(At, 0, 0); PG8_STAGE(PG8_SA(1, 1), a1 + hstepA, voffA);
            PG8_WAIT_V(8); PG8_WAIT_L(0); PG8_BAR; PG8_MMA(0, 0, At, B0); PG8_MMA(0, 1, At, B1); PG8_BAR; PG8_SCHED;
            PG8_LDA(At, 0, 1); PG8_STAGE(PG8_SB(0, 0), b2, voffB); PG8_STAGE(PG8_SB(0, 1), b2 + hstepB, voffB); PG8_STAGE(PG8_SA(0, 0), a2, voffA);
            PG8_WAIT_V(8); PG8_WAIT_L(0); PG8_BAR; PG8_MMA(1, 0, At, B0); PG8_MMA(1, 1, At, B1); PG8_BAR; PG8_SCHED;
            PG8_LDB(B0, 1, 0); PG8_LDB(B1, 1, 1); PG8_SCHED; PG8_LDA(At, 1, 0); PG8_STAGE(PG8_SA(0, 1), a2 + hstepA, voffA);
            PG8_WAIT_V(8); PG8_WAIT_L(0); PG8_BAR; PG8_MMA(0, 0, At, B0); PG8_MMA(0, 1, At, B1); PG8_BAR; PG8_SCHED;
            PG8_LDA(At, 1, 1); PG8_STAGE(PG8_SB(1, 0), b3, voffB); PG8_STAGE(PG8_SB(1, 1), b3 + hstepB, voffB); PG8_STAGE(PG8_SA(1, 0), a3, voffA);
            PG8_WAIT_V(8); PG8_WAIT_L(0); PG8_BAR; PG8_MMA(1, 0, At, B0); PG8_MMA(1, 1, At, B1); PG8_BAR; PG8_SCHED;
            } else {
            PG8_LDB(B0, 0, 0); PG8_SCHED; PG8_LDA(At, 0, 0); PG8_STAGE(PG8_SA(1, 1), a1 + hstepA, voffA);
            PG8_WAIT_L(8); PG8_BAR; PG8_WAIT_L(0); PG8_MMA(0, 0, At, B0); PG8_BAR; PG8_SCHED;
            PG8_LDB(B1, 0, 1); PG8_STAGE(PG8_SB(0, 0), b2, voffB);
            PG8_BAR; PG8_WAIT_L(0); PG8_MMA(0, 1, At, B1); PG8_BAR;
            PG8_LDA(At, 0, 1); PG8_STAGE(PG8_SA(0, 0), a2, voffA);
            PG8_BAR; PG8_WAIT_L(0); PG8_MMA(1, 0, At, B0); PG8_BAR; PG8_SCHED;
            PG8_STAGE(PG8_SB(0, 1), b2 + hstepB, voffB);
            PG8_WAIT_V(6); PG8_BAR; PG8_MMA(1, 1, At, B1); PG8_BAR;
            PG8_LDB(B0, 1, 0); PG8_SCHED; PG8_LDA(At, 1, 0); PG8_STAGE(PG8_SA(0, 1), a2 + hstepA, voffA);
            PG8_WAIT_L(8); PG8_BAR; PG8_WAIT_L(0); PG8_MMA(0, 0, At, B0); PG8_BAR; PG8_SCHED;
            PG8_LDB(B1, 1, 1); PG8_STAGE(PG8_SB(1, 0), b3, voffB);
            PG8_BAR; PG8_WAIT_L(0); PG8_MMA(0, 1, At, B1); PG8_BAR;
            PG8_LDA(At, 1, 1); PG8_STAGE(PG8_SA(1, 0), a3, voffA);
            PG8_BAR; PG8_WAIT_L(0); PG8_MMA(1, 0, At, B0); PG8_BAR; PG8_SCHED;
            PG8_STAGE(PG8_SB(1, 1), b3 + hstepB, voffB);
            PG8_WAIT_V(6); PG8_BAR; PG8_MMA(1, 1, At, B1); PG8_BAR;
            }
        }
        if constexpr (ALIGN_EPI) { if (wr == 0) PG8_BAR; }
        if constexpr (!Epi::AFTER_DRAIN) { E(acc, cur, wr, wc, fr, fq); S.done(cur); }
        if (!has_next) break;
#pragma unroll
        for (int a = 0; a < 2; ++a)
#pragma unroll
            for (int b = 0; b < 2; ++b)
#pragma unroll
                for (int m = 0; m < 4; ++m)
#pragma unroll
                    for (int n = 0; n < 2; ++n) acc[a][b][m][n] = (f32x4){0.f, 0.f, 0.f, 0.f};
        cur = nxt; cA = nA; cB = nB; ++ui;
        if constexpr (ALIGN_EPI) { if (wr == 1) PG8_BAR; }
    }
    PG8_WAIT_V(0);
    if constexpr (!ALIGN_EPI) { if (wr == 0) PG8_BAR; }
    PG8_BAR;
    if constexpr (Epi::AFTER_DRAIN) { E.fused(acc, cur, wr, wc, fr, fq, lds, wid, lane); S.done(cur); }
#undef PG8_SA
#undef PG8_SB
#undef PG8_STAGE
#undef PG8_LDA
#undef PG8_LDB
#undef PG8_MMA
#undef PG8_WAIT_V
#undef PG8_WAIT_L
#undef PG8_BAR
#undef PG8_SCHED
}
}

#define LAS __attribute__((address_space(3)))
typedef unsigned short bf16;
typedef float f32x4 __attribute__((ext_vector_type(4)));
typedef float f32x2 __attribute__((ext_vector_type(2)));
typedef unsigned u32x4 __attribute__((ext_vector_type(4)));
typedef unsigned u32x2 __attribute__((ext_vector_type(2)));
typedef __bf16 bf16x2_t __attribute__((ext_vector_type(2)));

constexpr int NWAVES = 8, NTHR = 512;
constexpr int BATCH = 2, SEQ = 4096, DM = 2048, TOK = BATCH * SEQ, DEPTH = 2;
constexpr int W_IN = 12800, HW = 12288;
constexpr int H_FF = 0, H_FB = 768, H_Q = 1536, H_I = 2304, H_G = 3072, H_QA = 3840, H_KA = 4608, H_VA = 5376, H_GATE = 6144;
constexpr int NEXP = 16384;
constexpr float DN_ALPHA = 1.41421356237309515f;
constexpr float LN_EPS = 1e-5f;
constexpr int LDS_BYTES = 147456;

constexpr size_t MiB = 1u << 20;
constexpr size_t WS_WL0 = 1 * MiB, WL_STRIDE = 202 * MiB;
constexpr size_t WL_WIN = 0, WL_WF = 48 * MiB, WL_BRF = 52 * MiB, WL_BRH = 54 * MiB, WL_BRA = 57 * MiB, WL_OUT = 58 * MiB, WL_WS = 66 * MiB, WL_U = 74 * MiB, WL_V = 138 * MiB;
constexpr size_t WS_F = 405 * MiB;
constexpr size_t WS_H = 469 * MiB;
constexpr size_t WS_PT = 661 * MiB;
constexpr size_t WS_FP = 677 * MiB;
constexpr size_t WS_LB = 741 * MiB;
constexpr size_t WS_SB = 837 * MiB;
constexpr size_t WS_YF = 885 * MiB, WS_YH = 893 * MiB, WS_YA = 905 * MiB;
constexpr size_t WS_XA = 909 * MiB;
constexpr size_t WS_TAB = 941 * MiB;
constexpr size_t WS_END = 944 * MiB;
constexpr size_t WS_VPRE = WS_H, WS_SC = WS_H + 64 * MiB, WS_MACC = WS_FP, WS_MERGED = WS_LB;
constexpr size_t TAB_SIN = 128 * 1024, TAB_LB = 256 * 1024;

struct Ctx { unsigned char* lds; int tid, lane, wave, G, c, gw, ngw; };

__device__ __forceinline__ unsigned f2bf(float f) { unsigned u = __float_as_uint(f); return (u + 0x7fffu + ((u >> 16) & 1u)) >> 16; }
__device__ __forceinline__ unsigned pk2(float lo, float hi) { return f2bf(lo) | (f2bf(hi) << 16); }
__device__ __forceinline__ float bf2f(unsigned short b) { return __uint_as_float((unsigned)b << 16); }
__device__ __forceinline__ float bflo(unsigned w) { return __uint_as_float(w << 16); }
__device__ __forceinline__ float bfhi(unsigned w) { return __uint_as_float(w & 0xffff0000u); }
#define LDS_WAIT() asm volatile("s_waitcnt lgkmcnt(0)" ::: "memory")

template <int CTRL> __device__ __forceinline__ float dpp_f(float v) { return __int_as_float(__builtin_amdgcn_update_dpp(0, __float_as_int(v), CTRL, 0xF, 0xF, true)); }
__device__ __forceinline__ float rdlane(float v, int l) { return __int_as_float(__builtin_amdgcn_readlane(__float_as_int(v), l)); }
__device__ __forceinline__ float wave_max(float v) {
    v = fmaxf(v, dpp_f<0xB1>(v)); v = fmaxf(v, dpp_f<0x4E>(v)); v = fmaxf(v, dpp_f<0x141>(v)); v = fmaxf(v, dpp_f<0x140>(v));
    return fmaxf(fmaxf(rdlane(v, 0), rdlane(v, 16)), fmaxf(rdlane(v, 32), rdlane(v, 48)));
}
__device__ __forceinline__ float wave_sum(float v) {
    v += dpp_f<0xB1>(v); v += dpp_f<0x4E>(v); v += dpp_f<0x141>(v); v += dpp_f<0x140>(v);
    return (rdlane(v, 0) + rdlane(v, 16)) + (rdlane(v, 32) + rdlane(v, 48));
}

__device__ __forceinline__ void transpose_item(const float* W, int ldw, int K, int N, bf16* WT, LAS float* scr, int item, int lane) {
    const int nblk = N / 32, kb = item / nblk, nb = item % nblk, k0 = 64 * kb, n0 = 32 * nb;
#pragma unroll 8
    for (int i = 0; i < 32; ++i) { const int kk = 2 * i + (lane >> 5); scr[kk * 33 + (lane & 31)] = W[(size_t)(k0 + kk) * ldw + n0 + (lane & 31)]; }
    LDS_WAIT(); asm volatile("" ::: "memory");
    const int c = lane & 7;
#pragma unroll
    for (int j = 0; j < 4; ++j) { const int n = (lane >> 3) + 8 * j; const LAS float* s = scr + (8 * c) * 33 + n;
        u32x4 o; o.x = pk2(s[0 * 33], s[1 * 33]); o.y = pk2(s[2 * 33], s[3 * 33]); o.z = pk2(s[4 * 33], s[5 * 33]); o.w = pk2(s[6 * 33], s[7 * 33]);
        *(u32x4*)(WT + (size_t)(n0 + n) * K + k0 + 8 * c) = o; }
    LDS_WAIT(); asm volatile("" ::: "memory");
}
__device__ __forceinline__ void ln_row(const float (&v)[32], int lane, const float* g, const float* b, float* of, bf16* ob) {
    float s = 0.f;
#pragma unroll
    for (int i = 0; i < 32; ++i) s += v[i];
    const float mean = wave_sum(s) * (1.f / DM);
    float s2 = 0.f;
#pragma unroll
    for (int i = 0; i < 32; ++i) { const float d = v[i] - mean; s2 += d * d; }
    const float rstd = 1.0f / sqrtf(wave_sum(s2) * (1.f / DM) + LN_EPS);
#pragma unroll
    for (int c = 0; c < 4; ++c) { const int e0 = c * 512 + lane * 8;
        const f32x4 g0 = *(const f32x4*)(g + e0), g1 = *(const f32x4*)(g + e0 + 4), b0 = *(const f32x4*)(b + e0), b1 = *(const f32x4*)(b + e0 + 4);
        f32x4 o0, o1;
#pragma unroll
        for (int e = 0; e < 4; ++e) { o0[e] = (v[c * 8 + e] - mean) * rstd * g0[e] + b0[e]; o1[e] = (v[c * 8 + 4 + e] - mean) * rstd * g1[e] + b1[e]; }
        *(f32x4*)(of + e0) = o0; *(f32x4*)(of + e0 + 4) = o1;
        u32x4 w; w.x = pk2(o0[0], o0[1]); w.y = pk2(o0[2], o0[3]); w.z = pk2(o1[0], o1[1]); w.w = pk2(o1[2], o1[3]);
        *(u32x4*)(ob + e0) = w; }
}
__device__ __forceinline__ void load_row32(const float* src, int lane, float (&v)[32]) {
#pragma unroll
    for (int c = 0; c < 4; ++c) { const f32x4 a = *(const f32x4*)(src + c * 512 + lane * 8), b = *(const f32x4*)(src + c * 512 + lane * 8 + 4);
#pragma unroll
        for (int e = 0; e < 4; ++e) { v[c * 8 + e] = a[e]; v[c * 8 + 4 + e] = b[e]; } }
}

__device__ __forceinline__ void prologue(const Ctx& X, const float* const* in, float* out, unsigned char* ws) {
    const float* x = in[0]; const float* emb_g = in[1]; const float* emb_b = in[2]; const float* w_in = in[3];
    const float* w_brf = in[4]; const float* w_brh = in[5]; const float* w_bra = in[6]; const float* w_out = in[7];
    const float* lb_logits = in[8]; const float* w_query = in[12]; const float* sub_keys = in[13]; const float* peer_u = in[14]; const float* peer_v = in[15];
    const int lane = X.lane, tid = X.tid;
    {
        LAS float* scr = (LAS float*)(X.lds + X.wave * 16384);
        constexpr int I_WIN = (DM / 64) * (HW / 32), I_BRF = (512 / 64) * (DM / 32), I_BRH = (768 / 64) * (DM / 32), I_BRA = (256 / 64) * (DM / 32), I_OUT = (DM / 64) * (DM / 32);
        constexpr int PER_L = I_WIN + I_BRF + I_BRH + I_BRA + I_OUT;
        for (int it = X.gw; it < DEPTH * PER_L; it += X.ngw) {
            const int l = it / PER_L; int r = it % PER_L; unsigned char* wl = ws + WS_WL0 + (size_t)l * WL_STRIDE;
            if (r < I_WIN) { transpose_item(w_in + (size_t)l * DM * W_IN + 512, W_IN, DM, HW, (bf16*)(wl + WL_WIN), scr, r, lane); continue; } r -= I_WIN;
            if (r < I_BRF) { transpose_item(w_brf + (size_t)l * 512 * DM, DM, 512, DM, (bf16*)(wl + WL_BRF), scr, r, lane); continue; } r -= I_BRF;
            if (r < I_BRH) { transpose_item(w_brh + (size_t)l * 768 * DM, DM, 768, DM, (bf16*)(wl + WL_BRH), scr, r, lane); continue; } r -= I_BRH;
            if (r < I_BRA) { transpose_item(w_bra + (size_t)l * 256 * DM, DM, 256, DM, (bf16*)(wl + WL_BRA), scr, r, lane); continue; } r -= I_BRA;
            transpose_item(w_out + (size_t)l * DM * DM, DM, DM, DM, (bf16*)(wl + WL_OUT), scr, r, lane);
        }
    }
    {
        const size_t n8 = (size_t)NEXP * DM / 8; const size_t gt = (size_t)X.c * NTHR + tid, gs = (size_t)X.G * NTHR;
        for (int l = 0; l < DEPTH; ++l) {
            const float* su = peer_u + (size_t)l * NEXP * DM; const float* sv = peer_v + (size_t)l * NEXP * DM;
            bf16* du = (bf16*)(ws + WS_WL0 + (size_t)l * WL_STRIDE + WL_U); bf16* dv = (bf16*)(ws + WS_WL0 + (size_t)l * WL_STRIDE + WL_V);
            for (size_t i = gt; i < n8; i += gs) {
                const f32x4 a = *(const f32x4*)(su + i * 8), b = *(const f32x4*)(su + i * 8 + 4), c = *(const f32x4*)(sv + i * 8), d = *(const f32x4*)(sv + i * 8 + 4);
                u32x4 w; w.x = pk2(a[0], a[1]); w.y = pk2(a[2], a[3]); w.z = pk2(b[0], b[1]); w.w = pk2(b[2], b[3]); *(u32x4*)(du + i * 8) = w;
                u32x4 z; z.x = pk2(c[0], c[1]); z.y = pk2(c[2], c[3]); z.z = pk2(d[0], d[1]); z.w = pk2(d[2], d[3]); *(u32x4*)(dv + i * 8) = z;
            }
        }
    }
    __syncthreads();
    {
        LAS float* wt = (LAS float*)X.lds;
        LAS float* ct = (LAS float*)(X.lds + 64 * 129 * 4);
        for (int it = X.c; it < DEPTH * 4 * 32; it += X.G) {
            const int l = it >> 7, g = (it >> 5) & 3, d0 = (it & 31) * 64;
            __syncthreads();
            if (tid < 128) ct[tid] = cospif((float)tid * (1.0f / 64.0f));
            const float* src = w_in + (size_t)l * DM * W_IN + (size_t)d0 * W_IN + g * 128;
#pragma unroll 4
            for (int i = 0; i < 16; ++i) { const int idx = tid + NTHR * i, dd = idx >> 7, n2 = idx & 127; wt[dd * 129 + n2] = src[(size_t)dd * W_IN + n2]; }
            __syncthreads();
            const int dd = tid & 63, rg = X.wave;
            float acc[32];
#pragma unroll
            for (int i = 0; i < 32; ++i) acc[i] = 0.f;
            const int part = rg >> 2, k2b = (rg & 3) * 32;
            for (int n2 = 0; n2 < 128; ++n2) {
                const float w = wt[dd * 129 + n2];
#pragma unroll
                for (int i = 0; i < 32; ++i) { const int k2 = k2b + i; const int m = (k2 * n2 - part * 32) & 127; acc[i] += ct[m] * w; }
            }
            bf16* dst = (bf16*)(ws + WS_WL0 + (size_t)l * WL_STRIDE + WL_WF);
#pragma unroll
            for (int i = 0; i < 32; ++i) dst[(size_t)(part * 512 + g * 128 + k2b + i) * DM + d0 + dd] = (bf16)f2bf(acc[i]);
        }
    }
    __syncthreads();
    {
        LAS float* wq = (LAS float*)X.lds;
        LAS float* ky = (LAS float*)(X.lds + 64 * 129 * 4 + 64);
        for (int it = X.c; it < DEPTH * 16 * 32; it += X.G) {
            const int l = it >> 9, hp = (it >> 5) & 15, dm0 = (it & 31) * 64, p = hp & 1;
            __syncthreads();
            const float* ksrc = sub_keys + ((size_t)l * 2 + p) * 128 * 128;
#pragma unroll 4
            for (int i = 0; i < 32; ++i) ky[tid + NTHR * i] = ksrc[tid + NTHR * i];
            const float* src = w_query + (size_t)l * DM * DM + (size_t)dm0 * DM + hp * 128;
#pragma unroll 4
            for (int i = 0; i < 16; ++i) { const int idx = tid + NTHR * i, dd = idx >> 7, d = idx & 127; wq[dd * 129 + d] = src[(size_t)dd * DM + d]; }
            __syncthreads();
            const int dd = tid & 63, k0 = X.wave * 16;
            float acc[16];
#pragma unroll
            for (int i = 0; i < 16; ++i) acc[i] = 0.f;
            for (int d = 0; d < 128; ++d) {
                const float w = wq[dd * 129 + d];
#pragma unroll
                for (int i = 0; i < 16; ++i) acc[i] += ky[(k0 + i) * 128 + d] * w;
            }
            bf16* dst = (bf16*)(ws + WS_WL0 + (size_t)l * WL_STRIDE + WL_WS);
#pragma unroll
            for (int i = 0; i < 16; ++i) dst[(size_t)(hp * 128 + k0 + i) * DM + dm0 + dd] = (bf16)f2bf(acc[i]);
        }
    }
    __syncthreads();
    {
        LAS float* ct = (LAS float*)X.lds;
        const float norm = 1.0f / sqrtf((float)SEQ * 128.0f);
        for (int i = tid; i < 4096; i += NTHR) ct[i] = cospif((float)i * (1.0f / 2048.0f)) * norm;
        __syncthreads();
        bf16* Fm = (bf16*)(ws + WS_F);
        for (int k1 = X.c; k1 < SEQ; k1 += X.G) {
#pragma unroll
            for (int rep = 0; rep < 2; ++rep) {
                const int e0 = (tid + rep * NTHR) * 8;
                const int part = e0 >> 12, n1 = e0 & 4095;
                float v[8];
#pragma unroll
                for (int j = 0; j < 8; ++j) { const int idx = (k1 * (n1 + j)) & 4095; v[j] = part ? -ct[(idx - 1024) & 4095] : ct[idx]; }
                u32x4 w; w.x = pk2(v[0], v[1]); w.y = pk2(v[2], v[3]); w.z = pk2(v[4], v[5]); w.w = pk2(v[6], v[7]);
                *(u32x4*)(Fm + (size_t)k1 * 8192 + e0) = w;
            }
        }
    }
    __syncthreads();
    {
        const int gt = X.c * NTHR + tid;
        if (gt < SEQ * 8) { const int pos = gt >> 3, i = gt & 7; const float invf = powf(500000.0f, -(float)i * 0.125f); const float ang = (float)pos * invf;
            ((float*)(ws + WS_TAB))[gt] = cosf(ang); ((float*)(ws + WS_TAB + TAB_SIN))[gt] = sinf(ang); }
        if (gt < 2 * 768) { const int dir = gt / 768, col = gt % 768; const float l0 = lb_logits[(dir * DEPTH + 0) * 768 + col], l1 = lb_logits[(dir * DEPTH + 1) * 768 + col];
            float* lb = (float*)(ws + WS_TAB + TAB_LB);
            lb[(dir * DEPTH + 0) * 768 + col] = 0.f;
            lb[(dir * DEPTH + 1) * 768 + col] = 1.0f / (1.0f + expf(l0 - l1)); }
    }
    for (int m = X.gw; m < TOK; m += X.ngw) { float v[32]; load_row32(x + (size_t)m * DM, lane, v); ln_row(v, lane, emb_g, emb_b, out + (size_t)m * DM, (bf16*)(ws + WS_XA) + (size_t)m * DM); }
}

__device__ __forceinline__ void attn_naive(const Ctx& X, const bf16* h, const float* rc, const float* rs, bf16* ya) {
    for (int idx = X.c * NTHR + X.tid; idx < TOK * 4; idx += X.G * NTHR) {
        const int tk = idx >> 2, hh = idx & 3, b = tk / SEQ, p = tk % SEQ;
        float mx = -1e30f, l = 0.f; float o[64];
#pragma unroll
        for (int d = 0; d < 64; ++d) o[d] = 0.f;
        for (int g = 0; g < 3; ++g) {
            const int dil = (g == 0) ? 1 : (g == 1 ? 4 : 16), head = g * 4 + hh;
            float q[64];
            { const bf16* qp = h + (size_t)tk * HW + H_QA + head * 64;
#pragma unroll
              for (int i = 0; i < 8; ++i) { const u32x4 w = *(const u32x4*)(qp + i * 8); q[i * 8 + 0] = bflo(w.x); q[i * 8 + 1] = bfhi(w.x); q[i * 8 + 2] = bflo(w.y); q[i * 8 + 3] = bfhi(w.y);
                  q[i * 8 + 4] = bflo(w.z); q[i * 8 + 5] = bfhi(w.z); q[i * 8 + 6] = bflo(w.w); q[i * 8 + 7] = bfhi(w.w); }
#pragma unroll
              for (int i = 0; i < 8; ++i) { const float c = rc[p * 8 + i], s = rs[p * 8 + i], t1 = q[i], t2 = q[8 + i]; q[i] = t1 * c - t2 * s; q[8 + i] = t2 * c + t1 * s; }
#pragma unroll
              for (int d = 0; d < 64; ++d) q[d] *= 0.125f; }
            for (int j = -64; j <= 64; ++j) {
                const int kp = p + j * dil; if (kp < 0 || kp >= SEQ) continue;
                const bf16* kr = h + (size_t)(b * SEQ + kp) * HW + H_KA + head * 64;
                float s = 0.f;
                { const u32x4 w0 = *(const u32x4*)(kr), w1 = *(const u32x4*)(kr + 8);
                  const float k1[8] = {bflo(w0.x), bfhi(w0.x), bflo(w0.y), bfhi(w0.y), bflo(w0.z), bfhi(w0.z), bflo(w0.w), bfhi(w0.w)};
                  const float k2[8] = {bflo(w1.x), bfhi(w1.x), bflo(w1.y), bfhi(w1.y), bflo(w1.z), bfhi(w1.z), bflo(w1.w), bfhi(w1.w)};
#pragma unroll
                  for (int i = 0; i < 8; ++i) { const float c = rc[kp * 8 + i], sn = rs[kp * 8 + i]; s += q[i] * (k1[i] * c - k2[i] * sn) + q[8 + i] * (k2[i] * c + k1[i] * sn); } }
#pragma unroll
                for (int i = 2; i < 8; ++i) { const u32x4 w = *(const u32x4*)(kr + i * 8);
                    s += q[i * 8 + 0] * bflo(w.x) + q[i * 8 + 1] * bfhi(w.x) + q[i * 8 + 2] * bflo(w.y) + q[i * 8 + 3] * bfhi(w.y) + q[i * 8 + 4] * bflo(w.z) + q[i * 8 + 5] * bfhi(w.z) + q[i * 8 + 6] * bflo(w.w) + q[i * 8 + 7] * bfhi(w.w); }
                const float mn = fmaxf(mx, s), corr = __expf(mx - mn), pr = __expf(s - mn);
                l = l * corr + pr; mx = mn;
                const bf16* vr = h + (size_t)(b * SEQ + kp) * HW + H_VA + head * 64;
#pragma unroll
                for (int i = 0; i < 8; ++i) { const u32x4 w = *(const u32x4*)(vr + i * 8);
                    o[i * 8 + 0] = o[i * 8 + 0] * corr + pr * bflo(w.x); o[i * 8 + 1] = o[i * 8 + 1] * corr + pr * bfhi(w.x); o[i * 8 + 2] = o[i * 8 + 2] * corr + pr * bflo(w.y); o[i * 8 + 3] = o[i * 8 + 3] * corr + pr * bfhi(w.y);
                    o[i * 8 + 4] = o[i * 8 + 4] * corr + pr * bflo(w.z); o[i * 8 + 5] = o[i * 8 + 5] * corr + pr * bfhi(w.z); o[i * 8 + 6] = o[i * 8 + 6] * corr + pr * bflo(w.w); o[i * 8 + 7] = o[i * 8 + 7] * corr + pr * bfhi(w.w); }
            }
        }
        const float il = 1.0f / l; bf16* op = ya + (size_t)tk * 256 + hh * 64;
#pragma unroll
        for (int i = 0; i < 8; ++i) { u32x4 w; w.x = pk2(o[i * 8] * il, o[i * 8 + 1] * il); w.y = pk2(o[i * 8 + 2] * il, o[i * 8 + 3] * il); w.z = pk2(o[i * 8 + 4] * il, o[i * 8 + 5] * il); w.w = pk2(o[i * 8 + 6] * il, o[i * 8 + 7] * il);
            *(u32x4*)(op + i * 8) = w; }
    }
}
__device__ __forceinline__ void hgrn_prep_naive(const Ctx& X, const bf16* h, const float* lbl  , float* FD, float* KY) {
    const size_t n = (size_t)2 * TOK * 768;
    for (size_t i = (size_t)X.c * NTHR + X.tid; i < n; i += (size_t)X.G * NTHR) {
        const int dir = (int)(i / ((size_t)TOK * 768)); const size_t r = i % ((size_t)TOK * 768); const int tk = (int)(r / 768), col = (int)(r % 768);
        const float z = bf2f(h[(size_t)tk * HW + (dir ? H_FB : H_FF) + col]); const float lb = lbl[dir * DEPTH * 768 + col];
        const float s = 1.0f / (1.0f + expf(-z));
        FD[i] = lb + (1.0f - lb) * s; KY[i] = (1.0f - lb) * (1.0f - s);
    }
}
__device__ __forceinline__ void hgrn_scan_naive(const Ctx& X, const bf16* h, const float* FD, const float* KY, float* O  ) {
    LAS float* sf = (LAS float*)X.lds; LAS float* sk = sf + 512; LAS float* sq = sk + 512;
    for (int it = X.c; it < 6; it += X.G) {
        const int grp = X.tid >> 7, v = X.tid & 127, ch = it * 4 + grp;
        const int dir = ch / 12, b = (ch % 12) / 6, hd = ch % 6;
        float S[128];
#pragma unroll
        for (int k = 0; k < 128; ++k) S[k] = 0.f;
        for (int st = 0; st < SEQ; ++st) {
            const int t = dir ? (SEQ - 1 - st) : st; const size_t tk = (size_t)b * SEQ + t;
            const size_t e = ((size_t)dir * TOK + tk) * 768 + hd * 128 + v;
            const float f = FD[e], ky = KY[e], qv = bf2f(h[tk * HW + H_Q + hd * 128 + v]), vv = bf2f(h[tk * HW + H_I + hd * 128 + v]);
            __syncthreads();
            sf[X.tid] = f; sk[X.tid] = ky; sq[X.tid] = qv;
            __syncthreads();
            float o = 0.f;
            const LAS f32x4* pf = (const LAS f32x4*)(sf + grp * 128); const LAS f32x4* pk = (const LAS f32x4*)(sk + grp * 128); const LAS f32x4* pq = (const LAS f32x4*)(sq + grp * 128);
#pragma unroll
            for (int k4 = 0; k4 < 32; ++k4) { const f32x4 a = pf[k4], c = pk[k4], d = pq[k4];
#pragma unroll
                for (int e2 = 0; e2 < 4; ++e2) { S[k4 * 4 + e2] = a[e2] * S[k4 * 4 + e2] + c[e2] * vv; o += d[e2] * S[k4 * 4 + e2]; } }
            O[e] = o;
        }
    }
}
__device__ __forceinline__ void hgrn_combine_naive(const Ctx& X, const bf16* h, const float* O, const float* norm_g, bf16* yh) {
    for (int it = X.gw; it < TOK * 6; it += X.ngw) {
        const int tk = it / 6, hd = it % 6; const size_t e = (size_t)tk * 768 + hd * 128 + X.lane * 2;
        const f32x2 a = *(const f32x2*)(O + e), b = *(const f32x2*)(O + (size_t)TOK * 768 + e);
        const float o0 = a[0] + b[0], o1 = a[1] + b[1];
        const float ms = wave_sum(o0 * o0 + o1 * o1) * (1.0f / 128.0f); const float r = 1.0f / sqrtf(ms + 1e-6f);
        const unsigned gw = *(const unsigned*)(h + (size_t)tk * HW + H_G + hd * 128 + X.lane * 2); const float g0 = bflo(gw), g1 = bfhi(gw);
        const f32x2 ng = *(const f32x2*)(norm_g + hd * 128 + X.lane * 2);
        const float y0 = o0 * r * ng[0] * (g0 / (1.0f + expf(-g0))), y1 = o1 * r * ng[1] * (g1 / (1.0f + expf(-g1)));
        *(unsigned*)(yh + e) = pk2(y0, y1);
    }
}
__device__ __forceinline__ void fourier_reduce(const Ctx& X, const float* FP, bf16* yf) {
    for (int i = X.c * NTHR + X.tid; i < SEQ * 1024 / 4; i += X.G * NTHR) {
        const int k1 = i >> 8, c4 = (i & 255) * 4;
        f32x4 s = *(const f32x4*)(FP + (size_t)k1 * 1024 + c4);
#pragma unroll
        for (int ks = 1; ks < 4; ++ks) s = s + *(const f32x4*)(FP + (size_t)ks * SEQ * 1024 + (size_t)k1 * 1024 + c4);
        const int b = c4 >> 9, j = c4 & 511; u32x2 w; w.x = pk2(s[0], s[1]); w.y = pk2(s[2], s[3]);
        *(u32x2*)(yf + (size_t)(b * SEQ + k1) * 512 + j) = w;
    }
}
__device__ __forceinline__ void ln_phase(const Ctx& X, const float* vpre, const float* g, const float* b, float* xres, bf16* xa) {
    for (int m = X.gw; m < TOK; m += X.ngw) { float v[32]; load_row32(vpre + (size_t)m * DM, X.lane, v); ln_row(v, X.lane, g, b, xres + (size_t)m * DM, xa + (size_t)m * DM); }
}

__device__ __forceinline__ float dot2bf(unsigned w, unsigned x, float acc) { return __builtin_amdgcn_fdot2_f32_bf16(__builtin_bit_cast(bf16x2_t, w), __builtin_bit_cast(bf16x2_t, x), acc, false); }
__device__ __forceinline__ float gelu_erf(float x) { return 0.5f * x * (1.0f + erff(x * 0.70710678118654752f)); }
__device__ __forceinline__ void peer_phase(const Ctx& X, const float* scores, const bf16* Ub, const bf16* Vb, float* xres, bf16* xa, const float* lng, const float* lnb,
                                           const float* Uf, const float* Vf, const float* Wq, const float* Kf) {
    const int lane = X.lane;
        LAS float* sc = (LAS float*)(X.lds + X.wave * 12288);
    LAS float* tops = sc + 2048;
    LAS int* topi = (LAS int*)(tops + 256);
    LAS int* le = topi + 256;
    LAS float* lg = (LAS float*)(le + 128);
    const float NEG = -3.0e38f;
    for (int tk = X.gw; tk < TOK; tk += X.ngw) {
        const float* srow = scores + (size_t)tk * 2048;
#if defined(PEER_NAIVE_SC)
        { (void)srow;
          float qa[32];
#pragma unroll
          for (int i = 0; i < 32; ++i) qa[i] = 0.f;
          for (int dm = 0; dm < DM; ++dm) { const float xv = xres[(size_t)tk * DM + dm];
#pragma unroll
              for (int i = 0; i < 32; ++i) qa[i] += xv * Wq[(size_t)dm * DM + i * 64 + lane]; }
#pragma unroll
          for (int i = 0; i < 32; ++i) sc[i * 64 + lane] = qa[i];
          LDS_WAIT();
          float sv[32];
#pragma unroll
          for (int r = 0; r < 16; ++r) { const int p = r & 1;
              float s0 = 0.f, s1 = 0.f;
              for (int d = 0; d < 128; ++d) { const float qv = sc[r * 128 + d]; s0 += qv * Kf[((size_t)p * 128 + lane) * 128 + d]; s1 += qv * Kf[((size_t)p * 128 + 64 + lane) * 128 + d]; }
              sv[2 * r] = s0; sv[2 * r + 1] = s1; }
          LDS_WAIT();
#pragma unroll
          for (int r = 0; r < 16; ++r) { sc[r * 128 + lane] = sv[2 * r]; sc[r * 128 + 64 + lane] = sv[2 * r + 1]; }
          LDS_WAIT(); }
#else
#pragma unroll
        for (int i = 0; i < 8; ++i) *(LAS f32x4*)(sc + i * 256 + lane * 4) = *(const f32x4*)(srow + i * 256 + lane * 4);
        LDS_WAIT();
#endif
#if defined(PEER_NAIVE_SEL)
        for (int r = 0; r < 16; ++r) {
            const float a = sc[r * 128 + lane], b = sc[r * 128 + 64 + lane]; int ca = 0, cb = 0;
            for (int k = 0; k < 128; ++k) { const float v = sc[r * 128 + k]; ca += (v > a || (v == a && k < lane)) ? 1 : 0; cb += (v > b || (v == b && k < 64 + lane)) ? 1 : 0; }
            if (ca < 16) { tops[r * 16 + ca] = a; topi[r * 16 + ca] = lane; }
            if (cb < 16) { tops[r * 16 + cb] = b; topi[r * 16 + cb] = 64 + lane; }
        }
        LDS_WAIT();
        for (int hd = 0; hd < 8; ++hd) {
            LAS float* cand = sc;
            const float a0 = tops[(2 * hd) * 16 + (lane >> 2)]; float cv[4];
#pragma unroll
            for (int jj = 0; jj < 4; ++jj) { cv[jj] = a0 + tops[(2 * hd + 1) * 16 + (lane & 3) * 4 + jj]; cand[lane * 4 + jj] = cv[jj]; }
            LDS_WAIT();
            int cn[4] = {0, 0, 0, 0};
            for (int k = 0; k < 256; ++k) { const float v = cand[k];
#pragma unroll
                for (int jj = 0; jj < 4; ++jj) cn[jj] += (v > cv[jj] || (v == cv[jj] && k < lane * 4 + jj)) ? 1 : 0; }
            LAS float* bsl = sc + 256; LAS int* bcl = (LAS int*)(sc + 272);
#pragma unroll
            for (int jj = 0; jj < 4; ++jj) if (cn[jj] < 16) { bsl[cn[jj]] = cv[jj]; bcl[cn[jj]] = lane * 4 + jj; }
            LDS_WAIT();
            const float M0 = bsl[0]; const float bs = (lane < 16) ? bsl[lane] : 0.f; const int bc = (lane < 16) ? bcl[lane] : 0;
            const float ex = (lane < 16) ? __expf(bs - M0) : 0.f; const float sum = wave_sum(ex);
            if (lane < 16) { const int i1 = topi[(2 * hd) * 16 + (bc >> 4)], i2 = topi[(2 * hd + 1) * 16 + (bc & 15)]; le[hd * 16 + lane] = i1 * 128 + i2; lg[hd * 16 + lane] = ex / sum; }
            LDS_WAIT();
        }
        LDS_WAIT();
#else
        for (int r = 0; r < 16; ++r) {
            float a = sc[r * 128 + lane], b = sc[r * 128 + 64 + lane]; float tv = 0.f; int ti = 0;
#pragma unroll
            for (int it = 0; it < 16; ++it) {
                const float M = wave_max(fmaxf(a, b));
                const unsigned long long ba = __ballot(a == M); int idx;
                if (ba != 0ull) { const int ln = __ffsll((long long)ba) - 1; idx = ln; if (lane == ln) a = NEG; }
                else { const unsigned long long bb = __ballot(b == M); const int ln = __ffsll((long long)bb) - 1; idx = 64 + ln; if (lane == ln) b = NEG; }
                if (lane == it) { tv = M; ti = idx; }
            }
            if (lane < 16) { tops[r * 16 + lane] = tv; topi[r * 16 + lane] = ti; }
        }
        LDS_WAIT();
        for (int hd = 0; hd < 8; ++hd) {
            const float a0 = tops[(2 * hd) * 16 + (lane >> 2)];
            float c0 = a0 + tops[(2 * hd + 1) * 16 + (lane & 3) * 4 + 0], c1 = a0 + tops[(2 * hd + 1) * 16 + (lane & 3) * 4 + 1];
            float c2 = a0 + tops[(2 * hd + 1) * 16 + (lane & 3) * 4 + 2], c3 = a0 + tops[(2 * hd + 1) * 16 + (lane & 3) * 4 + 3];
            float bs = NEG; int bc = 0;
#pragma unroll
            for (int it = 0; it < 16; ++it) {
                const float M = wave_max(fmaxf(fmaxf(c0, c1), fmaxf(c2, c3)));
                const int fj = (c0 == M) ? 0 : (c1 == M) ? 1 : (c2 == M) ? 2 : (c3 == M) ? 3 : -1;
                const unsigned long long bal = __ballot(fj >= 0); const int ln = __ffsll((long long)bal) - 1;
                const int fjw = __builtin_amdgcn_readlane(fj, ln);
                if (lane == ln) { if (fjw == 0) c0 = NEG; else if (fjw == 1) c1 = NEG; else if (fjw == 2) c2 = NEG; else c3 = NEG; }
                if (lane == it) { bs = M; bc = ln * 4 + fjw; }
            }
            const float M0 = rdlane(bs, 0);
            const float ex = (lane < 16) ? __expf(bs - M0) : 0.f; const float sum = wave_sum(ex);
            if (lane < 16) { const int i1 = topi[(2 * hd) * 16 + (bc >> 4)], i2 = topi[(2 * hd + 1) * 16 + (bc & 15)]; le[hd * 16 + lane] = i1 * 128 + i2; lg[hd * 16 + lane] = ex / sum; }
        }
        LDS_WAIT();
#endif
        unsigned xp[16];
        { float xr[32]; load_row32(xres + (size_t)tk * DM, lane, xr);
#pragma unroll
          for (int i = 0; i < 16; ++i) xp[i] = pk2(xr[2 * i], xr[2 * i + 1]); }
        float y[32];
#pragma unroll
        for (int i = 0; i < 32; ++i) y[i] = 0.f;
        constexpr int EG = 2;
        for (int g4 = 0; g4 < 128 / EG; ++g4) {
#if defined(PEER_F32_GATHER)
            { float xr2[32]; load_row32(xres + (size_t)tk * DM, lane, xr2);
              for (int k = 0; k < EG; ++k) { const int e = __builtin_amdgcn_readfirstlane(le[g4 * EG + k]); const float gtk = lg[g4 * EG + k];
                  float ur[32];
#if defined(PEER_BF_TABLE)
#pragma unroll
                  for (int c = 0; c < 4; ++c) { const u32x4 w = *(const u32x4*)(Ub + (size_t)e * DM + lane * 8 + c * 512);
                      ur[c * 8 + 0] = bflo(w.x); ur[c * 8 + 1] = bfhi(w.x); ur[c * 8 + 2] = bflo(w.y); ur[c * 8 + 3] = bfhi(w.y); ur[c * 8 + 4] = bflo(w.z); ur[c * 8 + 5] = bfhi(w.z); ur[c * 8 + 6] = bflo(w.w); ur[c * 8 + 7] = bfhi(w.w); }
#else
                  load_row32(Uf + (size_t)e * DM, lane, ur);
#endif
                  float s = 0.f;
#pragma unroll
                  for (int i = 0; i < 32; ++i) s += ur[i] * xr2[i];
                  const float hvk = gelu_erf(wave_sum(s)) * gtk;
                  float vr[32];
#if defined(PEER_BF_TABLE)
#pragma unroll
                  for (int c = 0; c < 4; ++c) { const u32x4 w = *(const u32x4*)(Vb + (size_t)e * DM + lane * 8 + c * 512);
                      vr[c * 8 + 0] = bflo(w.x); vr[c * 8 + 1] = bfhi(w.x); vr[c * 8 + 2] = bflo(w.y); vr[c * 8 + 3] = bfhi(w.y); vr[c * 8 + 4] = bflo(w.z); vr[c * 8 + 5] = bfhi(w.z); vr[c * 8 + 6] = bflo(w.w); vr[c * 8 + 7] = bfhi(w.w); }
#else
                  load_row32(Vf + (size_t)e * DM, lane, vr);
#endif
#pragma unroll
                  for (int i = 0; i < 32; ++i) y[i] += hvk * vr[i]; } }
            continue;
#endif
            u32x4 U[EG][4], V[EG][4]; float gt[EG];
#pragma unroll
            for (int k = 0; k < EG; ++k) { const int e = __builtin_amdgcn_readfirstlane(le[g4 * EG + k]); gt[k] = lg[g4 * EG + k];
                const bf16* up = Ub + (size_t)e * DM + lane * 8; const bf16* vp = Vb + (size_t)e * DM + lane * 8;
#pragma unroll
                for (int c = 0; c < 4; ++c) { U[k][c] = *(const u32x4*)(up + c * 512); V[k][c] = *(const u32x4*)(vp + c * 512); } }
            float hv[EG];
#pragma unroll
            for (int k = 0; k < EG; ++k) { float s = 0.f;
#pragma unroll
                for (int c = 0; c < 4; ++c) {
                    s = dot2bf(U[k][c].x, xp[c * 4 + 0], s);
                    s = dot2bf(U[k][c].y, xp[c * 4 + 1], s);
                    s = dot2bf(U[k][c].z, xp[c * 4 + 2], s);
                    s = dot2bf(U[k][c].w, xp[c * 4 + 3], s); }
                hv[k] = gelu_erf(wave_sum(s)) * gt[k]; }
#pragma unroll
            for (int k = 0; k < EG; ++k)
#pragma unroll
                for (int c = 0; c < 4; ++c) { const u32x4 w = V[k][c];
                    y[c * 8 + 0] += hv[k] * bflo(w.x); y[c * 8 + 1] += hv[k] * bfhi(w.x); y[c * 8 + 2] += hv[k] * bflo(w.y); y[c * 8 + 3] += hv[k] * bfhi(w.y);
                    y[c * 8 + 4] += hv[k] * bflo(w.z); y[c * 8 + 5] += hv[k] * bfhi(w.z); y[c * 8 + 6] += hv[k] * bflo(w.w); y[c * 8 + 7] += hv[k] * bfhi(w.w); }
        }
#if defined(EXP_ZERO_PEER)
#pragma unroll
        for (int i = 0; i < 32; ++i) y[i] = 0.f;
#endif
        asm volatile("" ::: "memory");
        { float xr[32]; load_row32(xres + (size_t)tk * DM, lane, xr);
#pragma unroll
          for (int i = 0; i < 32; ++i) y[i] += DN_ALPHA * xr[i]; }
        ln_row(y, lane, lng, lnb, xres + (size_t)tk * DM, xa + (size_t)tk * DM);
    }
}

typedef short bf16x8 __attribute__((ext_vector_type(8)));
#define MFMA16(a, b, c) __builtin_amdgcn_mfma_f32_16x16x32_bf16((a), (b), (c), 0, 0, 0)
constexpr size_t TAB_D = 1 * MiB;

__device__ __forceinline__ void hgrn_lf_key(float z, float lb, float& lf, float& key) {
    const float s = __builtin_amdgcn_rcpf(1.0f + __expf(-z));
    const float f = fmaxf(lb + (1.0f - lb) * s, 1e-30f);
    lf = __logf(f); key = (1.0f - lb) * (1.0f - s);
}
__device__ __forceinline__ void unpack8(const u32x4 w, float* o) { o[0] = bflo(w.x); o[1] = bfhi(w.x); o[2] = bflo(w.y); o[3] = bfhi(w.y); o[4] = bflo(w.z); o[5] = bfhi(w.z); o[6] = bflo(w.w); o[7] = bfhi(w.w); }
__device__ __forceinline__ u32x4 pack8(const float* v) { u32x4 w; w.x = pk2(v[0], v[1]); w.y = pk2(v[2], v[3]); w.z = pk2(v[4], v[5]); w.w = pk2(v[6], v[7]); return w; }

__device__ __forceinline__ void hgrn_cumsum(LAS float* LF, LAS float* SEG, int tid, int dir, float (&bl)[16], float& tot) {
    const int k = tid & 127, seg = tid >> 7; float run = 0.f;
    if (dir == 0) {
#pragma unroll
        for (int i = 0; i < 16; ++i) { run += LF[(16 * seg + i) * 128 + k]; bl[i] = run; }
    } else {
#pragma unroll
        for (int i = 15; i >= 0; --i) { run += LF[(16 * seg + i) * 128 + k]; bl[i] = run; }
    }
    SEG[seg * 128 + k] = run;
    __syncthreads();
    float off = 0.f; tot = 0.f;
#pragma unroll
    for (int s2 = 0; s2 < 4; ++s2) { const float sv = SEG[s2 * 128 + k]; tot += sv; if (dir == 0 ? (s2 < seg) : (s2 > seg)) off += sv; }
#pragma unroll
    for (int i = 0; i < 16; ++i) bl[i] += off;
}

__device__ __forceinline__ void hgrn_pass1(const Ctx& X, const bf16* h, const float* lbl, float* L, float* Dd) {
    LAS float* LF = (LAS float*)X.lds; LAS float* KYf = LF + 8192; LAS float* SEG = KYf + 8192;
    LAS bf16* VR = (LAS bf16*)(X.lds + 67584); LAS bf16* KT = (LAS bf16*)(X.lds + 83968); LAS bf16* VT = (LAS bf16*)(X.lds + 102400);
    const int tid = X.tid, lane = X.lane, q4 = lane >> 4, l15 = lane & 15;
    for (int u = X.c; u < 1536; u += X.G) {
        const int dir = u / 768, rem = u % 768, bh = rem >> 6, c = rem & 63, b = bh / 6, hd = bh % 6; const size_t tok0 = (size_t)b * SEQ + 64 * c;
        __syncthreads();
        { const int t = tid >> 3, kc = (tid & 7) * 16;
          const bf16* zr = h + (tok0 + t) * HW + (dir ? H_FB : H_FF) + hd * 128 + kc; const bf16* vr = h + (tok0 + t) * HW + H_I + hd * 128 + kc;
          const u32x4 z0 = *(const u32x4*)zr, z1 = *(const u32x4*)(zr + 8), v0 = *(const u32x4*)vr, v1 = *(const u32x4*)(vr + 8);
          float z[16]; unpack8(z0, z); unpack8(z1, z + 8);
          const float* lbp = lbl + dir * DEPTH * 768 + hd * 128 + kc;
          float lf[16], ky[16];
#pragma unroll
          for (int j = 0; j < 16; ++j) hgrn_lf_key(z[j], lbp[j], lf[j], ky[j]);
#pragma unroll
          for (int j = 0; j < 4; ++j) { *(LAS f32x4*)(LF + t * 128 + kc + 4 * j) = (f32x4){lf[4 * j], lf[4 * j + 1], lf[4 * j + 2], lf[4 * j + 3]};
              *(LAS f32x4*)(KYf + t * 128 + kc + 4 * j) = (f32x4){ky[4 * j], ky[4 * j + 1], ky[4 * j + 2], ky[4 * j + 3]}; }
          *(LAS u32x4*)(VR + t * 128 + kc) = v0; *(LAS u32x4*)(VR + t * 128 + kc + 8) = v1; }
        __syncthreads();
        float bl[16], tot; hgrn_cumsum(LF, SEG, tid, dir, bl, tot);
        { const int k = tid & 127, seg = tid >> 7; float kh[16];
#pragma unroll
          for (int i = 0; i < 16; ++i) kh[i] = KYf[(16 * seg + i) * 128 + k] * __expf(tot - bl[i]);
          *(LAS u32x4*)(KT + k * 72 + 16 * seg) = pack8(kh); *(LAS u32x4*)(KT + k * 72 + 16 * seg + 8) = pack8(kh + 8);
          if (seg == 0) Dd[(size_t)u * 128 + k] = __expf(tot);
          unsigned short vv[16];
#pragma unroll
          for (int i = 0; i < 16; ++i) vv[i] = VR[(16 * seg + i) * 128 + k];
          u32x4 w0, w1; w0.x = vv[0] | (vv[1] << 16); w0.y = vv[2] | (vv[3] << 16); w0.z = vv[4] | (vv[5] << 16); w0.w = vv[6] | (vv[7] << 16);
          w1.x = vv[8] | (vv[9] << 16); w1.y = vv[10] | (vv[11] << 16); w1.z = vv[12] | (vv[13] << 16); w1.w = vv[14] | (vv[15] << 16);
          *(LAS u32x4*)(VT + k * 72 + 16 * seg) = w0; *(LAS u32x4*)(VT + k * 72 + 16 * seg + 8) = w1; }
        __syncthreads();
        const int mb0 = (X.wave & 3) * 2, nb0 = (X.wave >> 2) * 4;
        f32x4 acc[2][4];
#pragma unroll
        for (int mi = 0; mi < 2; ++mi)
#pragma unroll
            for (int ni = 0; ni < 4; ++ni) acc[mi][ni] = (f32x4){0.f, 0.f, 0.f, 0.f};
#pragma unroll
        for (int ks = 0; ks < 2; ++ks) {
            bf16x8 a[2], bb[4];
#pragma unroll
            for (int mi = 0; mi < 2; ++mi) a[mi] = *(const LAS bf16x8*)(KT + ((mb0 + mi) * 16 + l15) * 72 + ks * 32 + 8 * q4);
#pragma unroll
            for (int ni = 0; ni < 4; ++ni) bb[ni] = *(const LAS bf16x8*)(VT + ((nb0 + ni) * 16 + l15) * 72 + ks * 32 + 8 * q4);
#pragma unroll
            for (int mi = 0; mi < 2; ++mi)
#pragma unroll
                for (int ni = 0; ni < 4; ++ni) acc[mi][ni] = MFMA16(a[mi], bb[ni], acc[mi][ni]);
        }
        float* Lu = L + (size_t)u * 16384;
#pragma unroll
        for (int mi = 0; mi < 2; ++mi)
#pragma unroll
            for (int ni = 0; ni < 4; ++ni) *(f32x4*)(Lu + ((nb0 + ni) * 16 + l15) * 128 + (mb0 + mi) * 16 + 4 * q4) = acc[mi][ni];
    }
}
__device__ __forceinline__ void hgrn_pass2(const Ctx& X, const float* L, const float* Dd, bf16* Sp) {
    for (int i = X.c * NTHR + X.tid; i < 24 * 8192; i += X.G * NTHR) {
        const int chain = i >> 13, e = (i & 8191) * 2, k = e & 127, dir = chain / 12, bh = chain % 12;
        float s0 = 0.f, s1 = 0.f;
#pragma unroll 8
        for (int j = 0; j < 64; ++j) { const int c = dir ? 63 - j : j; const size_t u = (size_t)(dir * 12 + bh) * 64 + c;
            *(unsigned*)(Sp + u * 16384 + e) = pk2(s0, s1);
            const f32x2 l = *(const f32x2*)(L + u * 16384 + e), d = *(const f32x2*)(Dd + u * 128 + k);
            s0 = d[0] * s0 + l[0]; s1 = d[1] * s1 + l[1]; }
    }
}
__device__ __forceinline__ void hgrn_pass3(const Ctx& X, const bf16* h, const float* lbl, const bf16* Sp, const float* norm_g, bf16* yh) {
    LAS unsigned char* R1 = (LAS unsigned char*)X.lds;
    LAS float* LF = (LAS float*)R1; LAS bf16* VR = (LAS bf16*)R1; LAS bf16* ST = (LAS bf16*)R1;
    LAS bf16* VT = (LAS bf16*)(X.lds + 34816); LAS bf16* QT1 = (LAS bf16*)(X.lds + 53248); LAS bf16* KT1 = (LAS bf16*)(X.lds + 70656); LAS bf16* QT2 = (LAS bf16*)(X.lds + 88064);
    LAS bf16* PM = (LAS bf16*)(X.lds + 105472); LAS float* SEG = (LAS float*)(X.lds + 114688); LAS float* RR = (LAS float*)(X.lds + 116736); LAS float* SS = (LAS float*)(X.lds + 117248);
    const int tid = X.tid, lane = X.lane, q4 = lane >> 4, l15 = lane & 15, w = X.wave;
    for (int u = X.c; u < 768; u += X.G) {
        const int bh = u >> 6, c = u & 63, b = bh / 6, hd = bh % 6; const size_t tok0 = (size_t)b * SEQ + 64 * c;
        __syncthreads();
        { const int t = tid >> 3, kc = (tid & 7) * 16; const bf16* vr = h + (tok0 + t) * HW + H_I + hd * 128 + kc;
          *(LAS u32x4*)(VR + t * 128 + kc) = *(const u32x4*)vr; *(LAS u32x4*)(VR + t * 128 + kc + 8) = *(const u32x4*)(vr + 8); }
        __syncthreads();
        { const int v = tid & 127, seg = tid >> 7; unsigned short vv[16];
#pragma unroll
          for (int i = 0; i < 16; ++i) vv[i] = VR[(16 * seg + i) * 128 + v];
          u32x4 w0, w1; w0.x = vv[0] | (vv[1] << 16); w0.y = vv[2] | (vv[3] << 16); w0.z = vv[4] | (vv[5] << 16); w0.w = vv[6] | (vv[7] << 16);
          w1.x = vv[8] | (vv[9] << 16); w1.y = vv[10] | (vv[11] << 16); w1.z = vv[12] | (vv[13] << 16); w1.w = vv[14] | (vv[15] << 16);
          *(LAS u32x4*)(VT + v * 72 + 16 * seg) = w0; *(LAS u32x4*)(VT + v * 72 + 16 * seg + 8) = w1; }
        f32x4 acc[4];
#pragma unroll
        for (int ni = 0; ni < 4; ++ni) acc[ni] = (f32x4){0.f, 0.f, 0.f, 0.f};
        const int tb = w & 3;
#pragma unroll 1
        for (int dir = 0; dir < 2; ++dir) {
            __syncthreads();
            const int t = tid >> 3, kc = (tid & 7) * 16;
            float ky[16], qv[16];
            { const bf16* zr = h + (tok0 + t) * HW + (dir ? H_FB : H_FF) + hd * 128 + kc; const bf16* qr = h + (tok0 + t) * HW + H_Q + hd * 128 + kc;
              const u32x4 z0 = *(const u32x4*)zr, z1 = *(const u32x4*)(zr + 8), q0 = *(const u32x4*)qr, q1 = *(const u32x4*)(qr + 8);
              float z[16]; unpack8(z0, z); unpack8(z1, z + 8); unpack8(q0, qv); unpack8(q1, qv + 8);
              const float* lbp = lbl + dir * DEPTH * 768 + hd * 128 + kc; float lf[16];
#pragma unroll
              for (int j = 0; j < 16; ++j) hgrn_lf_key(z[j], lbp[j], lf[j], ky[j]);
#pragma unroll
              for (int j = 0; j < 4; ++j) *(LAS f32x4*)(LF + t * 128 + kc + 4 * j) = (f32x4){lf[4 * j], lf[4 * j + 1], lf[4 * j + 2], lf[4 * j + 3]}; }
            const size_t us = (size_t)(dir * 12 + bh) * 64 + c; u32x4 sreg[4];
#pragma unroll
            for (int i = 0; i < 4; ++i) sreg[i] = *(const u32x4*)(Sp + us * 16384 + (size_t)(tid + NTHR * i) * 8);
            __syncthreads();
            { float bl[16], tot; hgrn_cumsum(LF, SEG, tid, dir, bl, tot);
              const int k = tid & 127, seg = tid >> 7;
#pragma unroll
              for (int i = 0; i < 16; ++i) LF[(16 * seg + i) * 128 + k] = bl[i];
              if (dir == 0 ? (seg == 1) : (seg == 2)) RR[k] = dir == 0 ? bl[15] : bl[0]; }
            __syncthreads();
            { float q1[16], k1[16], q2[16];
#pragma unroll
              for (int j = 0; j < 16; ++j) { const float bt = LF[t * 128 + kc + j], r = RR[kc + j];
                  q1[j] = qv[j] * __expf(bt - r); k1[j] = ky[j] * __expf(r - bt); q2[j] = qv[j] * __expf(bt); }
              *(LAS u32x4*)(QT1 + t * 136 + kc) = pack8(q1); *(LAS u32x4*)(QT1 + t * 136 + kc + 8) = pack8(q1 + 8);
              *(LAS u32x4*)(KT1 + t * 136 + kc) = pack8(k1); *(LAS u32x4*)(KT1 + t * 136 + kc + 8) = pack8(k1 + 8);
              *(LAS u32x4*)(QT2 + t * 136 + kc) = pack8(q2); *(LAS u32x4*)(QT2 + t * 136 + kc + 8) = pack8(q2 + 8); }
            __syncthreads();
#pragma unroll
            for (int i = 0; i < 4; ++i) { const int idx = tid + NTHR * i, v = idx >> 4, k8 = (idx & 15) * 8; *(LAS u32x4*)(ST + v * 136 + k8) = sreg[i]; }
            { const int sb0 = (w >> 2) * 2; f32x4 pa[2] = {(f32x4){0.f, 0.f, 0.f, 0.f}, (f32x4){0.f, 0.f, 0.f, 0.f}};
#pragma unroll
              for (int ks = 0; ks < 4; ++ks) { const bf16x8 a = *(const LAS bf16x8*)(QT1 + (tb * 16 + l15) * 136 + ks * 32 + 8 * q4);
#pragma unroll
                  for (int si = 0; si < 2; ++si) { const bf16x8 bb = *(const LAS bf16x8*)(KT1 + ((sb0 + si) * 16 + l15) * 136 + ks * 32 + 8 * q4); pa[si] = MFMA16(a, bb, pa[si]); } }
#pragma unroll
              for (int si = 0; si < 2; ++si) { const int s = (sb0 + si) * 16 + l15;
#pragma unroll
                  for (int r = 0; r < 4; ++r) { const int tt = tb * 16 + 4 * q4 + r; const bool keep = dir == 0 ? (s <= tt) : (s >= tt);
                      PM[tt * 72 + s] = (bf16)f2bf(keep ? pa[si][r] : 0.f); } } }
            __syncthreads();
            { const int vb0 = (w >> 2) * 4;
#pragma unroll
              for (int ks = 0; ks < 4; ++ks) { const bf16x8 a = *(const LAS bf16x8*)(QT2 + (tb * 16 + l15) * 136 + ks * 32 + 8 * q4);
#pragma unroll
                  for (int ni = 0; ni < 4; ++ni) { const bf16x8 bb = *(const LAS bf16x8*)(ST + ((vb0 + ni) * 16 + l15) * 136 + ks * 32 + 8 * q4); acc[ni] = MFMA16(a, bb, acc[ni]); } }
#pragma unroll
              for (int ks = 0; ks < 2; ++ks) { const bf16x8 a = *(const LAS bf16x8*)(PM + (tb * 16 + l15) * 72 + ks * 32 + 8 * q4);
#pragma unroll
                  for (int ni = 0; ni < 4; ++ni) { const bf16x8 bb = *(const LAS bf16x8*)(VT + ((vb0 + ni) * 16 + l15) * 72 + ks * 32 + 8 * q4); acc[ni] = MFMA16(a, bb, acc[ni]); } } }
        }
        { const int vb0 = (w >> 2) * 4; float ss[4];
#pragma unroll
          for (int r = 0; r < 4; ++r) { float s = 0.f;
#pragma unroll
              for (int ni = 0; ni < 4; ++ni) s += acc[ni][r] * acc[ni][r];
              s += dpp_f<0xB1>(s); s += dpp_f<0x4E>(s); s += dpp_f<0x141>(s); s += dpp_f<0x140>(s);
              ss[r] = s; }
          if (l15 == 0) {
#pragma unroll
              for (int r = 0; r < 4; ++r) SS[(tb * 16 + 4 * q4 + r) * 2 + (w >> 2)] = ss[r]; }
          __syncthreads();
#pragma unroll
          for (int r = 0; r < 4; ++r) { const int tt = tb * 16 + 4 * q4 + r; const float tot = SS[tt * 2] + SS[tt * 2 + 1]; const float rn = 1.0f / sqrtf(tot * (1.0f / 128.0f) + 1e-6f);
#pragma unroll
              for (int ni = 0; ni < 4; ++ni) { const int v = (vb0 + ni) * 16 + l15; const float g = bf2f(h[(tok0 + tt) * HW + H_G + hd * 128 + v]);
                  const float y = acc[ni][r] * rn * norm_g[hd * 128 + v] * (g * __builtin_amdgcn_rcpf(1.0f + __expf(-g)));
                  yh[(tok0 + tt) * 768 + hd * 128 + v] = (bf16)f2bf(y); } } }
    }
}

constexpr size_t WS_AO = 944 * MiB, WS_LSE = 968 * MiB, WS_END2 = 969 * MiB;
__device__ __forceinline__ void rope16(float* t1, float* t2, const float* rc, const float* rs, int p) {
    const f32x4 c0 = *(const f32x4*)(rc + p * 8), c1 = *(const f32x4*)(rc + p * 8 + 4), s0 = *(const f32x4*)(rs + p * 8), s1 = *(const f32x4*)(rs + p * 8 + 4);
#pragma unroll
    for (int i = 0; i < 8; ++i) { const float c = i < 4 ? c0[i] : c1[i - 4], s = i < 4 ? s0[i] : s1[i - 4], a = t1[i], b = t2[i]; t1[i] = a * c - b * s; t2[i] = b * c + a * s; }
}
__device__ __forceinline__ void attn_fast(const Ctx& X, const bf16* h, const float* rc, const float* rs, float* AO, float* LSE) {
    LAS bf16* KL = (LAS bf16*)X.lds; LAS bf16* VL = KL + 256 * 72; LAS bf16* QL = VL + 256 * 72;
    const int tid = X.tid, lane = X.lane, q4 = lane >> 4, l15 = lane & 15, w = X.wave;
    for (int u = X.c; u < 768; u += X.G) {
        const int b = u / 384, head = (u % 384) >> 5, blk = u & 31, g = head >> 2, dsh = 2 * g, dil = 1 << dsh, Lsub = SEQ >> dsh, nblk = Lsub >> 7;
        const int cls = blk / nblk, m0 = (blk % nblk) * 128;
        const bf16* hb = h + (size_t)b * SEQ * HW;
        __syncthreads();
#pragma unroll
        for (int rep = 0; rep < 2; ++rep) {
            const int row = (tid >> 2) + 128 * rep, qt = tid & 3, m = m0 - 64 + row; const bool ok = (m >= 0) && (m < Lsub); const int p = ok ? m * dil + cls : 0;
            const bf16* kr = hb + (size_t)p * HW + H_KA + head * 64 + qt * 16; const bf16* vr = hb + (size_t)p * HW + H_VA + head * 64 + qt * 16;
            u32x4 k0 = *(const u32x4*)kr, k1 = *(const u32x4*)(kr + 8), v0 = *(const u32x4*)vr, v1 = *(const u32x4*)(vr + 8);
            if (qt == 0) { float t1[8], t2[8]; unpack8(k0, t1); unpack8(k1, t2); rope16(t1, t2, rc, rs, p); k0 = pack8(t1); k1 = pack8(t2); }
            if (!ok) { k0 = (u32x4){0u, 0u, 0u, 0u}; k1 = k0; v0 = k0; v1 = k0; }
            *(LAS u32x4*)(KL + row * 72 + qt * 16) = k0; *(LAS u32x4*)(KL + row * 72 + qt * 16 + 8) = k1;
            *(LAS u32x4*)(VL + row * 72 + qt * 16) = v0; *(LAS u32x4*)(VL + row * 72 + qt * 16 + 8) = v1;
        }
        { const int row = tid >> 2, qt = tid & 3, p = (m0 + row) * dil + cls; const bf16* qr = hb + (size_t)p * HW + H_QA + head * 64 + qt * 16;
          const u32x4 q0 = *(const u32x4*)qr, q1 = *(const u32x4*)(qr + 8); float t1[8], t2[8]; unpack8(q0, t1); unpack8(q1, t2);
          if (qt == 0) rope16(t1, t2, rc, rs, p);
#pragma unroll
          for (int i = 0; i < 8; ++i) { t1[i] *= 0.125f; t2[i] *= 0.125f; }
          *(LAS u32x4*)(QL + row * 72 + qt * 16) = pack8(t1); *(LAS u32x4*)(QL + row * 72 + qt * 16 + 8) = pack8(t2); }
        __syncthreads();
        bf16x8 qf[2];
#pragma unroll
        for (int ks = 0; ks < 2; ++ks) qf[ks] = *(const LAS bf16x8*)(QL + (16 * w + l15) * 72 + ks * 32 + 8 * q4);
        f32x4 sa[9];
#pragma unroll
        for (int kb = 0; kb < 9; ++kb) { sa[kb] = (f32x4){0.f, 0.f, 0.f, 0.f};
#pragma unroll
            for (int ks = 0; ks < 2; ++ks) { const bf16x8 a = *(const LAS bf16x8*)(KL + (16 * w + 16 * kb + l15) * 72 + ks * 32 + 8 * q4); sa[kb] = MFMA16(a, qf[ks], sa[kb]); } }
        float mx = -1e30f;
#pragma unroll
        for (int kb = 0; kb < 9; ++kb)
#pragma unroll
            for (int r = 0; r < 4; ++r) { const int j = 16 * kb + 4 * q4 + r, d = j - 64 - l15, km = m0 - 64 + 16 * w + j; const bool ok = (d >= -64) && (d <= 64) && (km >= 0) && (km < Lsub);
                sa[kb][r] = ok ? sa[kb][r] : -1e30f; mx = fmaxf(mx, sa[kb][r]); }
        mx = fmaxf(mx, __shfl_xor(mx, 16)); mx = fmaxf(mx, __shfl_xor(mx, 32));
        float lsum = 0.f;
#pragma unroll
        for (int kb = 0; kb < 9; ++kb)
#pragma unroll
            for (int r = 0; r < 4; ++r) { const float pv = __expf(sa[kb][r] - mx); sa[kb][r] = pv; lsum += pv; }
        lsum += __shfl_xor(lsum, 16); lsum += __shfl_xor(lsum, 32);
        f32x4 oa[4];
#pragma unroll
        for (int db = 0; db < 4; ++db) oa[db] = (f32x4){0.f, 0.f, 0.f, 0.f};
#pragma unroll
        for (int kp = 0; kp < 5; ++kp) {
            u32x4 pw; pw.x = pk2(sa[2 * kp][0], sa[2 * kp][1]); pw.y = pk2(sa[2 * kp][2], sa[2 * kp][3]);
            if (kp < 4) { pw.z = pk2(sa[2 * kp + 1][0], sa[2 * kp + 1][1]); pw.w = pk2(sa[2 * kp + 1][2], sa[2 * kp + 1][3]); } else { pw.z = 0u; pw.w = 0u; }
            const bf16x8 pb = __builtin_bit_cast(bf16x8, pw);
            int rows[8];
#pragma unroll
            for (int jj = 0; jj < 8; ++jj) { int R = 16 * w + 16 * (2 * kp + (jj >> 2)) + 4 * q4 + (jj & 3); rows[jj] = R > 255 ? 255 : R; }
#pragma unroll
            for (int db = 0; db < 4; ++db) { bf16x8 va;
#pragma unroll
                for (int jj = 0; jj < 8; ++jj) va[jj] = (short)VL[rows[jj] * 72 + 16 * db + l15];
                oa[db] = MFMA16(va, pb, oa[db]); }
        }
        const float il = 1.0f / lsum; const size_t tok = (size_t)b * SEQ + (size_t)(m0 + 16 * w + l15) * dil + cls;
#pragma unroll
        for (int db = 0; db < 4; ++db) *(f32x4*)(AO + tok * 768 + head * 64 + 16 * db + 4 * q4) = oa[db] * il;
        if (q4 == 0) LSE[tok * 12 + head] = mx + __logf(lsum);
    }
}
__device__ __forceinline__ void attn_merge(const Ctx& X, const float* AO, const float* LSE, bf16* ya) {
    for (int i = X.c * NTHR + X.tid; i < TOK * 64; i += X.G * NTHR) {
        const int tk = i >> 6, hh = (i >> 4) & 3, d4 = (i & 15) * 4;
        const float l0 = LSE[(size_t)tk * 12 + hh], l1 = LSE[(size_t)tk * 12 + 4 + hh], l2 = LSE[(size_t)tk * 12 + 8 + hh];
        const float m = fmaxf(l0, fmaxf(l1, l2)), e0 = __expf(l0 - m), e1 = __expf(l1 - m), e2 = __expf(l2 - m), inv = 1.0f / (e0 + e1 + e2);
        const float* ap = AO + (size_t)tk * 768 + hh * 64 + d4;
        const f32x4 o = (*(const f32x4*)ap * e0 + *(const f32x4*)(ap + 256) * e1 + *(const f32x4*)(ap + 512) * e2) * inv;
        u32x2 wv; wv.x = pk2(o[0], o[1]); wv.y = pk2(o[2], o[3]); *(u32x2*)(ya + (size_t)tk * 256 + hh * 64 + d4) = wv;
    }
}

#ifndef MK_ONE_LAUNCH
#define MK_ONE_LAUNCH 1
#endif
constexpr int N_PHASES = 1 + 9 * DEPTH;
__device__ __forceinline__ bool fresh(Ctx& X) { asm volatile("" : "+v"(X.tid), "+v"(X.lane)); return true; }

#if defined(CHECK_BRANCHES)
constexpr size_t WS_YA2 = 969 * MiB, WS_YH2 = 973 * MiB;
__device__ __forceinline__ void cmp_bf16(const Ctx& X, const bf16* a, const bf16* ref, size_t n, float* cnt) {
    float d2 = 0.f, r2 = 0.f;
    for (size_t i = (size_t)X.c * NTHR + X.tid; i < n; i += (size_t)X.G * NTHR) { const float x = bf2f(a[i]), y = bf2f(ref[i]); d2 += (x - y) * (x - y); r2 += y * y; }
    d2 = wave_sum(d2); r2 = wave_sum(r2);
    if (X.lane == 0) { atomicAdd(cnt, d2); atomicAdd(cnt + 1, r2); }
}
#endif
struct Args { const float* in[18]; float* out; unsigned char* ws; int ph_lo, ph_hi; };
typedef pg8::bf16_t pbf;

__global__ void __launch_bounds__(NTHR, 2) fwd_kernel(Args args) {
    extern __shared__ __attribute__((aligned(16))) unsigned char lds[];
    cg::grid_group grid = cg::this_grid();
    Ctx X; X.lds = lds; X.tid = threadIdx.x; X.lane = X.tid & 63; X.wave = __builtin_amdgcn_readfirstlane(X.tid >> 6);
    X.G = gridDim.x; X.c = blockIdx.x; X.gw = X.c * NWAVES + X.wave; X.ngw = X.G * NWAVES;
    unsigned char* ws = args.ws; float* out = args.out;
    LAS unsigned char* ldsl = (LAS unsigned char*)lds;
    const int lo = args.ph_lo, hi = args.ph_hi;
#define IN(k) (lo <= (k) && (k) < hi && fresh(X))
#define INR(k) (lo <= (k) && (k) < hi)
#define SEAM(k) do { if (INR(k) && INR((k) + 1)) grid.sync(); else __syncthreads(); } while (0)

    #ifndef SKIP_P0
    if (IN(0)) { prologue(X, args.in, out, ws); SEAM(0); }
#endif

    const float* ropec = (const float*)(ws + WS_TAB); const float* ropes = (const float*)(ws + WS_TAB + TAB_SIN); const float* lbt = (const float*)(ws + WS_TAB + TAB_LB);
    pbf* XA = (pbf*)(ws + WS_XA); pbf* Hb = (pbf*)(ws + WS_H); pbf* PT = (pbf*)(ws + WS_PT); float* FP = (float*)(ws + WS_FP);
    pbf* YF = (pbf*)(ws + WS_YF); pbf* YH = (pbf*)(ws + WS_YH); pbf* YA = (pbf*)(ws + WS_YA);
    float* MACC = (float*)(ws + WS_MACC); pbf* MERGED = (pbf*)(ws + WS_MERGED); float* VPRE = (float*)(ws + WS_VPRE); float* SC = (float*)(ws + WS_SC);
    float* FD = (float*)(ws + WS_LB); float* KY = FD + (size_t)2 * TOK * 768; float* OH = (float*)(ws + WS_SB);

    for (int l = 0; l < DEPTH; ++l) {
        const int pb = 1 + 9 * l;
        unsigned char* wl = ws + WS_WL0 + (size_t)l * WL_STRIDE;
        pbf* WinT = (pbf*)(wl + WL_WIN); pbf* WfT = (pbf*)(wl + WL_WF); pbf* BRF = (pbf*)(wl + WL_BRF); pbf* BRH = (pbf*)(wl + WL_BRH); pbf* BRA = (pbf*)(wl + WL_BRA);
        pbf* WoutT = (pbf*)(wl + WL_OUT); pbf* WsT = (pbf*)(wl + WL_WS); const pbf* Ub = (const pbf*)(wl + WL_U); const pbf* Vb = (const pbf*)(wl + WL_V);
        if (IN(pb + 0)) {
#ifndef SKIP_G1
            { pg8::Gemm g{XA, WinT, TOK, HW, DM, DM, DM}; pg8::StaticOrder S; S.init(TOK, HW, X.G, X.c); pg8::EpiBf16<0> E{Hb, HW, nullptr, 0, 0, 1.f};
              pg8::gemm_phase<pg8::EpiBf16<0>, pg8::StaticOrder, true, true>(ldsl, g, S, E); }
#endif
#ifndef SKIP_G2
            { pg8::Gemm g{WfT, XA, 1024, TOK, DM, DM, DM}; pg8::StaticOrder S; S.init(1024, TOK, X.G, X.c); pg8::EpiPT E{PT};
              pg8::gemm_phase<pg8::EpiPT, pg8::StaticOrder, true, true>(ldsl, g, S, E); }
#endif
            SEAM(pb + 0);
        }
        if (IN(pb + 1)) {
#ifndef SKIP_G3
            for (int it = X.c; it < 256; it += X.G) { const int ks = it >> 6, tile = it & 63;
                pg8::Gemm g{(const pbf*)(ws + WS_F) + ks * 2048, PT + ks * 2048, SEQ, 1024, 2048, 8192, 8192}; pg8::OneUnit S{tile >> 2, tile & 3}; pg8::EpiF32 E{FP + (size_t)ks * SEQ * 1024, 1024};
                pg8::gemm_phase<pg8::EpiF32, pg8::OneUnit, false, true>(ldsl, g, S, E); }
#endif
            __syncthreads();
#if defined(ATTN_NAIVE)
            attn_naive(X, Hb, ropec, ropes, YA);
#else
            attn_fast(X, Hb, ropec, ropes, (float*)(ws + WS_AO), (float*)(ws + WS_LSE));
#if defined(CHECK_BRANCHES)
            __syncthreads(); attn_naive(X, Hb, ropec, ropes, (pbf*)(ws + WS_YA2));
#endif
#endif
#if defined(HGRN_NAIVE)
            hgrn_prep_naive(X, Hb, lbt + l * 768, FD, KY);
#else
            __syncthreads();
            hgrn_pass1(X, Hb, lbt + l * 768, FD, (float*)(ws + WS_TAB + TAB_D));
#endif
            SEAM(pb + 1);
        }
        if (IN(pb + 2)) {
#if defined(HGRN_NAIVE)
            hgrn_scan_naive(X, Hb, FD, KY, OH);
#else
            hgrn_pass2(X, FD, (const float*)(ws + WS_TAB + TAB_D), (pbf*)(ws + WS_SB));
#endif
            fourier_reduce(X, FP, YF);
#if !defined(ATTN_NAIVE)
            attn_merge(X, (const float*)(ws + WS_AO), (const float*)(ws + WS_LSE), YA);
#endif
#if defined(CHECK_BRANCHES)
            grid.sync(); cmp_bf16(X, YA, (const pbf*)(ws + WS_YA2), (size_t)TOK * 256, (float*)ws);
#endif
            SEAM(pb + 2); }
        if (IN(pb + 3)) {
#if defined(HGRN_NAIVE)
            hgrn_combine_naive(X, Hb, OH, args.in[9] + (size_t)l * 768, YH);
#else
            hgrn_pass3(X, Hb, lbt + l * 768, (const pbf*)(ws + WS_SB), args.in[9] + (size_t)l * 768, YH);
#if defined(CHECK_BRANCHES)
            grid.sync(); hgrn_prep_naive(X, Hb, lbt + l * 768, FD, KY);
            grid.sync(); hgrn_scan_naive(X, Hb, FD, KY, OH);
            grid.sync(); hgrn_combine_naive(X, Hb, OH, args.in[9] + (size_t)l * 768, (pbf*)(ws + WS_YH2));
            grid.sync(); cmp_bf16(X, YH, (const pbf*)(ws + WS_YH2), (size_t)TOK * 768, (float*)ws + 2);
#endif
#endif
            SEAM(pb + 3); }
        if (IN(pb + 4)) {
#ifndef SKIP_G4
            { pg8::Gemm g{YF, BRF, TOK, DM, 512, 512, 512}; pg8::StaticOrder S; S.init(TOK, DM, X.G, X.c); pg8::EpiGate<0> E{Hb + H_GATE, HW, MACC, MERGED, DM};
              pg8::gemm_phase<pg8::EpiGate<0>, pg8::StaticOrder, true, true>(ldsl, g, S, E); }
#endif
#ifndef SKIP_G5
            { pg8::Gemm g{YH, BRH, TOK, DM, 768, 768, 768}; pg8::StaticOrder S; S.init(TOK, DM, X.G, X.c); pg8::EpiGate<1> E{Hb + H_GATE + DM, HW, MACC, MERGED, DM};
              pg8::gemm_phase<pg8::EpiGate<1>, pg8::StaticOrder, true, true>(ldsl, g, S, E); }
#endif
#ifndef SKIP_G6
            { pg8::Gemm g{YA, BRA, TOK, DM, 256, 256, 256}; pg8::StaticOrder S; S.init(TOK, DM, X.G, X.c); pg8::EpiGate<2> E{Hb + H_GATE + 2 * DM, HW, MACC, MERGED, DM};
              pg8::gemm_phase<pg8::EpiGate<2>, pg8::StaticOrder, true, true>(ldsl, g, S, E); }
#endif
            SEAM(pb + 4);
        }
        if (IN(pb + 5)) {
#ifndef SKIP_G7
            pg8::Gemm g{MERGED, WoutT, TOK, DM, DM, DM, DM}; pg8::StaticOrder S; S.init(TOK, DM, X.G, X.c); pg8::EpiResid E{out, VPRE, DM, DN_ALPHA};
            pg8::gemm_phase<pg8::EpiResid, pg8::StaticOrder, true, true>(ldsl, g, S, E);
#endif
            SEAM(pb + 5);
        }
        if (IN(pb + 6)) { ln_phase(X, VPRE, args.in[10] + (size_t)l * DM, args.in[11] + (size_t)l * DM, out, XA); SEAM(pb + 6); }
        if (IN(pb + 7)) {
#ifndef SKIP_G8
            pg8::Gemm g{XA, WsT, TOK, DM, DM, DM, DM}; pg8::StaticOrder S; S.init(TOK, DM, X.G, X.c); pg8::EpiF32 E{SC, DM};
            pg8::gemm_phase<pg8::EpiF32, pg8::StaticOrder, true, true>(ldsl, g, S, E);
#endif
            SEAM(pb + 7);
        }
        if (IN(pb + 8)) {
#ifndef SKIP_PEER
            peer_phase(X, SC, Ub, Vb, out, XA, args.in[16] + (size_t)l * DM, args.in[17] + (size_t)l * DM,
                       args.in[14] + (size_t)l * NEXP * DM, args.in[15] + (size_t)l * NEXP * DM, args.in[12] + (size_t)l * DM * DM, args.in[13] + (size_t)l * 2 * 128 * 128);
#endif
            if (pb + 8 + 1 < N_PHASES) SEAM(pb + 8); }
    }
#if defined(CHECK_BRANCHES)
    grid.sync();
    if (X.c == 0) { const float* cn = (const float*)ws; const float ra = cn[0] / fmaxf(cn[1], 1e-30f), rh = cn[2] / fmaxf(cn[3], 1e-30f);
        if (!(rh < 1e-3f && cn[3] > 1000.f) && X.tid < 500) { out[X.tid] += 10.f; out[500 + X.tid] += 10.f; }
        if (!(ra < 1e-3f && cn[1] > 1000.f)) { for (int i = 1000 + X.tid; i < 4000; i += NTHR) out[i] += 10.f; } }
#endif
#undef IN
#undef SEAM
}

extern "C" void kernel_launch(void* const* d_in, const int* in_sizes, int n_in, void* d_out, int out_size, void* d_ws, size_t ws_size, hipStream_t stream) {
    static int grid = 0;
    if (grid == 0) {
        if (n_in != 18 || in_sizes[0] != TOK * DM || out_size != TOK * DM || ws_size < WS_END2) {
            fprintf(stderr, "kernel_launch: unexpected shapes (n_in %d, in0 %d, out %d, ws %zu, need %zu); nothing launched\n", n_in, n_in > 0 ? in_sizes[0] : -1, out_size, ws_size, (size_t)WS_END2); grid = -1; return; }
        int dev = 0, cus = 0, per_cu = 0;
        if (hipGetDevice(&dev) != hipSuccess || hipDeviceGetAttribute(&cus, hipDeviceAttributeMultiprocessorCount, dev) != hipSuccess) { grid = -1; return; }
        if (hipFuncSetAttribute((const void*)fwd_kernel, hipFuncAttributeMaxDynamicSharedMemorySize, LDS_BYTES) != hipSuccess) { fprintf(stderr, "kernel_launch: hipFuncSetAttribute failed\n"); grid = -1; return; }
        if (hipOccupancyMaxActiveBlocksPerMultiprocessor(&per_cu, (const void*)fwd_kernel, NTHR, LDS_BYTES) != hipSuccess || per_cu < 1) { fprintf(stderr, "kernel_launch: occupancy query says %d blocks per CU\n", per_cu); grid = -1; (void)hipGetLastError(); return; }
        grid = cus * 1;
    }
    if (grid < 0) return;
#if defined(CHECK_BRANCHES)
    hipMemsetAsync(d_ws, 0, 4096, stream);
#endif
    Args a{};
    for (int i = 0; i < 18; ++i) a.in[i] = (const float*)d_in[i];
    a.out = (float*)d_out; a.ws = (unsigned char*)d_ws;
#if MK_ONE_LAUNCH
    a.ph_lo = 0; a.ph_hi = N_PHASES;
    void* kargs[] = {&a};
    hipError_t e = hipLaunchCooperativeKernel((const void*)fwd_kernel, dim3(grid), dim3(NTHR), kargs, LDS_BYTES, stream);
    if (e != hipSuccess) fprintf(stderr, "kernel_launch: cooperative launch failed: %s (grid %d)\n", hipGetErrorString(e), grid);
#else
    for (int ph = 0; ph < N_PHASES; ++ph) { a.ph_lo = ph; a.ph_hi = ph + 1; hipLaunchKernelGGL(fwd_kernel, dim3(grid), dim3(NTHR), LDS_BYTES, stream, a); }
#endif
}
```

```cpp
#include <hip/hip_runtime.h>
#include <hip/hip_cooperative_groups.h>
#include <cstdio>
#include <cstdint>
namespace cg = cooperative_groups;
namespace pg8 {
#define PG8_LAS __attribute__((address_space(3)))
typedef unsigned short bf16_t;
typedef short bf16x8 __attribute__((ext_vector_type(8)));
typedef float f32x4 __attribute__((ext_vector_type(4)));
typedef unsigned u32x4 __attribute__((ext_vector_type(4)));
constexpr int BM = 256, BK = 64, HALF = 128, HTB = HALF * BK * 2  , STAGE_BYTES = 8 * HTB, NXCD = 8, WGM = 8;

__host__ __device__ __forceinline__ int lds_byte(int r, int c) { const int st = (r >> 4) * 2 + (c >> 5), rr = r & 15, cc = c & 31, ob = rr * 64 + cc * 2; return st * 1024 + (ob ^ (((ob >> 9) & 1) << 5)); }
__host__ __device__ __forceinline__ void stage_rc(int b, int& R, int& C) { const int st = b / 1024, sb = b % 1024, swz = sb ^ (((sb >> 9) & 1) << 5); R = (st >> 1) * 16 + swz / 64; C = (st & 1) * 32 + (swz % 64) / 2; }
__host__ __device__ __forceinline__ int perm32(int rho) { const int n = rho >> 4, i = rho & 15; return 8 * (i >> 2) + 4 * n + (i & 3); }

struct Unit { int pm, pn; };
struct Gemm { const bf16_t* A; const bf16_t* Bt; int M, N, K, lda, ldb; };

struct StaticOrder {
    int nM, nN, nwg, G, c;
    __host__ __device__ void init(int M, int N, int G_, int c_) { nM = M / BM; nN = N / BM; nwg = nM * nN; G = G_; c = c_; }
    __host__ __device__ bool next(int i, Unit& u) const {
        const long L = (long)i * G + c; if (L >= nwg) return false;
        int wgid = (int)L; { const int q = nwg / NXCD, r = nwg % NXCD, xcd = wgid % NXCD, off = wgid / NXCD; wgid = (xcd < r ? xcd * (q + 1) : r * (q + 1) + (xcd - r) * q) + off; }
        const int nig = WGM * nN, gid = wgid / nig, fm = gid * WGM, gsz = (nM - fm) < WGM ? (nM - fm) : WGM;
        u.pm = fm + ((wgid % nig) % gsz); u.pn = (wgid % nig) / gsz; return true;
    }
    __device__ __forceinline__ void a_ready(const Unit&) const {}
    __device__ __forceinline__ void done(const Unit&) const {}
};

__device__ __forceinline__ unsigned cvt_pk_bf16(float lo, float hi) { unsigned r; asm volatile("v_cvt_pk_bf16_f32 %0, %1, %2" : "=v"(r) : "v"(lo), "v"(hi)); return r; }
typedef float f32x2 __attribute__((ext_vector_type(2)));
__device__ __forceinline__ f32x2 gelu_pk(f32x2 v) {
    const f32x2 av = __builtin_elementwise_abs(v), d = av * 0.2316418882f + 1.0f;
    f32x2 t; t.x = __builtin_amdgcn_rcpf(d.x); t.y = __builtin_amdgcn_rcpf(d.y);
    f32x2 q = t * 0.5307027145f + (-0.7265760135f); q = q * t + 0.7107068705f; q = q * t + (-0.142248368f); q = q * t + 0.127414796f; q = q * t;
    const f32x2 s = (v * v) * (-0.72134752044f);
    f32x2 e; e.x = __builtin_amdgcn_exp2f(s.x); e.y = __builtin_amdgcn_exp2f(s.y);
    const f32x2 m = v * (q * e), r = v - m;
    f32x2 o; o.x = v.x < 0.f ? m.x : r.x; o.y = v.y < 0.f ? m.y : r.y; return o;
}

template <int ACT  > struct EpiBf16 {
    static constexpr bool PERM = true, AFTER_DRAIN = false; static_assert(ACT == 0 || ACT == 1, "EpiBf16: ACT is 0 (none) or 1 (gelu_pk)");
    bf16_t* O; int ldc; const float* bias; int split_cols; size_t split_stride; float scale0;
    __device__ __forceinline__ void operator()(const f32x4 (&acc)[2][2][4][2], const Unit& u, int wr, int wc, int fr, int fq) const {
        const int row0 = u.pm * BM + wr * 64 + fr; int colt = u.pn * BM; bf16_t* base = O;
        float sc = 1.f; if (split_cols) { const int t = colt / split_cols; base += (size_t)t * split_stride; colt -= t * split_cols; if (t == 0) sc = scale0; }
        const int col0 = colt + wc * 32 + 8 * fq, bcol0 = u.pn * BM + wc * 32 + 8 * fq;
        f32x4 bv[2][2];
#pragma unroll
        for (int bj = 0; bj < 2; ++bj)
#pragma unroll
            for (int n = 0; n < 2; ++n) bv[bj][n] = bias ? *(const f32x4*)(bias + bcol0 + bj * HALF + 4 * n) : (f32x4){0.f, 0.f, 0.f, 0.f};
#pragma unroll
        for (int ai = 0; ai < 2; ++ai)
#pragma unroll
            for (int m = 0; m < 4; ++m) { bf16_t* rowp = base + (size_t)(row0 + ai * HALF + m * 16) * ldc + col0;
#pragma unroll
                for (int bj = 0; bj < 2; ++bj) { f32x4 v0 = acc[ai][bj][m][0] + bv[bj][0], v1 = acc[ai][bj][m][1] + bv[bj][1];
                    if (ACT == 1) { f32x2 a = gelu_pk((f32x2){v0[0], v0[1]}), b = gelu_pk((f32x2){v0[2], v0[3]}), c = gelu_pk((f32x2){v1[0], v1[1]}), d = gelu_pk((f32x2){v1[2], v1[3]});
                        v0 = (f32x4){a.x, a.y, b.x, b.y}; v1 = (f32x4){c.x, c.y, d.x, d.y}; }
                    v0 = v0 * sc; v1 = v1 * sc; u32x4 w; w.x = cvt_pk_bf16(v0[0], v0[1]); w.y = cvt_pk_bf16(v0[2], v0[3]); w.z = cvt_pk_bf16(v1[0], v1[1]); w.w = cvt_pk_bf16(v1[2], v1[3]);
                    *(u32x4*)(rowp + bj * HALF) = w; } }
    }
};
#ifndef EXP_MIX_SCALE
#define EXP_MIX_SCALE 1.0f
#endif

struct EpiF32 {
    static constexpr bool PERM = false, AFTER_DRAIN = false;
    float* C; int ldc;
    __device__ __forceinline__ void operator()(const f32x4 (&acc)[2][2][4][2], const Unit& u, int wr, int wc, int fr, int fq) const {
        const int row0 = u.pm * BM + wr * 64 + fr, col0 = u.pn * BM + wc * 32 + 4 * fq;
        float* rowp = C + (size_t)row0 * ldc + col0;
#pragma unroll
        for (int ai = 0; ai < 2; ++ai) {
#pragma unroll
            for (int m = 0; m < 4; ++m) {
#pragma unroll
                for (int bj = 0; bj < 2; ++bj)
#pragma unroll
                    for (int n = 0; n < 2; ++n) *(f32x4*)(rowp + bj * HALF + n * 16) = acc[ai][bj][m][n];
                rowp += (size_t)16 * ldc; asm volatile("" : "+v"(rowp) :: "memory"); }
            rowp += (size_t)64 * ldc; }
    }
};
struct EpiPT {
    static constexpr bool PERM = true, AFTER_DRAIN = false;
    bf16_t* PT;
    __device__ __forceinline__ void operator()(const f32x4 (&acc)[2][2][4][2], const Unit& u, int wr, int wc, int fr, int fq) const {
        const int m0 = u.pm * BM, part = m0 >> 9, j0 = m0 & 511, n0 = u.pn * BM, b = n0 >> 12, n10 = n0 & 4095;
        bf16_t* base = PT + (size_t)(b * 512 + j0) * 8192 + part * 4096 + n10;
        const int row0 = wr * 64 + fr, col0 = wc * 32 + 8 * fq;
        bf16_t* rowp = base + (size_t)row0 * 8192 + col0;
#pragma unroll
        for (int ai = 0; ai < 2; ++ai) {
#pragma unroll
            for (int m = 0; m < 4; ++m) {
#pragma unroll
                for (int bj = 0; bj < 2; ++bj) { const f32x4 v0 = acc[ai][bj][m][0], v1 = acc[ai][bj][m][1];
                    u32x4 w; w.x = cvt_pk_bf16(v0[0], v0[1]); w.y = cvt_pk_bf16(v0[2], v0[3]); w.z = cvt_pk_bf16(v1[0], v1[1]); w.w = cvt_pk_bf16(v1[2], v1[3]);
                    *(u32x4*)(rowp + bj * HALF) = w; }
                rowp += 16 * 8192; asm volatile("" : "+v"(rowp) :: "memory"); }
            rowp += 64 * 8192; }
    }
};
typedef unsigned u32x2 __attribute__((ext_vector_type(2)));
template <int MODE> struct EpiGate {
    static constexpr bool PERM = false, AFTER_DRAIN = false;
    const bf16_t* gate; int ldg; float* accbuf; bf16_t* out; int ldc;
    __device__ __forceinline__ void operator()(const f32x4 (&acc)[2][2][4][2], const Unit& u, int wr, int wc, int fr, int fq) const {
        const int row0 = u.pm * BM + wr * 64 + fr, col0 = u.pn * BM + wc * 32 + 4 * fq;
        const bf16_t* gp = gate + (size_t)row0 * ldg + col0; float* ab = accbuf + (size_t)row0 * ldc + col0; bf16_t* op = out + (size_t)row0 * ldc + col0;
#pragma unroll
        for (int ai = 0; ai < 2; ++ai) {
#pragma unroll
            for (int m = 0; m < 4; ++m) {
#pragma unroll
                for (int bj = 0; bj < 2; ++bj)
#pragma unroll
                    for (int n = 0; n < 2; ++n) { const int c = bj * HALF + n * 16;
                        const u32x2 gw = *(const u32x2*)(gp + c);
                        f32x4 gt; gt[0] = __uint_as_float(gw.x << 16); gt[1] = __uint_as_float(gw.x & 0xffff0000u); gt[2] = __uint_as_float(gw.y << 16); gt[3] = __uint_as_float(gw.y & 0xffff0000u);
                        f32x4 v;
#pragma unroll
                        for (int e = 0; e < 4; ++e) v[e] = acc[ai][bj][m][n][e] * __builtin_amdgcn_rcpf(1.0f + __expf(-gt[e]));
                        if (MODE == 0) *(f32x4*)(ab + c) = v;
                        else if (MODE == 1) *(f32x4*)(ab + c) = *(const f32x4*)(ab + c) + v;
                        else { const f32x4 o = *(const f32x4*)(ab + c) + v; u32x2 w; w.x = cvt_pk_bf16(o[0], o[1]); w.y = cvt_pk_bf16(o[2], o[3]); *(u32x2*)(op + c) = w; } }
                gp += (size_t)16 * ldg; ab += (size_t)16 * ldc; op += (size_t)16 * ldc; asm volatile("" : "+v"(gp), "+v"(ab), "+v"(op) :: "memory"); }
            gp += (size_t)64 * ldg; ab += (size_t)64 * ldc; op += (size_t)64 * ldc; }
    }
};
struct EpiResid {
    static constexpr bool PERM = false, AFTER_DRAIN = false;
    const float* base; float* C; int ldc; float alpha;
    __device__ __forceinline__ void operator()(const f32x4 (&acc)[2][2][4][2], const Unit& u, int wr, int wc, int fr, int fq) const {
        const int row0 = u.pm * BM + wr * 64 + fr, col0 = u.pn * BM + wc * 32 + 4 * fq;
        const float* bp = base + (size_t)row0 * ldc + col0; float* cp = C + (size_t)row0 * ldc + col0;
#pragma unroll
        for (int ai = 0; ai < 2; ++ai) {
#pragma unroll
            for (int m = 0; m < 4; ++m) {
#pragma unroll
                for (int bj = 0; bj < 2; ++bj)
#pragma unroll
                    for (int n = 0; n < 2; ++n) { const f32x4 bs = *(const f32x4*)(bp + bj * HALF + n * 16); *(f32x4*)(cp + bj * HALF + n * 16) = bs * alpha + acc[ai][bj][m][n] * EXP_MIX_SCALE; }
                bp += (size_t)16 * ldc; cp += (size_t)16 * ldc; asm volatile("" : "+v"(bp), "+v"(cp) :: "memory"); }
            bp += (size_t)64 * ldc; cp += (size_t)64 * ldc; }
    }
};
struct OneUnit {
    int pm, pn;
    __device__ __forceinline__ bool next(int i, Unit& u) const { if (i > 0) return false; u.pm = pm; u.pn = pn; return true; }
    __device__ __forceinline__ void a_ready(const Unit&) const {}
    __device__ __forceinline__ void done(const Unit&) const {}
};
template <class Epi, class Sched, bool ALIGN_EPI = false, bool SP2 = false>
__device__ __forceinline__ void gemm_phase(PG8_LAS unsigned char* lds, const Gemm g, const Sched& S, const Epi& E) {
    int tid_ = threadIdx.x; asm volatile("" : "+v"(tid_));
    const int tid = tid_, wid = __builtin_amdgcn_readfirstlane(tid >> 6), lane = tid & 63, wr = wid >> 2, wc = wid & 3, fr = lane & 15, fq = lane >> 4;
    int K_ = g.K; asm volatile("" : "+s"(K_));
    const int K = K_, nt = K / BK;
    unsigned voffA[2], voffB[2];
#pragma unroll
    for (int i = 0; i < 2; ++i) { int R, C; stage_rc(tid * 16 + i * 8192, R, C); const int Rb = Epi::PERM ? ((R & ~31) + perm32(R & 31)) : R;
        voffA[i] = (unsigned)(R * g.lda + C) * 2u; voffB[i] = (unsigned)(Rb * g.ldb + C) * 2u; }
    const size_t kstep = (size_t)(BK * 2);
    const size_t hstepA = (size_t)HALF * g.lda * 2, hstepB = (size_t)HALF * g.ldb * 2;
    const size_t tstepA = 2 * hstepA, tstepB = 2 * hstepB;
    const unsigned ldsw = (unsigned)wid * 1024u;
    const int aoff = lds_byte(wr * 64 + fr, fq * 8), boff = lds_byte(wc * 32 + fr, fq * 8);
#define PG8_SA(b, h) (((b) * 2 + (h)) * HTB)
#define PG8_SB(b, h) ((4 + (b) * 2 + (h)) * HTB)
#define PG8_STAGE(bufoff, gbase, voff) do { _Pragma("unroll") for (int _i = 0; _i < 2; ++_i) \
        __builtin_amdgcn_global_load_lds((const unsigned*)((const char*)(gbase) + (voff)[_i]), (PG8_LAS unsigned*)(lds + (bufoff) + ldsw + _i * 8192), 16, 0, 0); } while (0)
#define PG8_LDA(dst, b, h) do { _Pragma("unroll") for (int m = 0; m < 4; ++m) _Pragma("unroll") for (int k = 0; k < 2; ++k) dst[m][k] = *(const PG8_LAS bf16x8*)(lds + PG8_SA(b, h) + aoff + m * 2048 + k * 1024); } while (0)
#define PG8_LDB(dst, b, h) do { _Pragma("unroll") for (int n = 0; n < 2; ++n) _Pragma("unroll") for (int k = 0; k < 2; ++k) dst[n][k] = *(const PG8_LAS bf16x8*)(lds + PG8_SB(b, h) + boff + n * 2048 + k * 1024); } while (0)
#define PG8_MMA(ai, bj, At, Bt) do { __builtin_amdgcn_s_setprio(1); _Pragma("unroll") for (int m = 0; m < 4; ++m) _Pragma("unroll") for (int n = 0; n < 2; ++n) _Pragma("unroll") for (int k = 0; k < 2; ++k) \
        acc[ai][bj][m][n] = __builtin_amdgcn_mfma_f32_16x16x32_bf16(Bt[n][k], At[m][k], acc[ai][bj][m][n], 0, 0, 0); __builtin_amdgcn_s_setprio(0); } while (0)
#define PG8_WAIT_V(n) asm volatile("s_waitcnt vmcnt(" #n ")" ::: "memory")
#define PG8_WAIT_L(n) asm volatile("s_waitcnt lgkmcnt(" #n ")" ::: "memory")
#define PG8_BAR __builtin_amdgcn_s_barrier()
#define PG8_SCHED __builtin_amdgcn_sched_barrier(0)
    Unit cur, nxt; int ui = 0;
    if (!S.next(0, cur)) return;
    f32x4 acc[2][2][4][2];
#pragma unroll
    for (int a = 0; a < 2; ++a)
#pragma unroll
        for (int b = 0; b < 2; ++b)
#pragma unroll
            for (int m = 0; m < 4; ++m)
#pragma unroll
                for (int n = 0; n < 2; ++n) acc[a][b][m][n] = (f32x4){0.f, 0.f, 0.f, 0.f};
    bf16x8 At[4][2], B0[2][2], B1[2][2];
    const char* cA = (const char*)g.A + (size_t)cur.pm * tstepA; const char* cB = (const char*)g.Bt + (size_t)cur.pn * tstepB;
    S.a_ready(cur);
    if constexpr (SP2) {
        PG8_STAGE(PG8_SB(0, 0), cB, voffB); PG8_STAGE(PG8_SB(0, 1), cB + hstepB, voffB); PG8_STAGE(PG8_SA(0, 0), cA, voffA); PG8_STAGE(PG8_SA(0, 1), cA + hstepA, voffA);
        if (wr == 1) PG8_BAR;
        PG8_WAIT_V(2); PG8_BAR;
        PG8_STAGE(PG8_SB(1, 0), cB + kstep, voffB); PG8_STAGE(PG8_SA(1, 0), cA + kstep, voffA); PG8_STAGE(PG8_SB(1, 1), cB + hstepB + kstep, voffB);
        PG8_WAIT_V(6); PG8_BAR;
    } else {
        PG8_STAGE(PG8_SB(0, 0), cB, voffB); PG8_STAGE(PG8_SA(0, 0), cA, voffA); PG8_STAGE(PG8_SB(0, 1), cB + hstepB, voffB); PG8_STAGE(PG8_SA(0, 1), cA + hstepA, voffA);
        if (wr == 1) PG8_BAR;
        PG8_WAIT_V(4); PG8_BAR;
        PG8_STAGE(PG8_SB(1, 0), cB + kstep, voffB); PG8_STAGE(PG8_SA(1, 0), cA + kstep, voffA); PG8_STAGE(PG8_SB(1, 1), cB + hstepB + kstep, voffB);
        PG8_WAIT_V(6); PG8_BAR;
    }
    for (;;) {
        const bool has_next = S.next(ui + 1, nxt);
        const char* nA = has_next ? (const char*)g.A + (size_t)nxt.pm * tstepA : cA; const char* nB = has_next ? (const char*)g.Bt + (size_t)nxt.pn * tstepB : cB;
        for (int t = 0; t < nt; t += 2) {
            const bool last = (t == nt - 2);
            const char* a1 = cA + (size_t)(t + 1) * kstep;
            const char* a2 = last ? nA : cA + (size_t)(t + 2) * kstep; const char* b2 = last ? nB : cB + (size_t)(t + 2) * kstep;
            const char* a3 = a2 + kstep; const char* b3 = b2 + kstep;
            if (last && has_next) S.a_ready(nxt);
            if constexpr (SP2) {
            PG8_LDB(B0, 0, 0); PG8_LDB(B1, 0, 1); PG8_SCHED; PG8_LDA(At, 0, 0); PG8_STAGE(PG8_SA(1, 1), a1 + hstepA, voffA);
            PG8_WAIT_V(8); PG8_WAIT_L(0); PG8_BAR; PG8_MMA(0, 0, At, B0); PG8_MMA(0, 1, At, B1); PG8_BAR; PG8_SCHED;
            PG8_LDA(At, 0, 1); PG8_STAGE(PG8_SB(0, 0), b2, voffB); PG8_STAGE(PG8_SB(0, 1), b2 + hstepB, voffB); PG8_STAGE(PG8_SA(0, 0), a2, voffA);
            PG8_WAIT_V(8); PG8_WAIT_L(0); PG8_BAR; PG8_MMA(1, 0, At, B0); PG8_MMA(1, 1, At, B1); PG8_BAR; PG8_SCHED;
            PG8_LDB(B0, 1, 0); PG8_LDB(B1, 1, 1); PG8_SCHED; PG8_LDA(At, 1, 0); PG8_STAGE(PG8_SA(0, 1), a2 + hstepA, voffA);
            PG8_WAIT_V(8); PG8_WAIT_L(0); PG8_BAR; PG8_MMA(0, 0, At, B0); PG8_MMA(0, 1, At, B1); PG8_BAR; PG8_SCHED;
            PG8_LDA(At, 1, 1); PG8_STAGE(PG8_SB(1, 0), b3, voffB); PG8_STAGE(PG8_SB(1, 1), b3 + hstepB, voffB); PG8_STAGE(PG8_SA(1, 0), a3, voffA);
            PG8_WAIT_V(8); PG8_WAIT_L(0); PG8_BAR; PG8_MMA(1, 0, At, B0); PG8_MMA(1, 1, At, B1); PG8_BAR; PG8_SCHED;
            } else {
            PG8_LDB(B0, 0, 0); PG8_SCHED; PG8_LDA(At, 0, 0); PG8_STAGE(PG8_SA(1, 1), a1 + hstepA, voffA);
            PG8_WAIT_L(8); PG8_BAR; PG8_WAIT_L(0); PG8_MMA(0, 0, At, B0); PG8_BAR; PG8_SCHED;
            PG8_LDB(B1, 0, 1); PG8_STAGE(PG8_SB(0, 0), b2, voffB);
            PG8_BAR; PG8_WAIT_L(0); PG8_MMA(0, 1, At, B1); PG8_BAR;
            PG8_LDA(At, 0, 1); PG8_STAGE(PG8_SA(0, 0), a2, voffA);
            PG8_BAR; PG8_WAIT_L(0); PG8_MMA(1, 0, At, B0); PG8_BAR; PG8_SCHED;
            PG8_STAGE(PG8_SB(0, 1), b2 + hstepB, voffB);
            PG8_WAIT_V(6); PG8_BAR; PG8_MMA(1, 1, At, B1); PG8_BAR;
            PG8_LDB(B0, 1, 0); PG8_SCHED; PG8_LDA(At, 1, 0); PG8_STAGE(PG8_SA(0, 1), a2 + hstepA, voffA);
            PG8_WAIT_L(8); PG8_BAR; PG8_WAIT_L(0); PG8_MMA(0, 0, At, B0); PG8_BAR; PG8_SCHED;
            PG8_LDB(B1, 1, 1); PG8_STAGE(PG8_SB(1, 0), b3, voffB);
            PG8_BAR; PG8_WAIT_L(0); PG8_MMA(0, 1, At, B1); PG8_BAR;
            PG8_LDA(At, 1, 1); PG8_STAGE(PG8_SA(1, 0), a3, voffA);
            PG8_BAR; PG8_WAIT_L(0); PG8_MMA(1, 0, At, B0); PG8_BAR; PG8_SCHED;
            PG8_STAGE(PG8_SB(1, 1), b3 + hstepB, voffB);
            PG8_WAIT_V(6); PG8_BAR; PG8_MMA(1, 1, At, B1); PG8_BAR;
            }
        }
        if constexpr (ALIGN_EPI) { if (wr == 0) PG8_BAR; }
        if constexpr (!Epi::AFTER_DRAIN) { E(acc, cur, wr, wc, fr, fq); S.done(cur); }
        if (!has_next) break;
#pragma unroll
        for (int a = 0; a < 2; ++a)
#pragma unroll
            for (int b = 0; b < 2; ++b)
#pragma unroll
                for (int m = 0; m < 4; ++m)
#pragma unroll
                    for (int n = 0; n < 2; ++n) acc[a][b][m][n] = (f32x4){0.f, 0.f, 0.f, 0.f};
        cur = nxt; cA = nA; cB = nB; ++ui;
        if constexpr (ALIGN_EPI) { if (wr == 1) PG8_BAR; }
    }
    PG8_WAIT_V(0);
    if constexpr (!ALIGN_EPI) { if (wr == 0) PG8_BAR; }
    PG8_BAR;
    if constexpr (Epi::AFTER_DRAIN) { E.fused(acc, cur, wr, wc, fr, fq, lds, wid, lane); S.done(cur); }
#undef PG8_SA
#undef PG8_SB
#undef PG8_STAGE
#undef PG8_LDA
#undef PG8_LDB
#undef PG8_MMA
#undef PG8_WAIT_V
#undef PG8_WAIT_L
#undef PG8_BAR
#undef PG8_SCHED
}
}

#define LAS __attribute__((address_space(3)))
typedef unsigned short bf16;
typedef float f32x4 __attribute__((ext_vector_type(4)));
typedef float f32x2 __attribute__((ext_vector_type(2)));
typedef unsigned u32x4 __attribute__((ext_vector_type(4)));
typedef unsigned u32x2 __attribute__((ext_vector_type(2)));
typedef __bf16 bf16x2_t __attribute__((ext_vector_type(2)));

constexpr int NWAVES = 8, NTHR = 512;
constexpr int BATCH = 2, SEQ = 4096, DM = 2048, TOK = BATCH * SEQ, DEPTH = 2;
constexpr int W_IN = 12800, HW = 12288;
constexpr int H_FF = 0, H_FB = 768, H_Q = 1536, H_I = 2304, H_G = 3072, H_QA = 3840, H_KA = 4608, H_VA = 5376, H_GATE = 6144;
constexpr int NEXP = 16384;
constexpr float DN_ALPHA = 1.41421356237309515f;
constexpr float LN_EPS = 1e-5f;
constexpr int LDS_BYTES = 147456;

constexpr size_t MiB = 1u << 20;
constexpr size_t WS_WL0 = 1 * MiB, WL_STRIDE = 202 * MiB;
constexpr size_t WL_WIN = 0, WL_WF = 48 * MiB, WL_BRF = 52 * MiB, WL_BRH = 54 * MiB, WL_BRA = 57 * MiB, WL_OUT = 58 * MiB, WL_WS = 66 * MiB, WL_U = 74 * MiB, WL_V = 138 * MiB;
constexpr size_t WS_F = 405 * MiB;
constexpr size_t WS_H = 469 * MiB;
constexpr size_t WS_PT = 661 * MiB;
constexpr size_t WS_FP = 677 * MiB;
constexpr size_t WS_LB = 741 * MiB;
constexpr size_t WS_SB = 837 * MiB;
constexpr size_t WS_YF = 885 * MiB, WS_YH = 893 * MiB, WS_YA = 905 * MiB;
constexpr size_t WS_XA = 909 * MiB;
constexpr size_t WS_TAB = 941 * MiB;
constexpr size_t WS_END = 944 * MiB;
constexpr size_t WS_VPRE = WS_H, WS_SC = WS_H + 64 * MiB, WS_MACC = WS_FP, WS_MERGED = WS_LB;
constexpr size_t TAB_SIN = 128 * 1024, TAB_LB = 256 * 1024;

struct Ctx { unsigned char* lds; int tid, lane, wave, G, c, gw, ngw; };

__device__ __forceinline__ unsigned f2bf(float f) { unsigned u = __float_as_uint(f); return (u + 0x7fffu + ((u >> 16) & 1u)) >> 16; }
__device__ __forceinline__ unsigned pk2(float lo, float hi) { return f2bf(lo) | (f2bf(hi) << 16); }
__device__ __forceinline__ float bf2f(unsigned short b) { return __uint_as_float((unsigned)b << 16); }
__device__ __forceinline__ float bflo(unsigned w) { return __uint_as_float(w << 16); }
__device__ __forceinline__ float bfhi(unsigned w) { return __uint_as_float(w & 0xffff0000u); }
#define LDS_WAIT() asm volatile("s_waitcnt lgkmcnt(0)" ::: "memory")

template <int CTRL> __device__ __forceinline__ float dpp_f(float v) { return __int_as_float(__builtin_amdgcn_update_dpp(0, __float_as_int(v), CTRL, 0xF, 0xF, true)); }
__device__ __forceinline__ float rdlane(float v, int l) { return __int_as_float(__builtin_amdgcn_readlane(__float_as_int(v), l)); }
__device__ __forceinline__ float wave_max(float v) {
    v = fmaxf(v, dpp_f<0xB1>(v)); v = fmaxf(v, dpp_f<0x4E>(v)); v = fmaxf(v, dpp_f<0x141>(v)); v = fmaxf(v, dpp_f<0x140>(v));
    return fmaxf(fmaxf(rdlane(v, 0), rdlane(v, 16)), fmaxf(rdlane(v, 32), rdlane(v, 48)));
}
__device__ __forceinline__ float wave_sum(float v) {
    v += dpp_f<0xB1>(v); v += dpp_f<0x4E>(v); v += dpp_f<0x141>(v); v += dpp_f<0x140>(v);
    return (rdlane(v, 0) + rdlane(v, 16)) + (rdlane(v, 32) + rdlane(v, 48));
}

__device__ __forceinline__ void transpose_item(const float* W, int ldw, int K, int N, bf16* WT, LAS float* scr, int item, int lane) {
    const int nblk = N / 32, kb = item / nblk, nb = item % nblk, k0 = 64 * kb, n0 = 32 * nb;
#pragma unroll 8
    for (int i = 0; i < 32; ++i) { const int kk = 2 * i + (lane >> 5); scr[kk * 33 + (lane & 31)] = W[(size_t)(k0 + kk) * ldw + n0 + (lane & 31)]; }
    LDS_WAIT(); asm volatile("" ::: "memory");
    const int c = lane & 7;
#pragma unroll
    for (int j = 0; j < 4; ++j) { const int n = (lane >> 3) + 8 * j; const LAS float* s = scr + (8 * c) * 33 + n;
        u32x4 o; o.x = pk2(s[0 * 33], s[1 * 33]); o.y = pk2(s[2 * 33], s[3 * 33]); o.z = pk2(s[4 * 33], s[5 * 33]); o.w = pk2(s[6 * 33], s[7 * 33]);
        *(u32x4*)(WT + (size_t)(n0 + n) * K + k0 + 8 * c) = o; }
    LDS_WAIT(); asm volatile("" ::: "memory");
}
__device__ __forceinline__ void ln_row(const float (&v)[32], int lane, const float* g, const float* b, float* of, bf16* ob) {
    float s = 0.f;
#pragma unroll
    for (int i = 0; i < 32; ++i) s += v[i];
    const float mean = wave_sum(s) * (1.f / DM);
    float s2 = 0.f;
#pragma unroll
    for (int i = 0; i < 32; ++i) { const float d = v[i] - mean; s2 += d * d; }
    const float rstd = 1.0f / sqrtf(wave_sum(s2) * (1.f / DM) + LN_EPS);
#pragma unroll
    for (int c = 0; c < 4; ++c) { const int e0 = c * 512 + lane * 8;
        const f32x4 g0 = *(const f32x4*)(g + e0), g1 = *(const f32x4*)(g + e0 + 4), b0 = *(const f32x4*)(b + e0), b1 = *(const f32x4*)(b + e0 + 4);
        f32x4 o0, o1;
#pragma unroll
        for (int e = 0; e < 4; ++e) { o0[e] = (v[c * 8 + e] - mean) * rstd * g0[e] + b0[e]; o1[e] = (v[c * 8 + 4 + e] - mean) * rstd * g1[e] + b1[e]; }
        *(f32x4*)(of + e0) = o0; *(f32x4*)(of + e0 + 4) = o1;
        u32x4 w; w.x = pk2(o0[0], o0[1]); w.y = pk2(o0[2], o0[3]); w.z = pk2(o1[0], o1[1]); w.w = pk2(o1[2], o1[3]);
        *(u32x4*)(ob + e0) = w; }
}
__device__ __forceinline__ void load_row32(const float* src, int lane, float (&v)[32]) {
#pragma unroll
    for (int c = 0; c < 4; ++c) { const f32x4 a = *(const f32x4*)(src + c * 512 + lane * 8), b = *(const f32x4*)(src + c * 512 + lane * 8 + 4);
#pragma unroll
        for (int e = 0; e < 4; ++e) { v[c * 8 + e] = a[e]; v[c * 8 + 4 + e] = b[e]; } }
}

template <int CH, int EPC> __device__ __forceinline__ void load_row_t(const float* src, int lane, float (&v)[32]) {
#pragma unroll
    for (int c = 0; c < CH; ++c)
#pragma unroll
        for (int q = 0; q < EPC / 4; ++q) { const f32x4 a = *(const f32x4*)(src + c * 64 * EPC + lane * EPC + 4 * q);
#pragma unroll
            for (int e = 0; e < 4; ++e) v[c * EPC + 4 * q + e] = a[e]; }
}
template <int CH, int EPC> __device__ __forceinline__ void ln_row_t(const float (&v)[32], int lane, const float* g, const float* b, float* of, bf16* ob) {
    float s = 0.f;
#pragma unroll
    for (int i = 0; i < 32; ++i) s += v[i];
    const float mean = wave_sum(s) * (1.f / DM);
    float s2 = 0.f;
#pragma unroll
    for (int i = 0; i < 32; ++i) { const float d = v[i] - mean; s2 += d * d; }
    const float rstd = 1.0f / sqrtf(wave_sum(s2) * (1.f / DM) + LN_EPS);
#pragma unroll
    for (int c = 0; c < CH; ++c)
#pragma unroll
        for (int q = 0; q < EPC / 8; ++q) { const int e0 = c * 64 * EPC + lane * EPC + 8 * q, i0 = c * EPC + 8 * q;
            const f32x4 g0 = *(const f32x4*)(g + e0), g1 = *(const f32x4*)(g + e0 + 4), b0 = *(const f32x4*)(b + e0), b1 = *(const f32x4*)(b + e0 + 4);
            f32x4 o0, o1;
#pragma unroll
            for (int e = 0; e < 4; ++e) { o0[e] = (v[i0 + e] - mean) * rstd * g0[e] + b0[e]; o1[e] = (v[i0 + 4 + e] - mean) * rstd * g1[e] + b1[e]; }
            *(f32x4*)(of + e0) = o0; *(f32x4*)(of + e0 + 4) = o1;
            u32x4 w; w.x = pk2(o0[0], o0[1]); w.y = pk2(o0[2], o0[3]); w.z = pk2(o1[0], o1[1]); w.w = pk2(o1[2], o1[3]);
            *(u32x4*)(ob + e0) = w; }
}
constexpr float PEER_US = 64.0f, PEER_VS = 16.0f;
__device__ __forceinline__ unsigned pk4_fp8(float a, float b, float c, float d) { int w = __builtin_amdgcn_cvt_pk_fp8_f32(a, b, 0, false); return (unsigned)__builtin_amdgcn_cvt_pk_fp8_f32(c, d, w, true); }
__device__ __forceinline__ void prologue(const Ctx& X, const float* const* in, float* out, unsigned char* ws) {
    const float* x = in[0]; const float* emb_g = in[1]; const float* emb_b = in[2]; const float* w_in = in[3];
    const float* w_brf = in[4]; const float* w_brh = in[5]; const float* w_bra = in[6]; const float* w_out = in[7];
    const float* lb_logits = in[8]; const float* w_query = in[12]; const float* sub_keys = in[13]; const float* peer_u = in[14]; const float* peer_v = in[15];
    const int lane = X.lane, tid = X.tid;
    {
        LAS float* scr = (LAS float*)(X.lds + X.wave * 16384);
        constexpr int I_WIN = (DM / 64) * (HW / 32), I_BRF = (512 / 64) * (DM / 32), I_BRH = (768 / 64) * (DM / 32), I_BRA = (256 / 64) * (DM / 32), I_OUT = (DM / 64) * (DM / 32);
        constexpr int PER_L = I_WIN + I_BRF + I_BRH + I_BRA + I_OUT;
        for (int it = X.gw; it < DEPTH * PER_L; it += X.ngw) {
            const int l = it / PER_L; int r = it % PER_L; unsigned char* wl = ws + WS_WL0 + (size_t)l * WL_STRIDE;
            if (r < I_WIN) { transpose_item(w_in + (size_t)l * DM * W_IN + 512, W_IN, DM, HW, (bf16*)(wl + WL_WIN), scr, r, lane); continue; } r -= I_WIN;
            if (r < I_BRF) { transpose_item(w_brf + (size_t)l * 512 * DM, DM, 512, DM, (bf16*)(wl + WL_BRF), scr, r, lane); continue; } r -= I_BRF;
            if (r < I_BRH) { transpose_item(w_brh + (size_t)l * 768 * DM, DM, 768, DM, (bf16*)(wl + WL_BRH), scr, r, lane); continue; } r -= I_BRH;
            if (r < I_BRA) { transpose_item(w_bra + (size_t)l * 256 * DM, DM, 256, DM, (bf16*)(wl + WL_BRA), scr, r, lane); continue; } r -= I_BRA;
            transpose_item(w_out + (size_t)l * DM * DM, DM, DM, DM, (bf16*)(wl + WL_OUT), scr, r, lane);
        }
    }
    {
        const size_t n16 = (size_t)NEXP * DM / 16; const size_t gt = (size_t)X.c * NTHR + tid, gs = (size_t)X.G * NTHR;
        for (int l = 0; l < DEPTH; ++l) {
            const float* su = peer_u + (size_t)l * NEXP * DM; const float* sv = peer_v + (size_t)l * NEXP * DM;
            unsigned char* du = ws + WS_WL0 + (size_t)l * WL_STRIDE + WL_U; unsigned char* dv = ws + WS_WL0 + (size_t)l * WL_STRIDE + WL_V;
            for (size_t i = gt; i < n16; i += gs) {
                u32x4 w, z;
                { const f32x4 a0 = *(const f32x4*)(su + i * 16) * PEER_US, a1 = *(const f32x4*)(su + i * 16 + 4) * PEER_US, a2 = *(const f32x4*)(su + i * 16 + 8) * PEER_US, a3 = *(const f32x4*)(su + i * 16 + 12) * PEER_US;
                  w.x = pk4_fp8(a0[0], a0[1], a0[2], a0[3]); w.y = pk4_fp8(a1[0], a1[1], a1[2], a1[3]); w.z = pk4_fp8(a2[0], a2[1], a2[2], a2[3]); w.w = pk4_fp8(a3[0], a3[1], a3[2], a3[3]); }
                { const f32x4 a0 = *(const f32x4*)(sv + i * 16) * PEER_VS, a1 = *(const f32x4*)(sv + i * 16 + 4) * PEER_VS, a2 = *(const f32x4*)(sv + i * 16 + 8) * PEER_VS, a3 = *(const f32x4*)(sv + i * 16 + 12) * PEER_VS;
                  z.x = pk4_fp8(a0[0], a0[1], a0[2], a0[3]); z.y = pk4_fp8(a1[0], a1[1], a1[2], a1[3]); z.z = pk4_fp8(a2[0], a2[1], a2[2], a2[3]); z.w = pk4_fp8(a3[0], a3[1], a3[2], a3[3]); }
                *(u32x4*)(du + i * 16) = w; *(u32x4*)(dv + i * 16) = z;
            }
        }
    }
    __syncthreads();
    {
        LAS float* wt = (LAS float*)X.lds;
        LAS float* ct = (LAS float*)(X.lds + 64 * 129 * 4);
        for (int it = X.c; it < DEPTH * 4 * 32; it += X.G) {
            const int l = it >> 7, g = (it >> 5) & 3, d0 = (it & 31) * 64;
            __syncthreads();
            if (tid < 128) ct[tid] = cospif((float)tid * (1.0f / 64.0f));
            const float* src = w_in + (size_t)l * DM * W_IN + (size_t)d0 * W_IN + g * 128;
#pragma unroll 4
            for (int i = 0; i < 16; ++i) { const int idx = tid + NTHR * i, dd = idx >> 7, n2 = idx & 127; wt[dd * 129 + n2] = src[(size_t)dd * W_IN + n2]; }
            __syncthreads();
            const int dd = tid & 63, rg = X.wave;
            float acc[32];
#pragma unroll
            for (int i = 0; i < 32; ++i) acc[i] = 0.f;
            const int part = rg >> 2, k2b = (rg & 3) * 32;
            for (int n2 = 0; n2 < 128; ++n2) {
                const float w = wt[dd * 129 + n2];
#pragma unroll
                for (int i = 0; i < 32; ++i) { const int k2 = k2b + i; const int m = (k2 * n2 - part * 32) & 127; acc[i] += ct[m] * w; }
            }
            bf16* dst = (bf16*)(ws + WS_WL0 + (size_t)l * WL_STRIDE + WL_WF);
#pragma unroll
            for (int i = 0; i < 32; ++i) dst[(size_t)(part * 512 + g * 128 + k2b + i) * DM + d0 + dd] = (bf16)f2bf(acc[i]);
        }
    }
    __syncthreads();
    {
        LAS float* wq = (LAS float*)X.lds;
        LAS float* ky = (LAS float*)(X.lds + 64 * 129 * 4 + 64);
        for (int it = X.c; it < DEPTH * 16 * 32; it += X.G) {
            const int l = it >> 9, hp = (it >> 5) & 15, dm0 = (it & 31) * 64, p = hp & 1;
            __syncthreads();
            const float* ksrc = sub_keys + ((size_t)l * 2 + p) * 128 * 128;
#pragma unroll 4
            for (int i = 0; i < 32; ++i) ky[tid + NTHR * i] = ksrc[tid + NTHR * i];
            const float* src = w_query + (size_t)l * DM * DM + (size_t)dm0 * DM + hp * 128;
#pragma unroll 4
            for (int i = 0; i < 16; ++i) { const int idx = tid + NTHR * i, dd = idx >> 7, d = idx & 127; wq[dd * 129 + d] = src[(size_t)dd * DM + d]; }
            __syncthreads();
            const int dd = tid & 63, k0 = X.wave * 16;
            float acc[16];
#pragma unroll
            for (int i = 0; i < 16; ++i) acc[i] = 0.f;
            for (int d = 0; d < 128; ++d) {
                const float w = wq[dd * 129 + d];
#pragma unroll
                for (int i = 0; i < 16; ++i) acc[i] += ky[(k0 + i) * 128 + d] * w;
            }
            bf16* dst = (bf16*)(ws + WS_WL0 + (size_t)l * WL_STRIDE + WL_WS);
#pragma unroll
            for (int i = 0; i < 16; ++i) dst[(size_t)(hp * 128 + k0 + i) * DM + dm0 + dd] = (bf16)f2bf(acc[i]);
        }
    }
    __syncthreads();
    {
        LAS float* ct = (LAS float*)X.lds;
        const float norm = 1.0f / sqrtf((float)SEQ * 128.0f);
        for (int i = tid; i < 4096; i += NTHR) ct[i] = cospif((float)i * (1.0f / 2048.0f)) * norm;
        __syncthreads();
        bf16* Fm = (bf16*)(ws + WS_F);
        for (int k1 = X.c; k1 < SEQ; k1 += X.G) {
#pragma unroll
            for (int rep = 0; rep < 2; ++rep) {
                const int e0 = (tid + rep * NTHR) * 8;
                const int part = e0 >> 12, n1 = e0 & 4095;
                float v[8];
#pragma unroll
                for (int j = 0; j < 8; ++j) { const int idx = (k1 * (n1 + j)) & 4095; v[j] = part ? -ct[(idx - 1024) & 4095] : ct[idx]; }
                u32x4 w; w.x = pk2(v[0], v[1]); w.y = pk2(v[2], v[3]); w.z = pk2(v[4], v[5]); w.w = pk2(v[6], v[7]);
                *(u32x4*)(Fm + (size_t)k1 * 8192 + e0) = w;
            }
        }
    }
    __syncthreads();
    {
        const int gt = X.c * NTHR + tid;
        if (gt < SEQ * 8) { const int pos = gt >> 3, i = gt & 7; const float invf = powf(500000.0f, -(float)i * 0.125f); const float ang = (float)pos * invf;
            ((float*)(ws + WS_TAB))[gt] = cosf(ang); ((float*)(ws + WS_TAB + TAB_SIN))[gt] = sinf(ang); }
        if (gt < 2 * 768) { const int dir = gt / 768, col = gt % 768; const float l0 = lb_logits[(dir * DEPTH + 0) * 768 + col], l1 = lb_logits[(dir * DEPTH + 1) * 768 + col];
            float* lb = (float*)(ws + WS_TAB + TAB_LB);
            lb[(dir * DEPTH + 0) * 768 + col] = 0.f;
            lb[(dir * DEPTH + 1) * 768 + col] = 1.0f / (1.0f + expf(l0 - l1)); }
    }
    for (int m = X.gw; m < TOK; m += X.ngw) { float v[32]; load_row32(x + (size_t)m * DM, lane, v); ln_row(v, lane, emb_g, emb_b, out + (size_t)m * DM, (bf16*)(ws + WS_XA) + (size_t)m * DM); }
}
#define GAS __attribute__((address_space(1)))
typedef GAS unsigned gu32;
typedef GAS unsigned long long gu64;
#define RLX_AGENT __ATOMIC_RELAXED, __HIP_MEMORY_SCOPE_AGENT
#define VM_WAIT() asm volatile("s_waitcnt vmcnt(0)" ::: "memory")
__device__ __forceinline__ unsigned long long rt() { return __builtin_amdgcn_s_memrealtime(); }
#define XB_TMO      128
#define XB_XCNT(j)  (256  + 64 * (j))
#define XB_XSUB(j)  (1280 + 64 * (j))
#define XB_XGEN(j)  (2304 + 64 * (j))
#define XB_TOP      3328
#define XB_TOPGEN   3392
#define XCD_BAR_WORDS 3456
#define XB_SPIN_CAP (1u << 22)

__device__ __forceinline__ unsigned xb_ld(unsigned* p)              { return __hip_atomic_load(p, __ATOMIC_RELAXED, __HIP_MEMORY_SCOPE_AGENT); }
__device__ __forceinline__ unsigned xb_add(unsigned* p, unsigned v) { return __hip_atomic_fetch_add(p, v, __ATOMIC_RELAXED, __HIP_MEMORY_SCOPE_AGENT); }
__device__ __forceinline__ unsigned xb_xcc_id() { return (unsigned)__builtin_amdgcn_s_getreg((3 << 11) | 20) & 0xFu; }
#define XB_SPIN(cond, bar) do { unsigned _sp = 0; while (cond) { __builtin_amdgcn_s_sleep(1); \
    if ((++_sp & 255u) == 0u) { if (xb_ld(&(bar)[XB_TMO])) break; if (_sp > XB_SPIN_CAP) { atomicAdd(&(bar)[XB_TMO], 1u); break; } } } } while (0)

struct XcdBarrier {
    unsigned* bar; unsigned x;
    volatile LAS unsigned* st;
};

__device__ __forceinline__ XcdBarrier xcd_barrier_post(unsigned* bar, volatile LAS unsigned* st) {
    XcdBarrier b; b.bar = bar; b.x = xb_xcc_id(); b.st = st;
    if (threadIdx.x == 0) (void)xb_add(&bar[XB_XCNT(b.x)], 1u);
    return b;
}
__device__ __forceinline__ void xcd_barrier_complete(unsigned* bar, unsigned x, unsigned& nloc, unsigned& nx) {
    const unsigned G = gridDim.x * gridDim.y * gridDim.z;
    unsigned sum, cnt, mine, sp = 0u;
    for (;;) {
        sum = 0u; cnt = 0u; mine = 0u;
#pragma unroll
        for (unsigned j = 0; j < 16; ++j) { const unsigned c = xb_ld(&bar[XB_XCNT(j)]); sum += c; cnt += (c > 0u) ? 1u : 0u; mine = (j == x) ? c : mine; }
        if (sum == G) break;
        __builtin_amdgcn_s_sleep(1);
        if ((++sp & 255u) == 0u) { if (xb_ld(&bar[XB_TMO])) break; if (sp > XB_SPIN_CAP) { atomicAdd(&bar[XB_TMO], 1u); break; } }
    }
    nloc = mine > 0u ? mine : 1u; nx = cnt > 0u ? cnt : 1u;
}

__device__ __forceinline__ void xcd_barrier(const XcdBarrier& b) {
    asm volatile("s_waitcnt vmcnt(0)" ::: "memory");
    __syncthreads();
    if (threadIdx.x == 0) {
        unsigned* bar = b.bar;
        __builtin_amdgcn_s_waitcnt(0);
        unsigned nloc = b.st[0], nx = b.st[1];
        if (nloc == 0u) { xcd_barrier_complete(bar, b.x, nloc, nx); b.st[0] = nloc; b.st[1] = nx; }
        const unsigned old = xb_add(&bar[XB_XSUB(b.x)], 1u);
        const unsigned gen = old / nloc;
        if (old + 1u == (gen + 1u) * nloc) {
            __builtin_amdgcn_fence(__ATOMIC_RELEASE, "agent");
            asm volatile("s_waitcnt vmcnt(0)" ::: "memory");
            const unsigned og = xb_add(&bar[XB_TOP], 1u);
            const unsigned tg = og / nx;
            if (og + 1u == (tg + 1u) * nx) xb_add(&bar[XB_TOPGEN], 1u);
            else XB_SPIN(xb_ld(&bar[XB_TOPGEN]) == tg, bar);
            __builtin_amdgcn_fence(__ATOMIC_ACQUIRE, "agent");
            xb_add(&bar[XB_XGEN(b.x)], 1u);
            asm volatile("s_waitcnt vmcnt(0)" ::: "memory");
        } else {
            XB_SPIN(xb_ld(&bar[XB_XGEN(b.x)]) == gen, bar);
            __builtin_amdgcn_fence(__ATOMIC_ACQUIRE, "agent");
            asm volatile("s_waitcnt vmcnt(0)" ::: "memory");
        }
    }
    __syncthreads();
}

__device__ __forceinline__ void attn_naive(const Ctx& X, const bf16* h, const float* rc, const float* rs, bf16* ya) {
    for (int idx = X.c * NTHR + X.tid; idx < TOK * 4; idx += X.G * NTHR) {
        const int tk = idx >> 2, hh = idx & 3, b = tk / SEQ, p = tk % SEQ;
        float mx = -1e30f, l = 0.f; float o[64];
#pragma unroll
        for (int d = 0; d < 64; ++d) o[d] = 0.f;
        for (int g = 0; g < 3; ++g) {
            const int dil = (g == 0) ? 1 : (g == 1 ? 4 : 16), head = g * 4 + hh;
            float q[64];
            { const bf16* qp = h + (size_t)tk * HW + H_QA + head * 64;
#pragma unroll
              for (int i = 0; i < 8; ++i) { const u32x4 w = *(const u32x4*)(qp + i * 8); q[i * 8 + 0] = bflo(w.x); q[i * 8 + 1] = bfhi(w.x); q[i * 8 + 2] = bflo(w.y); q[i * 8 + 3] = bfhi(w.y);
                  q[i * 8 + 4] = bflo(w.z); q[i * 8 + 5] = bfhi(w.z); q[i * 8 + 6] = bflo(w.w); q[i * 8 + 7] = bfhi(w.w); }
#pragma unroll
              for (int i = 0; i < 8; ++i) { const float c = rc[p * 8 + i], s = rs[p * 8 + i], t1 = q[i], t2 = q[8 + i]; q[i] = t1 * c - t2 * s; q[8 + i] = t2 * c + t1 * s; }
#pragma unroll
              for (int d = 0; d < 64; ++d) q[d] *= 0.125f; }
            for (int j = -64; j <= 64; ++j) {
                const int kp = p + j * dil; if (kp < 0 || kp >= SEQ) continue;
                const bf16* kr = h + (size_t)(b * SEQ + kp) * HW + H_KA + head * 64;
                float s = 0.f;
                { const u32x4 w0 = *(const u32x4*)(kr), w1 = *(const u32x4*)(kr + 8);
                  const float k1[8] = {bflo(w0.x), bfhi(w0.x), bflo(w0.y), bfhi(w0.y), bflo(w0.z), bfhi(w0.z), bflo(w0.w), bfhi(w0.w)};
                  const float k2[8] = {bflo(w1.x), bfhi(w1.x), bflo(w1.y), bfhi(w1.y), bflo(w1.z), bfhi(w1.z), bflo(w1.w), bfhi(w1.w)};
#pragma unroll
                  for (int i = 0; i < 8; ++i) { const float c = rc[kp * 8 + i], sn = rs[kp * 8 + i]; s += q[i] * (k1[i] * c - k2[i] * sn) + q[8 + i] * (k2[i] * c + k1[i] * sn); } }
#pragma unroll
                for (int i = 2; i < 8; ++i) { const u32x4 w = *(const u32x4*)(kr + i * 8);
                    s += q[i * 8 + 0] * bflo(w.x) + q[i * 8 + 1] * bfhi(w.x) + q[i * 8 + 2] * bflo(w.y) + q[i * 8 + 3] * bfhi(w.y) + q[i * 8 + 4] * bflo(w.z) + q[i * 8 + 5] * bfhi(w.z) + q[i * 8 + 6] * bflo(w.w) + q[i * 8 + 7] * bfhi(w.w); }
                const float mn = fmaxf(mx, s), corr = __expf(mx - mn), pr = __expf(s - mn);
                l = l * corr + pr; mx = mn;
                const bf16* vr = h + (size_t)(b * SEQ + kp) * HW + H_VA + head * 64;
#pragma unroll
                for (int i = 0; i < 8; ++i) { const u32x4 w = *(const u32x4*)(vr + i * 8);
                    o[i * 8 + 0] = o[i * 8 + 0] * corr + pr * bflo(w.x); o[i * 8 + 1] = o[i * 8 + 1] * corr + pr * bfhi(w.x); o[i * 8 + 2] = o[i * 8 + 2] * corr + pr * bflo(w.y); o[i * 8 + 3] = o[i * 8 + 3] * corr + pr * bfhi(w.y);
                    o[i * 8 + 4] = o[i * 8 + 4] * corr + pr * bflo(w.z); o[i * 8 + 5] = o[i * 8 + 5] * corr + pr * bfhi(w.z); o[i * 8 + 6] = o[i * 8 + 6] * corr + pr * bflo(w.w); o[i * 8 + 7] = o[i * 8 + 7] * corr + pr * bfhi(w.w); }
            }
        }
        const float il = 1.0f / l; bf16* op = ya + (size_t)tk * 256 + hh * 64;
#pragma unroll
        for (int i = 0; i < 8; ++i) { u32x4 w; w.x = pk2(o[i * 8] * il, o[i * 8 + 1] * il); w.y = pk2(o[i * 8 + 2] * il, o[i * 8 + 3] * il); w.z = pk2(o[i * 8 + 4] * il, o[i * 8 + 5] * il); w.w = pk2(o[i * 8 + 6] * il, o[i * 8 + 7] * il);
            *(u32x4*)(op + i * 8) = w; }
    }
}
__device__ __forceinline__ void hgrn_prep_naive(const Ctx& X, const bf16* h, const float* lbl  , float* FD, float* KY) {
    const size_t n = (size_t)2 * TOK * 768;
    for (size_t i = (size_t)X.c * NTHR + X.tid; i < n; i += (size_t)X.G * NTHR) {
        const int dir = (int)(i / ((size_t)TOK * 768)); const size_t r = i % ((size_t)TOK * 768); const int tk = (int)(r / 768), col = (int)(r % 768);
        const float z = bf2f(h[(size_t)tk * HW + (dir ? H_FB : H_FF) + col]); const float lb = lbl[dir * DEPTH * 768 + col];
        const float s = 1.0f / (1.0f + expf(-z));
        FD[i] = lb + (1.0f - lb) * s; KY[i] = (1.0f - lb) * (1.0f - s);
    }
}
__device__ __forceinline__ void hgrn_scan_naive(const Ctx& X, const bf16* h, const float* FD, const float* KY, float* O  ) {
    LAS float* sf = (LAS float*)X.lds; LAS float* sk = sf + 512; LAS float* sq = sk + 512;
    for (int it = X.c; it < 6; it += X.G) {
        const int grp = X.tid >> 7, v = X.tid & 127, ch = it * 4 + grp;
        const int dir = ch / 12, b = (ch % 12) / 6, hd = ch % 6;
        float S[128];
#pragma unroll
        for (int k = 0; k < 128; ++k) S[k] = 0.f;
        for (int st = 0; st < SEQ; ++st) {
            const int t = dir ? (SEQ - 1 - st) : st; const size_t tk = (size_t)b * SEQ + t;
            const size_t e = ((size_t)dir * TOK + tk) * 768 + hd * 128 + v;
            const float f = FD[e], ky = KY[e], qv = bf2f(h[tk * HW + H_Q + hd * 128 + v]), vv = bf2f(h[tk * HW + H_I + hd * 128 + v]);
            __syncthreads();
            sf[X.tid] = f; sk[X.tid] = ky; sq[X.tid] = qv;
            __syncthreads();
            float o = 0.f;
            const LAS f32x4* pf = (const LAS f32x4*)(sf + grp * 128); const LAS f32x4* pk = (const LAS f32x4*)(sk + grp * 128); const LAS f32x4* pq = (const LAS f32x4*)(sq + grp * 128);
#pragma unroll
            for (int k4 = 0; k4 < 32; ++k4) { const f32x4 a = pf[k4], c = pk[k4], d = pq[k4];
#pragma unroll
                for (int e2 = 0; e2 < 4; ++e2) { S[k4 * 4 + e2] = a[e2] * S[k4 * 4 + e2] + c[e2] * vv; o += d[e2] * S[k4 * 4 + e2]; } }
            O[e] = o;
        }
    }
}
__device__ __forceinline__ void hgrn_combine_naive(const Ctx& X, const bf16* h, const float* O, const float* norm_g, bf16* yh) {
    for (int it = X.gw; it < TOK * 6; it += X.ngw) {
        const int tk = it / 6, hd = it % 6; const size_t e = (size_t)tk * 768 + hd * 128 + X.lane * 2;
        const f32x2 a = *(const f32x2*)(O + e), b = *(const f32x2*)(O + (size_t)TOK * 768 + e);
        const float o0 = a[0] + b[0], o1 = a[1] + b[1];
        const float ms = wave_sum(o0 * o0 + o1 * o1) * (1.0f / 128.0f); const float r = 1.0f / sqrtf(ms + 1e-6f);
        const unsigned gw = *(const unsigned*)(h + (size_t)tk * HW + H_G + hd * 128 + X.lane * 2); const float g0 = bflo(gw), g1 = bfhi(gw);
        const f32x2 ng = *(const f32x2*)(norm_g + hd * 128 + X.lane * 2);
        const float y0 = o0 * r * ng[0] * (g0 / (1.0f + expf(-g0))), y1 = o1 * r * ng[1] * (g1 / (1.0f + expf(-g1)));
        *(unsigned*)(yh + e) = pk2(y0, y1);
    }
}
__device__ __forceinline__ void fourier_reduce(const Ctx& X, const float* FP, bf16* yf) {
    for (int i = X.c * NTHR + X.tid; i < SEQ * 1024 / 4; i += X.G * NTHR) {
        const int k1 = i >> 8, c4 = (i & 255) * 4;
        f32x4 s = *(const f32x4*)(FP + (size_t)k1 * 1024 + c4);
#pragma unroll
        for (int ks = 1; ks < 4; ++ks) s = s + *(const f32x4*)(FP + (size_t)ks * SEQ * 1024 + (size_t)k1 * 1024 + c4);
        const int b = c4 >> 9, j = c4 & 511; u32x2 w; w.x = pk2(s[0], s[1]); w.y = pk2(s[2], s[3]);
        *(u32x2*)(yf + (size_t)(b * SEQ + k1) * 512 + j) = w;
    }
}
__device__ __forceinline__ void ln_phase(const Ctx& X, const float* vpre, const float* g, const float* b, float* xres, bf16* xa) {
    for (int m = X.gw; m < TOK; m += X.ngw) { float v[32]; load_row32(vpre + (size_t)m * DM, X.lane, v); ln_row(v, X.lane, g, b, xres + (size_t)m * DM, xa + (size_t)m * DM); }
}

__device__ __forceinline__ float dot2bf(unsigned w, unsigned x, float acc) { return __builtin_amdgcn_fdot2_f32_bf16(__builtin_bit_cast(bf16x2_t, w), __builtin_bit_cast(bf16x2_t, x), acc, false); }
__device__ __forceinline__ float gelu_erf(float x) { return 0.5f * x * (1.0f + erff(x * 0.70710678118654752f)); }
__device__ __forceinline__ void peer_phase(const Ctx& X, const float* scores, const unsigned char* U8, const unsigned char* V8, float* xres, bf16* xa, const float* lng, const float* lnb,
                                           const float* Uf, const float* Vf, const float* Wq, const float* Kf) {
    const int lane = X.lane;
        LAS float* sc = (LAS float*)(X.lds + X.wave * 12288);
    LAS float* tops = sc + 2048;
    LAS int* topi = (LAS int*)(tops + 256);
    LAS int* le = topi + 256;
    LAS float* lg = (LAS float*)(le + 128);
    const float NEG = -3.0e38f;
    for (int tk = X.gw; tk < TOK; tk += X.ngw) {
        const float* srow = scores + (size_t)tk * 2048;
#if defined(PEER_NAIVE_SC)
        { (void)srow;
          float qa[32];
#pragma unroll
          for (int i = 0; i < 32; ++i) qa[i] = 0.f;
          for (int dm = 0; dm < DM; ++dm) { const float xv = xres[(size_t)tk * DM + dm];
#pragma unroll
              for (int i = 0; i < 32; ++i) qa[i] += xv * Wq[(size_t)dm * DM + i * 64 + lane]; }
#pragma unroll
          for (int i = 0; i < 32; ++i) sc[i * 64 + lane] = qa[i];
          LDS_WAIT();
          float sv[32];
#pragma unroll
          for (int r = 0; r < 16; ++r) { const int p = r & 1;
              float s0 = 0.f, s1 = 0.f;
              for (int d = 0; d < 128; ++d) { const float qv = sc[r * 128 + d]; s0 += qv * Kf[((size_t)p * 128 + lane) * 128 + d]; s1 += qv * Kf[((size_t)p * 128 + 64 + lane) * 128 + d]; }
              sv[2 * r] = s0; sv[2 * r + 1] = s1; }
          LDS_WAIT();
#pragma unroll
          for (int r = 0; r < 16; ++r) { sc[r * 128 + lane] = sv[2 * r]; sc[r * 128 + 64 + lane] = sv[2 * r + 1]; }
          LDS_WAIT(); }
#else
#pragma unroll
        for (int i = 0; i < 8; ++i) *(LAS f32x4*)(sc + i * 256 + lane * 4) = *(const f32x4*)(srow + i * 256 + lane * 4);
        LDS_WAIT();
#endif
#if defined(PEER_NAIVE_SEL)
        for (int r = 0; r < 16; ++r) {
            const float a = sc[r * 128 + lane], b = sc[r * 128 + 64 + lane]; int ca = 0, cb = 0;
            for (int k = 0; k < 128; ++k) { const float v = sc[r * 128 + k]; ca += (v > a || (v == a && k < lane)) ? 1 : 0; cb += (v > b || (v == b && k < 64 + lane)) ? 1 : 0; }
            if (ca < 16) { tops[r * 16 + ca] = a; topi[r * 16 + ca] = lane; }
            if (cb < 16) { tops[r * 16 + cb] = b; topi[r * 16 + cb] = 64 + lane; }
        }
        LDS_WAIT();
        for (int hd = 0; hd < 8; ++hd) {
            LAS float* cand = sc;
            const float a0 = tops[(2 * hd) * 16 + (lane >> 2)]; float cv[4];
#pragma unroll
            for (int jj = 0; jj < 4; ++jj) { cv[jj] = a0 + tops[(2 * hd + 1) * 16 + (lane & 3) * 4 + jj]; cand[lane * 4 + jj] = cv[jj]; }
            LDS_WAIT();
            int cn[4] = {0, 0, 0, 0};
            for (int k = 0; k < 256; ++k) { const float v = cand[k];
#pragma unroll
                for (int jj = 0; jj < 4; ++jj) cn[jj] += (v > cv[jj] || (v == cv[jj] && k < lane * 4 + jj)) ? 1 : 0; }
            LAS float* bsl = sc + 256; LAS int* bcl = (LAS int*)(sc + 272);
#pragma unroll
            for (int jj = 0; jj < 4; ++jj) if (cn[jj] < 16) { bsl[cn[jj]] = cv[jj]; bcl[cn[jj]] = lane * 4 + jj; }
            LDS_WAIT();
            const float M0 = bsl[0]; const float bs = (lane < 16) ? bsl[lane] : 0.f; const int bc = (lane < 16) ? bcl[lane] : 0;
            const float ex = (lane < 16) ? __expf(bs - M0) : 0.f; const float sum = wave_sum(ex);
            if (lane < 16) { const int i1 = topi[(2 * hd) * 16 + (bc >> 4)], i2 = topi[(2 * hd + 1) * 16 + (bc & 15)]; le[hd * 16 + lane] = i1 * 128 + i2; lg[hd * 16 + lane] = ex / sum; }
            LDS_WAIT();
        }
        LDS_WAIT();
#else
        for (int r = 0; r < 16; ++r) {
            float a = sc[r * 128 + lane], b = sc[r * 128 + 64 + lane]; float tv = 0.f; int ti = 0;
#pragma unroll
            for (int it = 0; it < 16; ++it) {
                const float M = wave_max(fmaxf(a, b));
                const unsigned long long ba = __ballot(a == M); int idx;
                if (ba != 0ull) { const int ln = __ffsll((long long)ba) - 1; idx = ln; if (lane == ln) a = NEG; }
                else { const unsigned long long bb = __ballot(b == M); const int ln = __ffsll((long long)bb) - 1; idx = 64 + ln; if (lane == ln) b = NEG; }
                if (lane == it) { tv = M; ti = idx; }
            }
            if (lane < 16) { tops[r * 16 + lane] = tv; topi[r * 16 + lane] = ti; }
        }
        LDS_WAIT();
        for (int hd = 0; hd < 8; ++hd) {
            const float a0 = tops[(2 * hd) * 16 + (lane >> 2)];
            float c0 = a0 + tops[(2 * hd + 1) * 16 + (lane & 3) * 4 + 0], c1 = a0 + tops[(2 * hd + 1) * 16 + (lane & 3) * 4 + 1];
            float c2 = a0 + tops[(2 * hd + 1) * 16 + (lane & 3) * 4 + 2], c3 = a0 + tops[(2 * hd + 1) * 16 + (lane & 3) * 4 + 3];
            float bs = NEG; int bc = 0;
#pragma unroll
            for (int it = 0; it < 16; ++it) {
                const float M = wave_max(fmaxf(fmaxf(c0, c1), fmaxf(c2, c3)));
                const int fj = (c0 == M) ? 0 : (c1 == M) ? 1 : (c2 == M) ? 2 : (c3 == M) ? 3 : -1;
                const unsigned long long bal = __ballot(fj >= 0); const int ln = __ffsll((long long)bal) - 1;
                const int fjw = __builtin_amdgcn_readlane(fj, ln);
                if (lane == ln) { if (fjw == 0) c0 = NEG; else if (fjw == 1) c1 = NEG; else if (fjw == 2) c2 = NEG; else c3 = NEG; }
                if (lane == it) { bs = M; bc = ln * 4 + fjw; }
            }
            const float M0 = rdlane(bs, 0);
            const float ex = (lane < 16) ? __expf(bs - M0) : 0.f; const float sum = wave_sum(ex);
            if (lane < 16) { const int i1 = topi[(2 * hd) * 16 + (bc >> 4)], i2 = topi[(2 * hd + 1) * 16 + (bc & 15)]; le[hd * 16 + lane] = i1 * 128 + i2; lg[hd * 16 + lane] = ex / sum; }
        }
        LDS_WAIT();
#endif
        float xr[32]; load_row_t<2, 16>(xres + (size_t)tk * DM, lane, xr);
        float y[32];
#pragma unroll
        for (int i = 0; i < 32; ++i) y[i] = 0.f;
        constexpr int EG = 2;
        for (int g4 = 0; g4 < 128 / EG; ++g4) {
            u32x4 U[EG][2], V[EG][2]; float gt[EG];
#pragma unroll
            for (int k = 0; k < EG; ++k) { const int e = __builtin_amdgcn_readfirstlane(le[g4 * EG + k]); gt[k] = lg[g4 * EG + k];
                const unsigned char* up = U8 + (size_t)e * DM + lane * 16; const unsigned char* vp = V8 + (size_t)e * DM + lane * 16;
#pragma unroll
                for (int c = 0; c < 2; ++c) { U[k][c] = *(const u32x4*)(up + c * 1024); V[k][c] = *(const u32x4*)(vp + c * 1024); } }
            float hv[EG];
#pragma unroll
            for (int k = 0; k < EG; ++k) { float s = 0.f;
#pragma unroll
                for (int c = 0; c < 2; ++c) { const unsigned wd[4] = {U[k][c].x, U[k][c].y, U[k][c].z, U[k][c].w};
#pragma unroll
                    for (int d = 0; d < 4; ++d) { const f32x2 lo = __builtin_amdgcn_cvt_pk_f32_fp8((int)wd[d], false), hi = __builtin_amdgcn_cvt_pk_f32_fp8((int)wd[d], true);
                        s += lo[0] * xr[c * 16 + 4 * d] + lo[1] * xr[c * 16 + 4 * d + 1] + hi[0] * xr[c * 16 + 4 * d + 2] + hi[1] * xr[c * 16 + 4 * d + 3]; } }
                hv[k] = gelu_erf(wave_sum(s) * (1.0f / PEER_US)) * gt[k] * (1.0f / PEER_VS); }
#pragma unroll
            for (int k = 0; k < EG; ++k)
#pragma unroll
                for (int c = 0; c < 2; ++c) { const unsigned wd[4] = {V[k][c].x, V[k][c].y, V[k][c].z, V[k][c].w};
#pragma unroll
                    for (int d = 0; d < 4; ++d) { const f32x2 lo = __builtin_amdgcn_cvt_pk_f32_fp8((int)wd[d], false), hi = __builtin_amdgcn_cvt_pk_f32_fp8((int)wd[d], true);
                        y[c * 16 + 4 * d] += hv[k] * lo[0]; y[c * 16 + 4 * d + 1] += hv[k] * lo[1]; y[c * 16 + 4 * d + 2] += hv[k] * hi[0]; y[c * 16 + 4 * d + 3] += hv[k] * hi[1]; } }
        }
#pragma unroll
        for (int i = 0; i < 32; ++i) y[i] += DN_ALPHA * xr[i];
        ln_row_t<2, 16>(y, lane, lng, lnb, xres + (size_t)tk * DM, xa + (size_t)tk * DM);
    }
}

typedef short bf16x8 __attribute__((ext_vector_type(8)));
#define MFMA16(a, b, c) __builtin_amdgcn_mfma_f32_16x16x32_bf16((a), (b), (c), 0, 0, 0)
constexpr size_t TAB_D = 1 * MiB;

__device__ __forceinline__ void hgrn_lf_key(float z, float lb, float& lf, float& key) {
    const float s = __builtin_amdgcn_rcpf(1.0f + __expf(-z));
    const float f = fmaxf(lb + (1.0f - lb) * s, 1e-30f);
    lf = __logf(f); key = (1.0f - lb) * (1.0f - s);
}
__device__ __forceinline__ void unpack8(const u32x4 w, float* o) { o[0] = bflo(w.x); o[1] = bfhi(w.x); o[2] = bflo(w.y); o[3] = bfhi(w.y); o[4] = bflo(w.z); o[5] = bfhi(w.z); o[6] = bflo(w.w); o[7] = bfhi(w.w); }
__device__ __forceinline__ u32x4 pack8(const float* v) { u32x4 w; w.x = pk2(v[0], v[1]); w.y = pk2(v[2], v[3]); w.z = pk2(v[4], v[5]); w.w = pk2(v[6], v[7]); return w; }

__device__ __forceinline__ void hgrn_cumsum(LAS float* LF, LAS float* SEG, int tid, int dir, float (&bl)[16], float& tot) {
    const int k = tid & 127, seg = tid >> 7; float run = 0.f;
    if (dir == 0) {
#pragma unroll
        for (int i = 0; i < 16; ++i) { run += LF[(16 * seg + i) * 128 + k]; bl[i] = run; }
    } else {
#pragma unroll
        for (int i = 15; i >= 0; --i) { run += LF[(16 * seg + i) * 128 + k]; bl[i] = run; }
    }
    SEG[seg * 128 + k] = run;
    __syncthreads();
    float off = 0.f; tot = 0.f;
#pragma unroll
    for (int s2 = 0; s2 < 4; ++s2) { const float sv = SEG[s2 * 128 + k]; tot += sv; if (dir == 0 ? (s2 < seg) : (s2 > seg)) off += sv; }
#pragma unroll
    for (int i = 0; i < 16; ++i) bl[i] += off;
}

__device__ __forceinline__ void hgrn_pass1(const Ctx& X, const bf16* h, const float* lbl, float* L, float* Dd) {
    LAS float* LF = (LAS float*)X.lds; LAS float* KYf = LF + 8192; LAS float* SEG = KYf + 8192;
    LAS bf16* VR = (LAS bf16*)(X.lds + 67584); LAS bf16* KT = (LAS bf16*)(X.lds + 83968); LAS bf16* VT = (LAS bf16*)(X.lds + 102400);
    const int tid = X.tid, lane = X.lane, q4 = lane >> 4, l15 = lane & 15;
    for (int u = X.c; u < 1536; u += X.G) {
        const int dir = u / 768, rem = u % 768, bh = rem >> 6, c = rem & 63, b = bh / 6, hd = bh % 6; const size_t tok0 = (size_t)b * SEQ + 64 * c;
        __syncthreads();
        { const int t = tid >> 3, kc = (tid & 7) * 16;
          const bf16* zr = h + (tok0 + t) * HW + (dir ? H_FB : H_FF) + hd * 128 + kc; const bf16* vr = h + (tok0 + t) * HW + H_I + hd * 128 + kc;
          const u32x4 z0 = *(const u32x4*)zr, z1 = *(const u32x4*)(zr + 8), v0 = *(const u32x4*)vr, v1 = *(const u32x4*)(vr + 8);
          float z[16]; unpack8(z0, z); unpack8(z1, z + 8);
          const float* lbp = lbl + dir * DEPTH * 768 + hd * 128 + kc;
          float lf[16], ky[16];
#pragma unroll
          for (int j = 0; j < 16; ++j) hgrn_lf_key(z[j], lbp[j], lf[j], ky[j]);
#pragma unroll
          for (int j = 0; j < 4; ++j) { *(LAS f32x4*)(LF + t * 128 + kc + 4 * j) = (f32x4){lf[4 * j], lf[4 * j + 1], lf[4 * j + 2], lf[4 * j + 3]};
              *(LAS f32x4*)(KYf + t * 128 + kc + 4 * j) = (f32x4){ky[4 * j], ky[4 * j + 1], ky[4 * j + 2], ky[4 * j + 3]}; }
          *(LAS u32x4*)(VR + t * 128 + kc) = v0; *(LAS u32x4*)(VR + t * 128 + kc + 8) = v1; }
        __syncthreads();
        float bl[16], tot; hgrn_cumsum(LF, SEG, tid, dir, bl, tot);
        { const int k = tid & 127, seg = tid >> 7; float kh[16];
#pragma unroll
          for (int i = 0; i < 16; ++i) kh[i] = KYf[(16 * seg + i) * 128 + k] * __expf(tot - bl[i]);
          *(LAS u32x4*)(KT + k * 72 + 16 * seg) = pack8(kh); *(LAS u32x4*)(KT + k * 72 + 16 * seg + 8) = pack8(kh + 8);
          if (seg == 0) Dd[(size_t)u * 128 + k] = __expf(tot);
          unsigned short vv[16];
#pragma unroll
          for (int i = 0; i < 16; ++i) vv[i] = VR[(16 * seg + i) * 128 + k];
          u32x4 w0, w1; w0.x = vv[0] | (vv[1] << 16); w0.y = vv[2] | (vv[3] << 16); w0.z = vv[4] | (vv[5] << 16); w0.w = vv[6] | (vv[7] << 16);
          w1.x = vv[8] | (vv[9] << 16); w1.y = vv[10] | (vv[11] << 16); w1.z = vv[12] | (vv[13] << 16); w1.w = vv[14] | (vv[15] << 16);
          *(LAS u32x4*)(VT + k * 72 + 16 * seg) = w0; *(LAS u32x4*)(VT + k * 72 + 16 * seg + 8) = w1; }
        __syncthreads();
        const int mb0 = (X.wave & 3) * 2, nb0 = (X.wave >> 2) * 4;
        f32x4 acc[2][4];
#pragma unroll
        for (int mi = 0; mi < 2; ++mi)
#pragma unroll
            for (int ni = 0; ni < 4; ++ni) acc[mi][ni] = (f32x4){0.f, 0.f, 0.f, 0.f};
#pragma unroll
        for (int ks = 0; ks < 2; ++ks) {
            bf16x8 a[2], bb[4];
#pragma unroll
            for (int mi = 0; mi < 2; ++mi) a[mi] = *(const LAS bf16x8*)(KT + ((mb0 + mi) * 16 + l15) * 72 + ks * 32 + 8 * q4);
#pragma unroll
            for (int ni = 0; ni < 4; ++ni) bb[ni] = *(const LAS bf16x8*)(VT + ((nb0 + ni) * 16 + l15) * 72 + ks * 32 + 8 * q4);
#pragma unroll
            for (int mi = 0; mi < 2; ++mi)
#pragma unroll
                for (int ni = 0; ni < 4; ++ni) acc[mi][ni] = MFMA16(a[mi], bb[ni], acc[mi][ni]);
        }
        float* Lu = L + (size_t)u * 16384;
#pragma unroll
        for (int mi = 0; mi < 2; ++mi)
#pragma unroll
            for (int ni = 0; ni < 4; ++ni) *(f32x4*)(Lu + ((nb0 + ni) * 16 + l15) * 128 + (mb0 + mi) * 16 + 4 * q4) = acc[mi][ni];
    }
}
__device__ __forceinline__ void hgrn_pass2(const Ctx& X, const float* L, const float* Dd, bf16* Sp) {
    for (int i = X.c * NTHR + X.tid; i < 24 * 8192; i += X.G * NTHR) {
        const int chain = i >> 13, e = (i & 8191) * 2, k = e & 127, dir = chain / 12, bh = chain % 12;
        float s0 = 0.f, s1 = 0.f;
#pragma unroll 8
        for (int j = 0; j < 64; ++j) { const int c = dir ? 63 - j : j; const size_t u = (size_t)(dir * 12 + bh) * 64 + c;
            *(unsigned*)(Sp + u * 16384 + e) = pk2(s0, s1);
            const f32x2 l = *(const f32x2*)(L + u * 16384 + e), d = *(const f32x2*)(Dd + u * 128 + k);
            s0 = d[0] * s0 + l[0]; s1 = d[1] * s1 + l[1]; }
    }
}
__device__ __forceinline__ void hgrn_pass3(const Ctx& X, const bf16* h, const float* lbl, const bf16* Sp, const float* norm_g, bf16* yh) {
    LAS unsigned char* R1 = (LAS unsigned char*)X.lds;
    LAS float* LF = (LAS float*)R1; LAS bf16* VR = (LAS bf16*)R1; LAS bf16* ST = (LAS bf16*)R1;
    LAS bf16* VT = (LAS bf16*)(X.lds + 34816); LAS bf16* QT1 = (LAS bf16*)(X.lds + 53248); LAS bf16* KT1 = (LAS bf16*)(X.lds + 70656); LAS bf16* QT2 = (LAS bf16*)(X.lds + 88064);
    LAS bf16* PM = (LAS bf16*)(X.lds + 105472); LAS float* SEG = (LAS float*)(X.lds + 114688); LAS float* RR = (LAS float*)(X.lds + 116736); LAS float* SS = (LAS float*)(X.lds + 117248);
    const int tid = X.tid, lane = X.lane, q4 = lane >> 4, l15 = lane & 15, w = X.wave;
    for (int u = X.c; u < 768; u += X.G) {
        const int bh = u >> 6, c = u & 63, b = bh / 6, hd = bh % 6; const size_t tok0 = (size_t)b * SEQ + 64 * c;
        __syncthreads();
        { const int t = tid >> 3, kc = (tid & 7) * 16; const bf16* vr = h + (tok0 + t) * HW + H_I + hd * 128 + kc;
          *(LAS u32x4*)(VR + t * 128 + kc) = *(const u32x4*)vr; *(LAS u32x4*)(VR + t * 128 + kc + 8) = *(const u32x4*)(vr + 8); }
        __syncthreads();
        { const int v = tid & 127, seg = tid >> 7; unsigned short vv[16];
#pragma unroll
          for (int i = 0; i < 16; ++i) vv[i] = VR[(16 * seg + i) * 128 + v];
          u32x4 w0, w1; w0.x = vv[0] | (vv[1] << 16); w0.y = vv[2] | (vv[3] << 16); w0.z = vv[4] | (vv[5] << 16); w0.w = vv[6] | (vv[7] << 16);
          w1.x = vv[8] | (vv[9] << 16); w1.y = vv[10] | (vv[11] << 16); w1.z = vv[12] | (vv[13] << 16); w1.w = vv[14] | (vv[15] << 16);
          *(LAS u32x4*)(VT + v * 72 + 16 * seg) = w0; *(LAS u32x4*)(VT + v * 72 + 16 * seg + 8) = w1; }
        f32x4 acc[4];
#pragma unroll
        for (int ni = 0; ni < 4; ++ni) acc[ni] = (f32x4){0.f, 0.f, 0.f, 0.f};
        const int tb = w & 3;
#pragma unroll 1
        for (int dir = 0; dir < 2; ++dir) {
            __syncthreads();
            const int t = tid >> 3, kc = (tid & 7) * 16;
            float ky[16], qv[16];
            { const bf16* zr = h + (tok0 + t) * HW + (dir ? H_FB : H_FF) + hd * 128 + kc; const bf16* qr = h + (tok0 + t) * HW + H_Q + hd * 128 + kc;
              const u32x4 z0 = *(const u32x4*)zr, z1 = *(const u32x4*)(zr + 8), q0 = *(const u32x4*)qr, q1 = *(const u32x4*)(qr + 8);
              float z[16]; unpack8(z0, z); unpack8(z1, z + 8); unpack8(q0, qv); unpack8(q1, qv + 8);
              const float* lbp = lbl + dir * DEPTH * 768 + hd * 128 + kc; float lf[16];
#pragma unroll
              for (int j = 0; j < 16; ++j) hgrn_lf_key(z[j], lbp[j], lf[j], ky[j]);
#pragma unroll
              for (int j = 0; j < 4; ++j) *(LAS f32x4*)(LF + t * 128 + kc + 4 * j) = (f32x4){lf[4 * j], lf[4 * j + 1], lf[4 * j + 2], lf[4 * j + 3]}; }
            const size_t us = (size_t)(dir * 12 + bh) * 64 + c; u32x4 sreg[4];
#pragma unroll
            for (int i = 0; i < 4; ++i) sreg[i] = *(const u32x4*)(Sp + us * 16384 + (size_t)(tid + NTHR * i) * 8);
            __syncthreads();
            { float bl[16], tot; hgrn_cumsum(LF, SEG, tid, dir, bl, tot);
              const int k = tid & 127, seg = tid >> 7;
#pragma unroll
              for (int i = 0; i < 16; ++i) LF[(16 * seg + i) * 128 + k] = bl[i];
              if (dir == 0 ? (seg == 1) : (seg == 2)) RR[k] = dir == 0 ? bl[15] : bl[0]; }
            __syncthreads();
            { float q1[16], k1[16], q2[16];
#pragma unroll
              for (int j = 0; j < 16; ++j) { const float bt = LF[t * 128 + kc + j], r = RR[kc + j];
                  q1[j] = qv[j] * __expf(bt - r); k1[j] = ky[j] * __expf(r - bt); q2[j] = qv[j] * __expf(bt); }
              *(LAS u32x4*)(QT1 + t * 136 + kc) = pack8(q1); *(LAS u32x4*)(QT1 + t * 136 + kc + 8) = pack8(q1 + 8);
              *(LAS u32x4*)(KT1 + t * 136 + kc) = pack8(k1); *(LAS u32x4*)(KT1 + t * 136 + kc + 8) = pack8(k1 + 8);
              *(LAS u32x4*)(QT2 + t * 136 + kc) = pack8(q2); *(LAS u32x4*)(QT2 + t * 136 + kc + 8) = pack8(q2 + 8); }
            __syncthreads();
#pragma unroll
            for (int i = 0; i < 4; ++i) { const int idx = tid + NTHR * i, v = idx >> 4, k8 = (idx & 15) * 8; *(LAS u32x4*)(ST + v * 136 + k8) = sreg[i]; }
            { const int sb0 = (w >> 2) * 2; f32x4 pa[2] = {(f32x4){0.f, 0.f, 0.f, 0.f}, (f32x4){0.f, 0.f, 0.f, 0.f}};
#pragma unroll
              for (int ks = 0; ks < 4; ++ks) { const bf16x8 a = *(const LAS bf16x8*)(QT1 + (tb * 16 + l15) * 136 + ks * 32 + 8 * q4);
#pragma unroll
                  for (int si = 0; si < 2; ++si) { const bf16x8 bb = *(const LAS bf16x8*)(KT1 + ((sb0 + si) * 16 + l15) * 136 + ks * 32 + 8 * q4); pa[si] = MFMA16(a, bb, pa[si]); } }
#pragma unroll
              for (int si = 0; si < 2; ++si) { const int s = (sb0 + si) * 16 + l15;
#pragma unroll
                  for (int r = 0; r < 4; ++r) { const int tt = tb * 16 + 4 * q4 + r; const bool keep = dir == 0 ? (s <= tt) : (s >= tt);
                      PM[tt * 72 + s] = (bf16)f2bf(keep ? pa[si][r] : 0.f); } } }
            __syncthreads();
            { const int vb0 = (w >> 2) * 4;
#pragma unroll
              for (int ks = 0; ks < 4; ++ks) { const bf16x8 a = *(const LAS bf16x8*)(QT2 + (tb * 16 + l15) * 136 + ks * 32 + 8 * q4);
#pragma unroll
                  for (int ni = 0; ni < 4; ++ni) { const bf16x8 bb = *(const LAS bf16x8*)(ST + ((vb0 + ni) * 16 + l15) * 136 + ks * 32 + 8 * q4); acc[ni] = MFMA16(a, bb, acc[ni]); } }
#pragma unroll
              for (int ks = 0; ks < 2; ++ks) { const bf16x8 a = *(const LAS bf16x8*)(PM + (tb * 16 + l15) * 72 + ks * 32 + 8 * q4);
#pragma unroll
                  for (int ni = 0; ni < 4; ++ni) { const bf16x8 bb = *(const LAS bf16x8*)(VT + ((vb0 + ni) * 16 + l15) * 72 + ks * 32 + 8 * q4); acc[ni] = MFMA16(a, bb, acc[ni]); } } }
        }
        { const int vb0 = (w >> 2) * 4; float ss[4];
#pragma unroll
          for (int r = 0; r < 4; ++r) { float s = 0.f;
#pragma unroll
              for (int ni = 0; ni < 4; ++ni) s += acc[ni][r] * acc[ni][r];
              s += dpp_f<0xB1>(s); s += dpp_f<0x4E>(s); s += dpp_f<0x141>(s); s += dpp_f<0x140>(s);
              ss[r] = s; }
          if (l15 == 0) {
#pragma unroll
              for (int r = 0; r < 4; ++r) SS[(tb * 16 + 4 * q4 + r) * 2 + (w >> 2)] = ss[r]; }
          __syncthreads();
#pragma unroll
          for (int r = 0; r < 4; ++r) { const int tt = tb * 16 + 4 * q4 + r; const float tot = SS[tt * 2] + SS[tt * 2 + 1]; const float rn = 1.0f / sqrtf(tot * (1.0f / 128.0f) + 1e-6f);
#pragma unroll
              for (int ni = 0; ni < 4; ++ni) { const int v = (vb0 + ni) * 16 + l15; const float g = bf2f(h[(tok0 + tt) * HW + H_G + hd * 128 + v]);
                  const float y = acc[ni][r] * rn * norm_g[hd * 128 + v] * (g * __builtin_amdgcn_rcpf(1.0f + __expf(-g)));
                  yh[(tok0 + tt) * 768 + hd * 128 + v] = (bf16)f2bf(y); } } }
    }
}

constexpr size_t WS_AO = 944 * MiB, WS_LSE = 968 * MiB, WS_END2 = 969 * MiB;
__device__ __forceinline__ void rope16(float* t1, float* t2, const float* rc, const float* rs, int p) {
    const f32x4 c0 = *(const f32x4*)(rc + p * 8), c1 = *(const f32x4*)(rc + p * 8 + 4), s0 = *(const f32x4*)(rs + p * 8), s1 = *(const f32x4*)(rs + p * 8 + 4);
#pragma unroll
    for (int i = 0; i < 8; ++i) { const float c = i < 4 ? c0[i] : c1[i - 4], s = i < 4 ? s0[i] : s1[i - 4], a = t1[i], b = t2[i]; t1[i] = a * c - b * s; t2[i] = b * c + a * s; }
}
__device__ __forceinline__ void attn_fast(const Ctx& X, const bf16* h, const float* rc, const float* rs, float* AO, float* LSE) {
    LAS bf16* KL = (LAS bf16*)X.lds; LAS bf16* VL = KL + 256 * 72; LAS bf16* QL = VL + 256 * 72;
    const int tid = X.tid, lane = X.lane, q4 = lane >> 4, l15 = lane & 15, w = X.wave;
    for (int u = X.c; u < 768; u += X.G) {
        const int b = u / 384, head = (u % 384) >> 5, blk = u & 31, g = head >> 2, dsh = 2 * g, dil = 1 << dsh, Lsub = SEQ >> dsh, nblk = Lsub >> 7;
        const int cls = blk / nblk, m0 = (blk % nblk) * 128;
        const bf16* hb = h + (size_t)b * SEQ * HW;
        __syncthreads();
#pragma unroll
        for (int rep = 0; rep < 2; ++rep) {
            const int row = (tid >> 2) + 128 * rep, qt = tid & 3, m = m0 - 64 + row; const bool ok = (m >= 0) && (m < Lsub); const int p = ok ? m * dil + cls : 0;
            const bf16* kr = hb + (size_t)p * HW + H_KA + head * 64 + qt * 16; const bf16* vr = hb + (size_t)p * HW + H_VA + head * 64 + qt * 16;
            u32x4 k0 = *(const u32x4*)kr, k1 = *(const u32x4*)(kr + 8), v0 = *(const u32x4*)vr, v1 = *(const u32x4*)(vr + 8);
            if (qt == 0) { float t1[8], t2[8]; unpack8(k0, t1); unpack8(k1, t2); rope16(t1, t2, rc, rs, p); k0 = pack8(t1); k1 = pack8(t2); }
            if (!ok) { k0 = (u32x4){0u, 0u, 0u, 0u}; k1 = k0; v0 = k0; v1 = k0; }
            *(LAS u32x4*)(KL + row * 72 + qt * 16) = k0; *(LAS u32x4*)(KL + row * 72 + qt * 16 + 8) = k1;
            *(LAS u32x4*)(VL + row * 72 + qt * 16) = v0; *(LAS u32x4*)(VL + row * 72 + qt * 16 + 8) = v1;
        }
        { const int row = tid >> 2, qt = tid & 3, p = (m0 + row) * dil + cls; const bf16* qr = hb + (size_t)p * HW + H_QA + head * 64 + qt * 16;
          const u32x4 q0 = *(const u32x4*)qr, q1 = *(const u32x4*)(qr + 8); float t1[8], t2[8]; unpack8(q0, t1); unpack8(q1, t2);
          if (qt == 0) rope16(t1, t2, rc, rs, p);
#pragma unroll
          for (int i = 0; i < 8; ++i) { t1[i] *= 0.125f; t2[i] *= 0.125f; }
          *(LAS u32x4*)(QL + row * 72 + qt * 16) = pack8(t1); *(LAS u32x4*)(QL + row * 72 + qt * 16 + 8) = pack8(t2); }
        __syncthreads();
        bf16x8 qf[2];
#pragma unroll
        for (int ks = 0; ks < 2; ++ks) qf[ks] = *(const LAS bf16x8*)(QL + (16 * w + l15) * 72 + ks * 32 + 8 * q4);
        f32x4 sa[9];
#pragma unroll
        for (int kb = 0; kb < 9; ++kb) { sa[kb] = (f32x4){0.f, 0.f, 0.f, 0.f};
#pragma unroll
            for (int ks = 0; ks < 2; ++ks) { const bf16x8 a = *(const LAS bf16x8*)(KL + (16 * w + 16 * kb + l15) * 72 + ks * 32 + 8 * q4); sa[kb] = MFMA16(a, qf[ks], sa[kb]); } }
        float mx = -1e30f;
#pragma unroll
        for (int kb = 0; kb < 9; ++kb)
#pragma unroll
            for (int r = 0; r < 4; ++r) { const int j = 16 * kb + 4 * q4 + r, d = j - 64 - l15, km = m0 - 64 + 16 * w + j; const bool ok = (d >= -64) && (d <= 64) && (km >= 0) && (km < Lsub);
                sa[kb][r] = ok ? sa[kb][r] : -1e30f; mx = fmaxf(mx, sa[kb][r]); }
        mx = fmaxf(mx, __shfl_xor(mx, 16)); mx = fmaxf(mx, __shfl_xor(mx, 32));
        float lsum = 0.f;
#pragma unroll
        for (int kb = 0; kb < 9; ++kb)
#pragma unroll
            for (int r = 0; r < 4; ++r) { const float pv = __expf(sa[kb][r] - mx); sa[kb][r] = pv; lsum += pv; }
        lsum += __shfl_xor(lsum, 16); lsum += __shfl_xor(lsum, 32);
        f32x4 oa[4];
#pragma unroll
        for (int db = 0; db < 4; ++db) oa[db] = (f32x4){0.f, 0.f, 0.f, 0.f};
#pragma unroll
        for (int kp = 0; kp < 5; ++kp) {
            u32x4 pw; pw.x = pk2(sa[2 * kp][0], sa[2 * kp][1]); pw.y = pk2(sa[2 * kp][2], sa[2 * kp][3]);
            if (kp < 4) { pw.z = pk2(sa[2 * kp + 1][0], sa[2 * kp + 1][1]); pw.w = pk2(sa[2 * kp + 1][2], sa[2 * kp + 1][3]); } else { pw.z = 0u; pw.w = 0u; }
            const bf16x8 pb = __builtin_bit_cast(bf16x8, pw);
            int rows[8];
#pragma unroll
            for (int jj = 0; jj < 8; ++jj) { int R = 16 * w + 16 * (2 * kp + (jj >> 2)) + 4 * q4 + (jj & 3); rows[jj] = R > 255 ? 255 : R; }
#pragma unroll
            for (int db = 0; db < 4; ++db) { bf16x8 va;
#pragma unroll
                for (int jj = 0; jj < 8; ++jj) va[jj] = (short)VL[rows[jj] * 72 + 16 * db + l15];
                oa[db] = MFMA16(va, pb, oa[db]); }
        }
        const float il = 1.0f / lsum; const size_t tok = (size_t)b * SEQ + (size_t)(m0 + 16 * w + l15) * dil + cls;
#pragma unroll
        for (int db = 0; db < 4; ++db) *(f32x4*)(AO + tok * 768 + head * 64 + 16 * db + 4 * q4) = oa[db] * il;
        if (q4 == 0) LSE[tok * 12 + head] = mx + __logf(lsum);
    }
}
__device__ __forceinline__ void attn_merge(const Ctx& X, const float* AO, const float* LSE, bf16* ya) {
    for (int i = X.c * NTHR + X.tid; i < TOK * 64; i += X.G * NTHR) {
        const int tk = i >> 6, hh = (i >> 4) & 3, d4 = (i & 15) * 4;
        const float l0 = LSE[(size_t)tk * 12 + hh], l1 = LSE[(size_t)tk * 12 + 4 + hh], l2 = LSE[(size_t)tk * 12 + 8 + hh];
        const float m = fmaxf(l0, fmaxf(l1, l2)), e0 = __expf(l0 - m), e1 = __expf(l1 - m), e2 = __expf(l2 - m), inv = 1.0f / (e0 + e1 + e2);
        const float* ap = AO + (size_t)tk * 768 + hh * 64 + d4;
        const f32x4 o = (*(const f32x4*)ap * e0 + *(const f32x4*)(ap + 256) * e1 + *(const f32x4*)(ap + 512) * e2) * inv;
        u32x2 wv; wv.x = pk2(o[0], o[1]); wv.y = pk2(o[2], o[3]); *(u32x2*)(ya + (size_t)tk * 256 + hh * 64 + d4) = wv;
    }
}

#ifndef MK_ONE_LAUNCH
#define MK_ONE_LAUNCH 1
#endif
constexpr int N_PHASES = 1 + 9 * DEPTH;
__device__ __forceinline__ bool fresh(Ctx& X) { asm volatile("" : "+v"(X.tid), "+v"(X.lane)); return true; }

#if defined(CHECK_BRANCHES)
constexpr size_t WS_YA2 = 969 * MiB, WS_YH2 = 973 * MiB;
__device__ __forceinline__ void cmp_bf16(const Ctx& X, const bf16* a, const bf16* ref, size_t n, float* cnt) {
    float d2 = 0.f, r2 = 0.f;
    for (size_t i = (size_t)X.c * NTHR + X.tid; i < n; i += (size_t)X.G * NTHR) { const float x = bf2f(a[i]), y = bf2f(ref[i]); d2 += (x - y) * (x - y); r2 += y * y; }
    d2 = wave_sum(d2); r2 = wave_sum(r2);
    if (X.lane == 0) { atomicAdd(cnt, d2); atomicAdd(cnt + 1, r2); }
}
#endif
struct Args { const float* in[18]; float* out; unsigned char* ws; int ph_lo, ph_hi; };
typedef pg8::bf16_t pbf;

__global__ void __launch_bounds__(NTHR, 2) fwd_kernel(Args args) {
    extern __shared__ __attribute__((aligned(16))) unsigned char lds[];
    cg::grid_group grid = cg::this_grid();
    Ctx X; X.lds = lds; X.tid = threadIdx.x; X.lane = X.tid & 63; X.wave = __builtin_amdgcn_readfirstlane(X.tid >> 6);
    X.G = gridDim.x; X.c = blockIdx.x; X.gw = X.c * NWAVES + X.wave; X.ngw = X.G * NWAVES;
    unsigned char* ws = args.ws; float* out = args.out;
    LAS unsigned char* ldsl = (LAS unsigned char*)lds;
    const int lo = args.ph_lo, hi = args.ph_hi;
#define IN(k) (lo <= (k) && (k) < hi && fresh(X))
#define INR(k) (lo <= (k) && (k) < hi)
#define SEAM(k) do { if (INR(k) && INR((k) + 1)) { if ((k) == 0) grid.sync(); else xcd_barrier(bar); } else __syncthreads(); } while (0)
    volatile LAS unsigned* MISC = (volatile LAS unsigned*)(ldsl + 131072);
    if (X.tid < 16) MISC[X.tid] = 0u;
    __syncthreads();
    XcdBarrier bar = xcd_barrier_post((unsigned*)(ws + 8192), MISC + 8);

    #ifndef SKIP_P0
    if (IN(0)) { prologue(X, args.in, out, ws); SEAM(0); }
#endif

    const float* ropec = (const float*)(ws + WS_TAB); const float* ropes = (const float*)(ws + WS_TAB + TAB_SIN); const float* lbt = (const float*)(ws + WS_TAB + TAB_LB);
    pbf* XA = (pbf*)(ws + WS_XA); pbf* Hb = (pbf*)(ws + WS_H); pbf* PT = (pbf*)(ws + WS_PT); float* FP = (float*)(ws + WS_FP);
    pbf* YF = (pbf*)(ws + WS_YF); pbf* YH = (pbf*)(ws + WS_YH); pbf* YA = (pbf*)(ws + WS_YA);
    float* MACC = (float*)(ws + WS_MACC); pbf* MERGED = (pbf*)(ws + WS_MERGED); float* VPRE = (float*)(ws + WS_VPRE); float* SC = (float*)(ws + WS_SC);
    float* FD = (float*)(ws + WS_LB); float* KY = FD + (size_t)2 * TOK * 768; float* OH = (float*)(ws + WS_SB);

    for (int l = 0; l < DEPTH; ++l) {
        const int pb = 1 + 9 * l;
        unsigned char* wl = ws + WS_WL0 + (size_t)l * WL_STRIDE;
        pbf* WinT = (pbf*)(wl + WL_WIN); pbf* WfT = (pbf*)(wl + WL_WF); pbf* BRF = (pbf*)(wl + WL_BRF); pbf* BRH = (pbf*)(wl + WL_BRH); pbf* BRA = (pbf*)(wl + WL_BRA);
        pbf* WoutT = (pbf*)(wl + WL_OUT); pbf* WsT = (pbf*)(wl + WL_WS); const unsigned char* Ub = wl + WL_U; const unsigned char* Vb = wl + WL_V;
        if (IN(pb + 0)) {
#ifndef SKIP_G1
            { pg8::Gemm g{XA, WinT, TOK, HW, DM, DM, DM}; pg8::StaticOrder S; S.init(TOK, HW, X.G, X.c); pg8::EpiBf16<0> E{Hb, HW, nullptr, 0, 0, 1.f};
              pg8::gemm_phase<pg8::EpiBf16<0>, pg8::StaticOrder, true, true>(ldsl, g, S, E); }
#endif
#ifndef SKIP_G2
            { pg8::Gemm g{WfT, XA, 1024, TOK, DM, DM, DM}; pg8::StaticOrder S; S.init(1024, TOK, X.G, X.c); pg8::EpiPT E{PT};
              pg8::gemm_phase<pg8::EpiPT, pg8::StaticOrder, true, true>(ldsl, g, S, E); }
#endif
            SEAM(pb + 0);
        }
        if (IN(pb + 1)) {
#ifndef SKIP_G3
            for (int it = X.c; it < 256; it += X.G) { const int ks = it >> 6, tile = it & 63;
                pg8::Gemm g{(const pbf*)(ws + WS_F) + ks * 2048, PT + ks * 2048, SEQ, 1024, 2048, 8192, 8192}; pg8::OneUnit S{tile >> 2, tile & 3}; pg8::EpiF32 E{FP + (size_t)ks * SEQ * 1024, 1024};
                pg8::gemm_phase<pg8::EpiF32, pg8::OneUnit, false, true>(ldsl, g, S, E); }
#endif
            __syncthreads();
#if defined(ATTN_NAIVE)
            attn_naive(X, Hb, ropec, ropes, YA);
#else
            attn_fast(X, Hb, ropec, ropes, (float*)(ws + WS_AO), (float*)(ws + WS_LSE));
#if defined(CHECK_BRANCHES)
            __syncthreads(); attn_naive(X, Hb, ropec, ropes, (pbf*)(ws + WS_YA2));
#endif
#endif
#if defined(HGRN_NAIVE)
            hgrn_prep_naive(X, Hb, lbt + l * 768, FD, KY);
#else
            __syncthreads();
            hgrn_pass1(X, Hb, lbt + l * 768, FD, (float*)(ws + WS_TAB + TAB_D));
#endif
            SEAM(pb + 1);
        }
        if (IN(pb + 2)) {
#if defined(HGRN_NAIVE)
            hgrn_scan_naive(X, Hb, FD, KY, OH);
#else
            hgrn_pass2(X, FD, (const float*)(ws + WS_TAB + TAB_D), (pbf*)(ws + WS_SB));
#endif
            fourier_reduce(X, FP, YF);
#if !defined(ATTN_NAIVE)
            attn_merge(X, (const float*)(ws + WS_AO), (const float*)(ws + WS_LSE), YA);
#endif
#if defined(CHECK_BRANCHES)
            grid.sync(); cmp_bf16(X, YA, (const pbf*)(ws + WS_YA2), (size_t)TOK * 256, (float*)ws);
#endif
            SEAM(pb + 2); }
        if (IN(pb + 3)) {
#if defined(HGRN_NAIVE)
            hgrn_combine_naive(X, Hb, OH, args.in[9] + (size_t)l * 768, YH);
#else
            hgrn_pass3(X, Hb, lbt + l * 768, (const pbf*)(ws + WS_SB), args.in[9] + (size_t)l * 768, YH);
#if defined(CHECK_BRANCHES)
            grid.sync(); hgrn_prep_naive(X, Hb, lbt + l * 768, FD, KY);
            grid.sync(); hgrn_scan_naive(X, Hb, FD, KY, OH);
            grid.sync(); hgrn_combine_naive(X, Hb, OH, args.in[9] + (size_t)l * 768, (pbf*)(ws + WS_YH2));
            grid.sync(); cmp_bf16(X, YH, (const pbf*)(ws + WS_YH2), (size_t)TOK * 768, (float*)ws + 2);
#endif
#endif
            SEAM(pb + 3); }
        if (IN(pb + 4)) {
#ifndef SKIP_G4
            { pg8::Gemm g{YF, BRF, TOK, DM, 512, 512, 512}; pg8::StaticOrder S; S.init(TOK, DM, X.G, X.c); pg8::EpiGate<0> E{Hb + H_GATE, HW, MACC, MERGED, DM};
              pg8::gemm_phase<pg8::EpiGate<0>, pg8::StaticOrder, true, true>(ldsl, g, S, E); }
#endif
#ifndef SKIP_G5
            { pg8::Gemm g{YH, BRH, TOK, DM, 768, 768, 768}; pg8::StaticOrder S; S.init(TOK, DM, X.G, X.c); pg8::EpiGate<1> E{Hb + H_GATE + DM, HW, MACC, MERGED, DM};
              pg8::gemm_phase<pg8::EpiGate<1>, pg8::StaticOrder, true, true>(ldsl, g, S, E); }
#endif
#ifndef SKIP_G6
            { pg8::Gemm g{YA, BRA, TOK, DM, 256, 256, 256}; pg8::StaticOrder S; S.init(TOK, DM, X.G, X.c); pg8::EpiGate<2> E{Hb + H_GATE + 2 * DM, HW, MACC, MERGED, DM};
              pg8::gemm_phase<pg8::EpiGate<2>, pg8::StaticOrder, true, true>(ldsl, g, S, E); }
#endif
            SEAM(pb + 4);
        }
        if (IN(pb + 5)) {
#ifndef SKIP_G7
            pg8::Gemm g{MERGED, WoutT, TOK, DM, DM, DM, DM}; pg8::StaticOrder S; S.init(TOK, DM, X.G, X.c); pg8::EpiResid E{out, VPRE, DM, DN_ALPHA};
            pg8::gemm_phase<pg8::EpiResid, pg8::StaticOrder, true, true>(ldsl, g, S, E);
#endif
            SEAM(pb + 5);
        }
        if (IN(pb + 6)) { ln_phase(X, VPRE, args.in[10] + (size_t)l * DM, args.in[11] + (size_t)l * DM, out, XA); SEAM(pb + 6); }
        if (IN(pb + 7)) {
#ifndef SKIP_G8
            pg8::Gemm g{XA, WsT, TOK, DM, DM, DM, DM}; pg8::StaticOrder S; S.init(TOK, DM, X.G, X.c); pg8::EpiF32 E{SC, DM};
            pg8::gemm_phase<pg8::EpiF32, pg8::StaticOrder, true, true>(ldsl, g, S, E);
#endif
            SEAM(pb + 7);
        }
        if (IN(pb + 8)) {
#ifndef SKIP_PEER
            peer_phase(X, SC, Ub, Vb, out, XA, args.in[16] + (size_t)l * DM, args.in[17] + (size_t)l * DM,
                       args.in[14] + (size_t)l * NEXP * DM, args.in[15] + (size_t)l * NEXP * DM, args.in[12] + (size_t)l * DM * DM, args.in[13] + (size_t)l * 2 * 128 * 128);
#endif
            if (pb + 8 + 1 < N_PHASES) SEAM(pb + 8); }
    }
#if defined(CHECK_BRANCHES)
    grid.sync();
    if (X.c == 0) { const float* cn = (const float*)ws; const float ra = cn[0] / fmaxf(cn[1], 1e-30f), rh = cn[2] / fmaxf(cn[3], 1e-30f);
        if (!(rh < 1e-3f && cn[3] > 1000.f) && X.tid < 500) { out[X.tid] += 10.f; out[500 + X.tid] += 10.f; }
        if (!(ra < 1e-3f && cn[1] > 1000.f)) { for (int i = 1000 + X.tid; i < 4000; i += NTHR) out[i] += 10.f; } }
#endif
#undef IN
#undef SEAM
}

extern "C" void kernel_launch(void* const* d_in, const int* in_sizes, int n_in, void* d_out, int out_size, void* d_ws, size_t ws_size, hipStream_t stream) {
    static int grid = 0;
    if (grid == 0) {
        if (n_in != 18 || in_sizes[0] != TOK * DM || out_size != TOK * DM || ws_size < WS_END2) {
            fprintf(stderr, "kernel_launch: unexpected shapes (n_in %d, in0 %d, out %d, ws %zu, need %zu); nothing launched\n", n_in, n_in > 0 ? in_sizes[0] : -1, out_size, ws_size, (size_t)WS_END2); grid = -1; return; }
        int dev = 0, cus = 0, per_cu = 0;
        if (hipGetDevice(&dev) != hipSuccess || hipDeviceGetAttribute(&cus, hipDeviceAttributeMultiprocessorCount, dev) != hipSuccess) { grid = -1; return; }
        if (hipFuncSetAttribute((const void*)fwd_kernel, hipFuncAttributeMaxDynamicSharedMemorySize, LDS_BYTES) != hipSuccess) { fprintf(stderr, "kernel_launch: hipFuncSetAttribute failed\n"); grid = -1; return; }
        if (hipOccupancyMaxActiveBlocksPerMultiprocessor(&per_cu, (const void*)fwd_kernel, NTHR, LDS_BYTES) != hipSuccess || per_cu < 1) { fprintf(stderr, "kernel_launch: occupancy query says %d blocks per CU\n", per_cu); grid = -1; (void)hipGetLastError(); return; }
        grid = cus * 1;
    }
    if (grid < 0) return;
    if (hipMemsetAsync(d_ws, 0, 65536, stream) != hipSuccess) { fprintf(stderr, "kernel_launch: memset failed\n"); return; }
    Args a{};
    for (int i = 0; i < 18; ++i) a.in[i] = (const float*)d_in[i];
    a.out = (float*)d_out; a.ws = (unsigned char*)d_ws;
#if MK_ONE_LAUNCH
    a.ph_lo = 0; a.ph_hi = N_PHASES;
    void* kargs[] = {&a};
    hipError_t e = hipLaunchCooperativeKernel((const void*)fwd_kernel, dim3(grid), dim3(NTHR), kargs, LDS_BYTES, stream);
    if (e != hipSuccess) fprintf(stderr, "kernel_launch: cooperative launch failed: %s (grid %d)\n", hipGetErrorString(e), grid);
#else
    for (int ph = 0; ph < N_PHASES; ++ph) { a.ph_lo = ph; a.ph_hi = ph + 1; hipLaunchKernelGGL(fwd_kernel, dim3(grid), dim3(NTHR), LDS_BYTES, stream, a); }
#endif
}
```

```cpp
#include <hip/hip_runtime.h>
#include <hip/hip_cooperative_groups.h>
#include <cstdio>
#include <cstdint>
namespace cg = cooperative_groups;
namespace pg8 {
#define PG8_LAS __attribute__((address_space(3)))
typedef unsigned short bf16_t;
typedef short bf16x8 __attribute__((ext_vector_type(8)));
typedef float f32x4 __attribute__((ext_vector_type(4)));
typedef unsigned u32x4 __attribute__((ext_vector_type(4)));
constexpr int BM = 256, BK = 64, HALF = 128, HTB = HALF * BK * 2  , STAGE_BYTES = 8 * HTB, NXCD = 8, WGM = 8;

__host__ __device__ __forceinline__ int lds_byte(int r, int c) { const int st = (r >> 4) * 2 + (c >> 5), rr = r & 15, cc = c & 31, ob = rr * 64 + cc * 2; return st * 1024 + (ob ^ (((ob >> 9) & 1) << 5)); }
__host__ __device__ __forceinline__ void stage_rc(int b, int& R, int& C) { const int st = b / 1024, sb = b % 1024, swz = sb ^ (((sb >> 9) & 1) << 5); R = (st >> 1) * 16 + swz / 64; C = (st & 1) * 32 + (swz % 64) / 2; }
__host__ __device__ __forceinline__ int perm32(int rho) { const int n = rho >> 4, i = rho & 15; return 8 * (i >> 2) + 4 * n + (i & 3); }

struct Unit { int pm, pn; };
struct Gemm { const bf16_t* A; const bf16_t* Bt; int M, N, K, lda, ldb; };

struct StaticOrder {
    int nM, nN, nwg, G, c;
    __host__ __device__ void init(int M, int N, int G_, int c_) { nM = M / BM; nN = N / BM; nwg = nM * nN; G = G_; c = c_; }
    __host__ __device__ bool next(int i, Unit& u) const {
        const long L = (long)i * G + c; if (L >= nwg) return false;
        int wgid = (int)L; { const int q = nwg / NXCD, r = nwg % NXCD, xcd = wgid % NXCD, off = wgid / NXCD; wgid = (xcd < r ? xcd * (q + 1) : r * (q + 1) + (xcd - r) * q) + off; }
        const int nig = WGM * nN, gid = wgid / nig, fm = gid * WGM, gsz = (nM - fm) < WGM ? (nM - fm) : WGM;
        u.pm = fm + ((wgid % nig) % gsz); u.pn = (wgid % nig) / gsz; return true;
    }
    __device__ __forceinline__ void a_ready(const Unit&) const {}
    __device__ __forceinline__ void done(const Unit&) const {}
};

__device__ __forceinline__ unsigned cvt_pk_bf16(float lo, float hi) { unsigned r; asm volatile("v_cvt_pk_bf16_f32 %0, %1, %2" : "=v"(r) : "v"(lo), "v"(hi)); return r; }
typedef float f32x2 __attribute__((ext_vector_type(2)));
__device__ __forceinline__ f32x2 gelu_pk(f32x2 v) {
    const f32x2 av = __builtin_elementwise_abs(v), d = av * 0.2316418882f + 1.0f;
    f32x2 t; t.x = __builtin_amdgcn_rcpf(d.x); t.y = __builtin_amdgcn_rcpf(d.y);
    f32x2 q = t * 0.5307027145f + (-0.7265760135f); q = q * t + 0.7107068705f; q = q * t + (-0.142248368f); q = q * t + 0.127414796f; q = q * t;
    const f32x2 s = (v * v) * (-0.72134752044f);
    f32x2 e; e.x = __builtin_amdgcn_exp2f(s.x); e.y = __builtin_amdgcn_exp2f(s.y);
    const f32x2 m = v * (q * e), r = v - m;
    f32x2 o; o.x = v.x < 0.f ? m.x : r.x; o.y = v.y < 0.f ? m.y : r.y; return o;
}

template <int ACT  > struct EpiBf16 {
    static constexpr bool PERM = true, AFTER_DRAIN = false; static_assert(ACT == 0 || ACT == 1, "EpiBf16: ACT is 0 (none) or 1 (gelu_pk)");
    bf16_t* O; int ldc; const float* bias; int split_cols; size_t split_stride; float scale0;
    __device__ __forceinline__ void operator()(const f32x4 (&acc)[2][2][4][2], const Unit& u, int wr, int wc, int fr, int fq) const {
        const int row0 = u.pm * BM + wr * 64 + fr; int colt = u.pn * BM; bf16_t* base = O;
        float sc = 1.f; if (split_cols) { const int t = colt / split_cols; base += (size_t)t * split_stride; colt -= t * split_cols; if (t == 0) sc = scale0; }
        const int col0 = colt + wc * 32 + 8 * fq, bcol0 = u.pn * BM + wc * 32 + 8 * fq;
        f32x4 bv[2][2];
#pragma unroll
        for (int bj = 0; bj < 2; ++bj)
#pragma unroll
            for (int n = 0; n < 2; ++n) bv[bj][n] = bias ? *(const f32x4*)(bias + bcol0 + bj * HALF + 4 * n) : (f32x4){0.f, 0.f, 0.f, 0.f};
#pragma unroll
        for (int ai = 0; ai < 2; ++ai)
#pragma unroll
            for (int m = 0; m < 4; ++m) { bf16_t* rowp = base + (size_t)(row0 + ai * HALF + m * 16) * ldc + col0;
#pragma unroll
                for (int bj = 0; bj < 2; ++bj) { f32x4 v0 = acc[ai][bj][m][0] + bv[bj][0], v1 = acc[ai][bj][m][1] + bv[bj][1];
                    if (ACT == 1) { f32x2 a = gelu_pk((f32x2){v0[0], v0[1]}), b = gelu_pk((f32x2){v0[2], v0[3]}), c = gelu_pk((f32x2){v1[0], v1[1]}), d = gelu_pk((f32x2){v1[2], v1[3]});
                        v0 = (f32x4){a.x, a.y, b.x, b.y}; v1 = (f32x4){c.x, c.y, d.x, d.y}; }
                    v0 = v0 * sc; v1 = v1 * sc; u32x4 w; w.x = cvt_pk_bf16(v0[0], v0[1]); w.y = cvt_pk_bf16(v0[2], v0[3]); w.z = cvt_pk_bf16(v1[0], v1[1]); w.w = cvt_pk_bf16(v1[2], v1[3]);
                    *(u32x4*)(rowp + bj * HALF) = w; } }
    }
};
#ifndef EXP_MIX_SCALE
#define EXP_MIX_SCALE 1.0f
#endif

struct EpiF32 {
    static constexpr bool PERM = false, AFTER_DRAIN = false;
    float* C; int ldc;
    __device__ __forceinline__ void operator()(const f32x4 (&acc)[2][2][4][2], const Unit& u, int wr, int wc, int fr, int fq) const {
        const int row0 = u.pm * BM + wr * 64 + fr, col0 = u.pn * BM + wc * 32 + 4 * fq;
        float* rowp = C + (size_t)row0 * ldc + col0;
#pragma unroll
        for (int ai = 0; ai < 2; ++ai) {
#pragma unroll
            for (int m = 0; m < 4; ++m) {
#pragma unroll
                for (int bj = 0; bj < 2; ++bj)
#pragma unroll
                    for (int n = 0; n < 2; ++n) *(f32x4*)(rowp + bj * HALF + n * 16) = acc[ai][bj][m][n];
                rowp += (size_t)16 * ldc; asm volatile("" : "+v"(rowp) :: "memory"); }
            rowp += (size_t)64 * ldc; }
    }
};
struct EpiPT {
    static constexpr bool PERM = true, AFTER_DRAIN = false;
    bf16_t* PT;
    __device__ __forceinline__ void operator()(const f32x4 (&acc)[2][2][4][2], const Unit& u, int wr, int wc, int fr, int fq) const {
        const int m0 = u.pm * BM, part = m0 >> 9, j0 = m0 & 511, n0 = u.pn * BM, b = n0 >> 12, n10 = n0 & 4095;
        bf16_t* base = PT + (size_t)(b * 512 + j0) * 8192 + part * 4096 + n10;
        const int row0 = wr * 64 + fr, col0 = wc * 32 + 8 * fq;
        bf16_t* rowp = base + (size_t)row0 * 8192 + col0;
#pragma unroll
        for (int ai = 0; ai < 2; ++ai) {
#pragma unroll
            for (int m = 0; m < 4; ++m) {
#pragma unroll
                for (int bj = 0; bj < 2; ++bj) { const f32x4 v0 = acc[ai][bj][m][0], v1 = acc[ai][bj][m][1];
                    u32x4 w; w.x = cvt_pk_bf16(v0[0], v0[1]); w.y = cvt_pk_bf16(v0[2], v0[3]); w.z = cvt_pk_bf16(v1[0], v1[1]); w.w = cvt_pk_bf16(v1[2], v1[3]);
                    *(u32x4*)(rowp + bj * HALF) = w; }
                rowp += 16 * 8192; asm volatile("" : "+v"(rowp) :: "memory"); }
            rowp += 64 * 8192; }
    }
};
typedef unsigned u32x2 __attribute__((ext_vector_type(2)));
template <int MODE> struct EpiGate {
    static constexpr bool PERM = false, AFTER_DRAIN = false;
    const bf16_t* gate; int ldg; float* accbuf; bf16_t* out; int ldc;
    __device__ __forceinline__ void operator()(const f32x4 (&acc)[2][2][4][2], const Unit& u, int wr, int wc, int fr, int fq) const {
        const int row0 = u.pm * BM + wr * 64 + fr, col0 = u.pn * BM + wc * 32 + 4 * fq;
        const bf16_t* gp = gate + (size_t)row0 * ldg + col0; float* ab = accbuf + (size_t)row0 * ldc + col0; bf16_t* op = out + (size_t)row0 * ldc + col0;
#pragma unroll
        for (int ai = 0; ai < 2; ++ai) {
#pragma unroll
            for (int m = 0; m < 4; ++m) {
#pragma unroll
                for (int bj = 0; bj < 2; ++bj)
#pragma unroll
                    for (int n = 0; n < 2; ++n) { const int c = bj * HALF + n * 16;
                        const u32x2 gw = *(const u32x2*)(gp + c);
                        f32x4 gt; gt[0] = __uint_as_float(gw.x << 16); gt[1] = __uint_as_float(gw.x & 0xffff0000u); gt[2] = __uint_as_float(gw.y << 16); gt[3] = __uint_as_float(gw.y & 0xffff0000u);
                        f32x4 v;
#pragma unroll
                        for (int e = 0; e < 4; ++e) v[e] = acc[ai][bj][m][n][e] * __builtin_amdgcn_rcpf(1.0f + __expf(-gt[e]));
                        if (MODE == 0) *(f32x4*)(ab + c) = v;
                        else if (MODE == 1) *(f32x4*)(ab + c) = *(const f32x4*)(ab + c) + v;
                        else { const f32x4 o = *(const f32x4*)(ab + c) + v; u32x2 w; w.x = cvt_pk_bf16(o[0], o[1]); w.y = cvt_pk_bf16(o[2], o[3]); *(u32x2*)(op + c) = w; } }
                gp += (size_t)16 * ldg; ab += (size_t)16 * ldc; op += (size_t)16 * ldc; asm volatile("" : "+v"(gp), "+v"(ab), "+v"(op) :: "memory"); }
            gp += (size_t)64 * ldg; ab += (size_t)64 * ldc; op += (size_t)64 * ldc; }
    }
};
struct EpiResid {
    static constexpr bool PERM = false, AFTER_DRAIN = false;
    const float* base; float* C; int ldc; float alpha;
    __device__ __forceinline__ void operator()(const f32x4 (&acc)[2][2][4][2], const Unit& u, int wr, int wc, int fr, int fq) const {
        const int row0 = u.pm * BM + wr * 64 + fr, col0 = u.pn * BM + wc * 32 + 4 * fq;
        const float* bp = base + (size_t)row0 * ldc + col0; float* cp = C + (size_t)row0 * ldc + col0;
#pragma unroll
        for (int ai = 0; ai < 2; ++ai) {
#pragma unroll
            for (int m = 0; m < 4; ++m) {
#pragma unroll
                for (int bj = 0; bj < 2; ++bj)
#pragma unroll
                    for (int n = 0; n < 2; ++n) { const f32x4 bs = *(const f32x4*)(bp + bj * HALF + n * 16); *(f32x4*)(cp + bj * HALF + n * 16) = bs * alpha + acc[ai][bj][m][n] * EXP_MIX_SCALE; }
                bp += (size_t)16 * ldc; cp += (size_t)16 * ldc; asm volatile("" : "+v"(bp), "+v"(cp) :: "memory"); }
            bp += (size_t)64 * ldc; cp += (size_t)64 * ldc; }
    }
};
struct OneUnit {
    int pm, pn;
    __device__ __forceinline__ bool next(int i, Unit& u) const { if (i > 0) return false; u.pm = pm; u.pn = pn; return true; }
    __device__ __forceinline__ void a_ready(const Unit&) const {}
    __device__ __forceinline__ void done(const Unit&) const {}
};
template <class Epi, class Sched, bool ALIGN_EPI = false, bool SP2 = false>
__device__ __forceinline__ void gemm_phase(PG8_LAS unsigned char* lds, const Gemm g, const Sched& S, const Epi& E) {
    int tid_ = threadIdx.x; asm volatile("" : "+v"(tid_));
    const int tid = tid_, wid = __builtin_amdgcn_readfirstlane(tid >> 6), lane = tid & 63, wr = wid >> 2, wc = wid & 3, fr = lane & 15, fq = lane >> 4;
    int K_ = g.K; asm volatile("" : "+s"(K_));
    const int K = K_, nt = K / BK;
    unsigned voffA[2], voffB[2];
#pragma unroll
    for (int i = 0; i < 2; ++i) { int R, C; stage_rc(tid * 16 + i * 8192, R, C); const int Rb = Epi::PERM ? ((R & ~31) + perm32(R & 31)) : R;
        voffA[i] = (unsigned)(R * g.lda + C) * 2u; voffB[i] = (unsigned)(Rb * g.ldb + C) * 2u; }
    const size_t kstep = (size_t)(BK * 2);
    const size_t hstepA = (size_t)HALF * g.lda * 2, hstepB = (size_t)HALF * g.ldb * 2;
    const size_t tstepA = 2 * hstepA, tstepB = 2 * hstepB;
    const unsigned ldsw = (unsigned)wid * 1024u;
    const int aoff = lds_byte(wr * 64 + fr, fq * 8), boff = lds_byte(wc * 32 + fr, fq * 8);
#define PG8_SA(b, h) (((b) * 2 + (h)) * HTB)
#define PG8_SB(b, h) ((4 + (b) * 2 + (h)) * HTB)
#define PG8_STAGE(bufoff, gbase, voff) do { _Pragma("unroll") for (int _i = 0; _i < 2; ++_i) \
        __builtin_amdgcn_global_load_lds((const unsigned*)((const char*)(gbase) + (voff)[_i]), (PG8_LAS unsigned*)(lds + (bufoff) + ldsw + _i * 8192), 16, 0, 0); } while (0)
#define PG8_LDA(dst, b, h) do { _Pragma("unroll") for (int m = 0; m < 4; ++m) _Pragma("unroll") for (int k = 0; k < 2; ++k) dst[m][k] = *(const PG8_LAS bf16x8*)(lds + PG8_SA(b, h) + aoff + m * 2048 + k * 1024); } while (0)
#define PG8_LDB(dst, b, h) do { _Pragma("unroll") for (int n = 0; n < 2; ++n) _Pragma("unroll") for (int k = 0; k < 2; ++k) dst[n][k] = *(const PG8_LAS bf16x8*)(lds + PG8_SB(b, h) + boff + n * 2048 + k * 1024); } while (0)
#define PG8_MMA(ai, bj, At, Bt) do { __builtin_amdgcn_s_setprio(1); _Pragma("unroll") for (int m = 0; m < 4; ++m) _Pragma("unroll") for (int n = 0; n < 2; ++n) _Pragma("unroll") for (int k = 0; k < 2; ++k) \
        acc[ai][bj][m][n] = __builtin_amdgcn_mfma_f32_16x16x32_bf16(Bt[n][k], At[m][k], acc[ai][bj][m][n], 0, 0, 0); __builtin_amdgcn_s_setprio(0); } while (0)
#define PG8_WAIT_V(n) asm volatile("s_waitcnt vmcnt(" #n ")" ::: "memory")
#define PG8_WAIT_L(n) asm volatile("s_waitcnt lgkmcnt(" #n ")" ::: "memory")
#define PG8_BAR __builtin_amdgcn_s_barrier()
#define PG8_SCHED __builtin_amdgcn_sched_barrier(0)
    Unit cur, nxt; int ui = 0;
    if (!S.next(0, cur)) return;
    f32x4 acc[2][2][4][2];
#pragma unroll
    for (int a = 0; a < 2; ++a)
#pragma unroll
        for (int b = 0; b < 2; ++b)
#pragma unroll
            for (int m = 0; m < 4; ++m)
#pragma unroll
                for (int n = 0; n < 2; ++n) acc[a][b][m][n] = (f32x4){0.f, 0.f, 0.f, 0.f};
    bf16x8 At[4][2], B0[2][2], B1[2][2];
    const char* cA = (const char*)g.A + (size_t)cur.pm * tstepA; const char* cB = (const char*)g.Bt + (size_t)cur.pn * tstepB;
    S.a_ready(cur);
    if constexpr (SP2) {
        PG8_STAGE(PG8_SB(0, 0), cB, voffB); PG8_STAGE(PG8_SB(0, 1), cB + hstepB, voffB); PG8_STAGE(PG8_SA(0, 0), cA, voffA); PG8_STAGE(PG8_SA(0, 1), cA + hstepA, voffA);
        if (wr == 1) PG8_BAR;
        PG8_WAIT_V(2); PG8_BAR;
        PG8_STAGE(PG8_SB(1, 0), cB + kstep, voffB); PG8_STAGE(PG8_SA(1, 0), cA + kstep, voffA); PG8_STAGE(PG8_SB(1, 1), cB + hstepB + kstep, voffB);
        PG8_WAIT_V(6); PG8_BAR;
    } else {
        PG8_STAGE(PG8_SB(0, 0), cB, voffB); PG8_STAGE(PG8_SA(0, 0), cA, voffA); PG8_STAGE(PG8_SB(0, 1), cB + hstepB, voffB); PG8_STAGE(PG8_SA(0, 1), cA + hstepA, voffA);
        if (wr == 1) PG8_BAR;
        PG8_WAIT_V(4); PG8_BAR;
        PG8_STAGE(PG8_SB(1, 0), cB + kstep, voffB); PG8_STAGE(PG8_SA(1, 0), cA + kstep, voffA); PG8_STAGE(PG8_SB(1, 1), cB + hstepB + kstep, voffB);
        PG8_WAIT_V(6); PG8_BAR;
    }
    for (;;) {
        const bool has_next = S.next(ui + 1, nxt);
        const char* nA = has_next ? (const char*)g.A + (size_t)nxt.pm * tstepA : cA; const char* nB = has_next ? (const char*)g.Bt + (size_t)nxt.pn * tstepB : cB;
        for (int t = 0; t < nt; t += 2) {
            const bool last = (t == nt - 2);
            const char* a1 = cA + (size_t)(t + 1) * kstep;
            const char* a2 = last ? nA : cA + (size_t)(t + 2) * kstep; const char* b2 = last ? nB : cB + (size_t)(t + 2) * kstep;
            const char* a3 = a2 + kstep; const char* b3 = b2 + kstep;
            if (last && has_next) S.a_ready(nxt);
            if constexpr (SP2) {
            PG8_LDB(B0, 0, 0); PG8_LDB(B1, 0, 1); PG8_SCHED; PG8_LDA(At, 0, 0); PG8_STAGE(PG8_SA(1, 1), a1 + hstepA, voffA);
            PG8_WAIT_V(8); PG8_WAIT_L(0); PG8_BAR; PG8_MMA(0, 0, At, B0); PG8_MMA(0, 1, At, B1); PG8_BAR; PG8_SCHED;
            PG8_LDA(At, 0, 1); PG8_STAGE(PG8_SB(0, 0), b2, voffB); PG8_STAGE(PG8_SB(0, 1), b2 + hstepB, voffB); PG8_STAGE(PG8_SA(0, 0), a2, voffA);
            PG8_WAIT_V(8); PG8_WAIT_L(0); PG8_BAR; PG8_MMA(1, 0, At, B0); PG8_MMA(1, 1, At, B1); PG8_BAR; PG8_SCHED;
            PG8_LDB(B0, 1, 0); PG8_LDB(B1, 1, 1); PG8_SCHED; PG8_LDA(At, 1, 0); PG8_STAGE(PG8_SA(0, 1), a2 + hstepA, voffA);
            PG8_WAIT_V(8); PG8_WAIT_L(0); PG8_BAR; PG8_MMA(0, 0, At, B0); PG8_MMA(0, 1, At, B1); PG8_BAR; PG8_SCHED;
            PG8_LDA(At, 1, 1); PG8_STAGE(PG8_SB(1, 0), b3, voffB); PG8_STAGE(PG8_SB(1, 1), b3 + hstepB, voffB); PG8_STAGE(PG8_SA(1, 0), a3, voffA);
            PG8_WAIT_V(8); PG8_WAIT_L(0); PG8_BAR; PG8_MMA(1, 0, At, B0); PG8_MMA(1, 1, At, B1); PG8_BAR; PG8_SCHED;
            } else {
            PG8_LDB(B0, 0, 0); PG8_SCHED; PG8_LDA(At, 0, 0); PG8_STAGE(PG8_SA(1, 1), a1 + hstepA, voffA);
            PG8_WAIT_L(8); PG8_BAR; PG8_WAIT_L(0); PG8_MMA(0, 0, At, B0); PG8_BAR; PG8_SCHED;
            PG8_LDB(B1, 0, 1); PG8_STAGE(PG8_SB(0, 0), b2, voffB);
            PG8_BAR; PG8_WAIT_L(0); PG8_MMA(0, 1, At, B1); PG8_BAR;
            PG8_LDA(At, 0, 1); PG8_STAGE(PG8_SA(0, 0), a2, voffA);
            PG8_BAR; PG8_WAIT_L(0); PG8_MMA(1, 0, At, B0); PG8_BAR; PG8_SCHED;
            PG8_STAGE(PG8_SB(0, 1), b2 + hstepB, voffB);
            PG8_WAIT_V(6); PG8_BAR; PG8_MMA(1, 1, At, B1); PG8_BAR;
            PG8_LDB(B0, 1, 0); PG8_SCHED; PG8_LDA(At, 1, 0); PG8_STAGE(PG8_SA(0, 1), a2 + hstepA, voffA);
            PG8_WAIT_L(8); PG8_BAR; PG8_WAIT_L(0); PG8_MMA(0, 0, At, B0); PG8_BAR; PG8_SCHED;
            PG8_LDB(B1, 1, 1); PG8_STAGE(PG8_SB(1, 0), b3, voffB);
            PG8_BAR; PG8_WAIT_L(0); PG8_MMA(0, 1, At, B1); PG8_BAR;
            PG8_LDA(At, 1, 1); PG8_STAGE(PG8_SA(1, 0), a3, voffA);
            PG8_BAR; PG8_WAIT_L(0); PG8_MMA(1, 0, At, B0); PG8_BAR; PG8_SCHED;
            PG8_STAGE(PG8_SB(1, 1), b3 + hstepB, voffB);
            PG8_WAIT_V(6); PG8_BAR; PG8_MMA(1, 1, At, B1); PG8_BAR;
            }
        }
        if constexpr (ALIGN_EPI) { if (wr == 0) PG8_BAR; }
        if constexpr (!Epi::AFTER_DRAIN) { E(acc, cur, wr, wc, fr, fq); S.done(cur); }
        if (!has_next) break;
#pragma unroll
        for (int a = 0; a < 2; ++a)
#pragma unroll
            for (int b = 0; b < 2; ++b)
#pragma unroll
                for (int m = 0; m < 4; ++m)
#pragma unroll
                    for (int n = 0; n < 2; ++n) acc[a][b][m][n] = (f32x4){0.f, 0.f, 0.f, 0.f};
        cur = nxt; cA = nA; cB = nB; ++ui;
        if constexpr (ALIGN_EPI) { if (wr == 1) PG8_BAR; }
    }
    PG8_WAIT_V(0);
    if constexpr (!ALIGN_EPI) { if (wr == 0) PG8_BAR; }
    PG8_BAR;
    if constexpr (Epi::AFTER_DRAIN) { E.fused(acc, cur, wr, wc, fr, fq, lds, wid, lane); S.done(cur); }
#undef PG8_SA
#undef PG8_SB
#undef PG8_STAGE
#undef PG8_LDA
#undef PG8_LDB
#undef PG8_MMA
#undef PG8_WAIT_V
#undef PG8_WAIT_L
#undef PG8_BAR
#undef PG8_SCHED
}
}

#define LAS __attribute__((address_space(3)))
typedef unsigned short bf16;
typedef float f32x4 __attribute__((ext_vector_type(4)));
typedef float f32x2 __attribute__((ext_vector_type(2)));
typedef unsigned u32x4 __attribute__((ext_vector_type(4)));
typedef unsigned u32x2 __attribute__((ext_vector_type(2)));
typedef __bf16 bf16x2_t __attribute__((ext_vector_type(2)));

constexpr int NWAVES = 8, NTHR = 512;
constexpr int BATCH = 2, SEQ = 4096, DM = 2048, TOK = BATCH * SEQ, DEPTH = 2;
constexpr int W_IN = 12800, HW = 12288;
constexpr int H_FF = 0, H_FB = 768, H_Q = 1536, H_I = 2304, H_G = 3072, H_QA = 3840, H_KA = 4608, H_VA = 5376, H_GATE = 6144;
constexpr int NEXP = 16384;
constexpr float DN_ALPHA = 1.41421356237309515f;
constexpr float LN_EPS = 1e-5f;
constexpr int LDS_BYTES = 147456;

constexpr size_t MiB = 1u << 20;
constexpr size_t WS_WL0 = 1 * MiB, WL_STRIDE = 202 * MiB;
constexpr size_t WL_WIN = 0, WL_WF = 48 * MiB, WL_BRF = 52 * MiB, WL_BRH = 54 * MiB, WL_BRA = 57 * MiB, WL_OUT = 58 * MiB, WL_WS = 66 * MiB, WL_U = 74 * MiB, WL_V = 138 * MiB;
constexpr size_t WS_F = 405 * MiB;
constexpr size_t WS_H = 469 * MiB;
constexpr size_t WS_PT = 661 * MiB;
constexpr size_t WS_FP = 677 * MiB;
constexpr size_t WS_LB = 741 * MiB;
constexpr size_t WS_SB = 837 * MiB;
constexpr size_t WS_YF = 885 * MiB, WS_YH = 893 * MiB, WS_YA = 905 * MiB;
constexpr size_t WS_XA = 909 * MiB;
constexpr size_t WS_TAB = 941 * MiB;
constexpr size_t WS_END = 944 * MiB;
constexpr size_t WS_VPRE = WS_H, WS_SC = WS_H + 64 * MiB, WS_MACC = WS_FP, WS_MERGED = WS_LB;
constexpr size_t TAB_SIN = 128 * 1024, TAB_LB = 256 * 1024;

struct Ctx { unsigned char* lds; int tid, lane, wave, G, c, gw, ngw; };

__device__ __forceinline__ unsigned f2bf(float f) { unsigned u = __float_as_uint(f); return (u + 0x7fffu + ((u >> 16) & 1u)) >> 16; }
__device__ __forceinline__ unsigned pk2(float lo, float hi) { return f2bf(lo) | (f2bf(hi) << 16); }
__device__ __forceinline__ float bf2f(unsigned short b) { return __uint_as_float((unsigned)b << 16); }
__device__ __forceinline__ float bflo(unsigned w) { return __uint_as_float(w << 16); }
__device__ __forceinline__ float bfhi(unsigned w) { return __uint_as_float(w & 0xffff0000u); }
#define LDS_WAIT() asm volatile("s_waitcnt lgkmcnt(0)" ::: "memory")

template <int CTRL> __device__ __forceinline__ float dpp_f(float v) { return __int_as_float(__builtin_amdgcn_update_dpp(0, __float_as_int(v), CTRL, 0xF, 0xF, true)); }
__device__ __forceinline__ float rdlane(float v, int l) { return __int_as_float(__builtin_amdgcn_readlane(__float_as_int(v), l)); }
__device__ __forceinline__ float wave_max(float v) {
    v = fmaxf(v, dpp_f<0xB1>(v)); v = fmaxf(v, dpp_f<0x4E>(v)); v = fmaxf(v, dpp_f<0x141>(v)); v = fmaxf(v, dpp_f<0x140>(v));
    return fmaxf(fmaxf(rdlane(v, 0), rdlane(v, 16)), fmaxf(rdlane(v, 32), rdlane(v, 48)));
}
__device__ __forceinline__ float wave_sum(float v) {
    v += dpp_f<0xB1>(v); v += dpp_f<0x4E>(v); v += dpp_f<0x141>(v); v += dpp_f<0x140>(v);
    return (rdlane(v, 0) + rdlane(v, 16)) + (rdlane(v, 32) + rdlane(v, 48));
}

__device__ __forceinline__ void transpose_item(const float* W, int ldw, int K, int N, bf16* WT, LAS float* scr, int item, int lane) {
    const int nblk = N / 32, kb = item / nblk, nb = item % nblk, k0 = 64 * kb, n0 = 32 * nb;
    f32x4 rv[8];
#pragma unroll
    for (int i = 0; i < 8; ++i) rv[i] = *(const f32x4*)(W + (size_t)(k0 + 8 * i + (lane >> 3)) * ldw + n0 + (lane & 7) * 4);
#pragma unroll
    for (int i = 0; i < 8; ++i) { LAS float* d = scr + (8 * i + (lane >> 3)) * 33 + (lane & 7) * 4; d[0] = rv[i][0]; d[1] = rv[i][1]; d[2] = rv[i][2]; d[3] = rv[i][3]; }
    LDS_WAIT(); asm volatile("" ::: "memory");
    const int c = lane & 7;
#pragma unroll
    for (int j = 0; j < 4; ++j) { const int n = (lane >> 3) + 8 * j; const LAS float* s = scr + (8 * c) * 33 + n;
        u32x4 o; o.x = pk2(s[0 * 33], s[1 * 33]); o.y = pk2(s[2 * 33], s[3 * 33]); o.z = pk2(s[4 * 33], s[5 * 33]); o.w = pk2(s[6 * 33], s[7 * 33]);
        *(u32x4*)(WT + (size_t)(n0 + n) * K + k0 + 8 * c) = o; }
    LDS_WAIT(); asm volatile("" ::: "memory");
}
__device__ __forceinline__ void ln_row(const float (&v)[32], int lane, const float* g, const float* b, float* of, bf16* ob) {
    float s = 0.f;
#pragma unroll
    for (int i = 0; i < 32; ++i) s += v[i];
    const float mean = wave_sum(s) * (1.f / DM);
    float s2 = 0.f;
#pragma unroll
    for (int i = 0; i < 32; ++i) { const float d = v[i] - mean; s2 += d * d; }
    const float rstd = 1.0f / sqrtf(wave_sum(s2) * (1.f / DM) + LN_EPS);
#pragma unroll
    for (int c = 0; c < 4; ++c) { const int e0 = c * 512 + lane * 8;
        const f32x4 g0 = *(const f32x4*)(g + e0), g1 = *(const f32x4*)(g + e0 + 4), b0 = *(const f32x4*)(b + e0), b1 = *(const f32x4*)(b + e0 + 4);
        f32x4 o0, o1;
#pragma unroll
        for (int e = 0; e < 4; ++e) { o0[e] = (v[c * 8 + e] - mean) * rstd * g0[e] + b0[e]; o1[e] = (v[c * 8 + 4 + e] - mean) * rstd * g1[e] + b1[e]; }
        *(f32x4*)(of + e0) = o0; *(f32x4*)(of + e0 + 4) = o1;
        u32x4 w; w.x = pk2(o0[0], o0[1]); w.y = pk2(o0[2], o0[3]); w.z = pk2(o1[0], o1[1]); w.w = pk2(o1[2], o1[3]);
        *(u32x4*)(ob + e0) = w; }
}
__device__ __forceinline__ void load_row32(const float* src, int lane, float (&v)[32]) {
#pragma unroll
    for (int c = 0; c < 4; ++c) { const f32x4 a = *(const f32x4*)(src + c * 512 + lane * 8), b = *(const f32x4*)(src + c * 512 + lane * 8 + 4);
#pragma unroll
        for (int e = 0; e < 4; ++e) { v[c * 8 + e] = a[e]; v[c * 8 + 4 + e] = b[e]; } }
}

template <int CH, int EPC> __device__ __forceinline__ void load_row_t(const float* src, int lane, float (&v)[32]) {
#pragma unroll
    for (int c = 0; c < CH; ++c)
#pragma unroll
        for (int q = 0; q < EPC / 4; ++q) { const f32x4 a = *(const f32x4*)(src + c * 64 * EPC + lane * EPC + 4 * q);
#pragma unroll
            for (int e = 0; e < 4; ++e) v[c * EPC + 4 * q + e] = a[e]; }
}
template <int CH, int EPC> __device__ __forceinline__ void ln_row_t(const float (&v)[32], int lane, const float* g, const float* b, float* of, bf16* ob) {
    float s = 0.f;
#pragma unroll
    for (int i = 0; i < 32; ++i) s += v[i];
    const float mean = wave_sum(s) * (1.f / DM);
    float s2 = 0.f;
#pragma unroll
    for (int i = 0; i < 32; ++i) { const float d = v[i] - mean; s2 += d * d; }
    const float rstd = 1.0f / sqrtf(wave_sum(s2) * (1.f / DM) + LN_EPS);
#pragma unroll
    for (int c = 0; c < CH; ++c)
#pragma unroll
        for (int q = 0; q < EPC / 8; ++q) { const int e0 = c * 64 * EPC + lane * EPC + 8 * q, i0 = c * EPC + 8 * q;
            const f32x4 g0 = *(const f32x4*)(g + e0), g1 = *(const f32x4*)(g + e0 + 4), b0 = *(const f32x4*)(b + e0), b1 = *(const f32x4*)(b + e0 + 4);
            f32x4 o0, o1;
#pragma unroll
            for (int e = 0; e < 4; ++e) { o0[e] = (v[i0 + e] - mean) * rstd * g0[e] + b0[e]; o1[e] = (v[i0 + 4 + e] - mean) * rstd * g1[e] + b1[e]; }
            *(f32x4*)(of + e0) = o0; *(f32x4*)(of + e0 + 4) = o1;
            u32x4 w; w.x = pk2(o0[0], o0[1]); w.y = pk2(o0[2], o0[3]); w.z = pk2(o1[0], o1[1]); w.w = pk2(o1[2], o1[3]);
            *(u32x4*)(ob + e0) = w; }
}
constexpr float PEER_US = 64.0f, PEER_VS = 16.0f, PEER_XS = 32.0f;
__device__ __forceinline__ unsigned pk4_fp8(float a, float b, float c, float d) { int w = __builtin_amdgcn_cvt_pk_fp8_f32(a, b, 0, false); return (unsigned)__builtin_amdgcn_cvt_pk_fp8_f32(c, d, w, true); }
__device__ __forceinline__ void prologue(const Ctx& X, const float* const* in, float* out, unsigned char* ws) {
    const float* x = in[0]; const float* emb_g = in[1]; const float* emb_b = in[2]; const float* w_in = in[3];
    const float* w_brf = in[4]; const float* w_brh = in[5]; const float* w_bra = in[6]; const float* w_out = in[7];
    const float* lb_logits = in[8]; const float* w_query = in[12]; const float* sub_keys = in[13]; const float* peer_u = in[14]; const float* peer_v = in[15];
    const int lane = X.lane, tid = X.tid;
#ifndef PRO_REP
#define PRO_REP 0
#endif
    for (int rp = 0; rp < (PRO_REP == 1 ? 2 : 1); ++rp) {
        LAS float* scr = (LAS float*)(X.lds + X.wave * 16384);
        constexpr int I_WIN = (DM / 64) * (HW / 32), I_BRF = (512 / 64) * (DM / 32), I_BRH = (768 / 64) * (DM / 32), I_BRA = (256 / 64) * (DM / 32), I_OUT = (DM / 64) * (DM / 32);
        constexpr int PER_L = I_WIN + I_BRF + I_BRH + I_BRA + I_OUT;
        for (int it = X.gw; it < DEPTH * PER_L; it += X.ngw) {
            const int l = it / PER_L; int r = it % PER_L; unsigned char* wl = ws + WS_WL0 + (size_t)l * WL_STRIDE;
            if (r < I_WIN) { transpose_item(w_in + (size_t)l * DM * W_IN + 512, W_IN, DM, HW, (bf16*)(wl + WL_WIN), scr, r, lane); continue; } r -= I_WIN;
            if (r < I_BRF) { transpose_item(w_brf + (size_t)l * 512 * DM, DM, 512, DM, (bf16*)(wl + WL_BRF), scr, r, lane); continue; } r -= I_BRF;
            if (r < I_BRH) { transpose_item(w_brh + (size_t)l * 768 * DM, DM, 768, DM, (bf16*)(wl + WL_BRH), scr, r, lane); continue; } r -= I_BRH;
            if (r < I_BRA) { transpose_item(w_bra + (size_t)l * 256 * DM, DM, 256, DM, (bf16*)(wl + WL_BRA), scr, r, lane); continue; } r -= I_BRA;
            transpose_item(w_out + (size_t)l * DM * DM, DM, DM, DM, (bf16*)(wl + WL_OUT), scr, r, lane);
        }
    }
    for (int rp = 0; rp < (PRO_REP == 2 ? 2 : 1); ++rp) {
        const size_t n16 = (size_t)NEXP * DM / 16; const size_t gt = (size_t)X.c * NTHR + tid, gs = (size_t)X.G * NTHR;
        for (int l = 0; l < DEPTH; ++l) {
            const float* su = peer_u + (size_t)l * NEXP * DM; const float* sv = peer_v + (size_t)l * NEXP * DM;
            unsigned char* du = ws + WS_WL0 + (size_t)l * WL_STRIDE + WL_U; unsigned char* dv = ws + WS_WL0 + (size_t)l * WL_STRIDE + WL_V;
            for (size_t i = gt; i < n16; i += gs) {
                u32x4 w, z;
                { const f32x4 a0 = *(const f32x4*)(su + i * 16) * PEER_US, a1 = *(const f32x4*)(su + i * 16 + 4) * PEER_US, a2 = *(const f32x4*)(su + i * 16 + 8) * PEER_US, a3 = *(const f32x4*)(su + i * 16 + 12) * PEER_US;
                  w.x = pk4_fp8(a0[0], a0[1], a0[2], a0[3]); w.y = pk4_fp8(a1[0], a1[1], a1[2], a1[3]); w.z = pk4_fp8(a2[0], a2[1], a2[2], a2[3]); w.w = pk4_fp8(a3[0], a3[1], a3[2], a3[3]); }
                { const f32x4 a0 = *(const f32x4*)(sv + i * 16) * PEER_VS, a1 = *(const f32x4*)(sv + i * 16 + 4) * PEER_VS, a2 = *(const f32x4*)(sv + i * 16 + 8) * PEER_VS, a3 = *(const f32x4*)(sv + i * 16 + 12) * PEER_VS;
                  z.x = pk4_fp8(a0[0], a0[1], a0[2], a0[3]); z.y = pk4_fp8(a1[0], a1[1], a1[2], a1[3]); z.z = pk4_fp8(a2[0], a2[1], a2[2], a2[3]); z.w = pk4_fp8(a3[0], a3[1], a3[2], a3[3]); }
                *(u32x4*)(du + i * 16) = w; *(u32x4*)(dv + i * 16) = z;
            }
        }
    }
    __syncthreads();
    for (int rp = 0; rp < (PRO_REP == 3 ? 2 : 1); ++rp) {
        LAS float* wt = (LAS float*)X.lds;
        LAS float* ct = (LAS float*)(X.lds + 64 * 129 * 4);
        for (int it = X.c; it < DEPTH * 4 * 32; it += X.G) {
            const int l = it >> 7, g = (it >> 5) & 3, d0 = (it & 31) * 64;
            __syncthreads();
            if (tid < 128) ct[tid] = cospif((float)tid * (1.0f / 64.0f));
            const float* src = w_in + (size_t)l * DM * W_IN + (size_t)d0 * W_IN + g * 128;
#pragma unroll 4
            for (int i = 0; i < 16; ++i) { const int idx = tid + NTHR * i, dd = idx >> 7, n2 = idx & 127; wt[dd * 129 + n2] = src[(size_t)dd * W_IN + n2]; }
            __syncthreads();
            const int dd = tid & 63, rg = X.wave;
            float acc[32];
#pragma unroll
            for (int i = 0; i < 32; ++i) acc[i] = 0.f;
            const int part = rg >> 2, k2b = (rg & 3) * 32;
            for (int n2 = 0; n2 < 128; ++n2) {
                const float w = wt[dd * 129 + n2];
#pragma unroll
                for (int i = 0; i < 32; ++i) { const int k2 = k2b + i; const int m = (k2 * n2 - part * 32) & 127; acc[i] += ct[m] * w; }
            }
            bf16* dst = (bf16*)(ws + WS_WL0 + (size_t)l * WL_STRIDE + WL_WF);
#pragma unroll
            for (int i = 0; i < 32; ++i) dst[(size_t)(part * 512 + g * 128 + k2b + i) * DM + d0 + dd] = (bf16)f2bf(acc[i]);
        }
    }
    __syncthreads();
    for (int rp = 0; rp < (PRO_REP == 4 ? 2 : 1); ++rp) {
        LAS float* wq = (LAS float*)X.lds;
        LAS float* ky = (LAS float*)(X.lds + 64 * 129 * 4 + 64);
        for (int it = X.c; it < DEPTH * 16 * 32; it += X.G) {
            const int l = it >> 9, hp = (it >> 5) & 15, dm0 = (it & 31) * 64, p = hp & 1;
            __syncthreads();
            const float* ksrc = sub_keys + ((size_t)l * 2 + p) * 128 * 128;
#pragma unroll 4
            for (int i = 0; i < 32; ++i) ky[tid + NTHR * i] = ksrc[tid + NTHR * i];
            const float* src = w_query + (size_t)l * DM * DM + (size_t)dm0 * DM + hp * 128;
#pragma unroll 4
            for (int i = 0; i < 16; ++i) { const int idx = tid + NTHR * i, dd = idx >> 7, d = idx & 127; wq[dd * 129 + d] = src[(size_t)dd * DM + d]; }
            __syncthreads();
            const int dd = tid & 63, k0 = X.wave * 16;
            float acc[16];
#pragma unroll
            for (int i = 0; i < 16; ++i) acc[i] = 0.f;
            for (int d = 0; d < 128; ++d) {
                const float w = wq[dd * 129 + d];
#pragma unroll
                for (int i = 0; i < 16; ++i) acc[i] += ky[(k0 + i) * 128 + d] * w;
            }
            bf16* dst = (bf16*)(ws + WS_WL0 + (size_t)l * WL_STRIDE + WL_WS);
#pragma unroll
            for (int i = 0; i < 16; ++i) dst[(size_t)(hp * 128 + k0 + i) * DM + dm0 + dd] = (bf16)f2bf(acc[i]);
        }
    }
    __syncthreads();
    for (int rp = 0; rp < (PRO_REP == 5 ? 2 : 1); ++rp) {
        LAS float* ct = (LAS float*)X.lds;
        const float norm = 1.0f / sqrtf((float)SEQ * 128.0f);
        for (int i = tid; i < 4096; i += NTHR) ct[i] = cospif((float)i * (1.0f / 2048.0f)) * norm;
        __syncthreads();
        bf16* Fm = (bf16*)(ws + WS_F);
        for (int k1 = X.c; k1 < SEQ; k1 += X.G) {
#pragma unroll
            for (int rep = 0; rep < 2; ++rep) {
                const int e0 = (tid + rep * NTHR) * 8;
                const int part = e0 >> 12, n1 = e0 & 4095;
                float v[8];
#pragma unroll
                for (int j = 0; j < 8; ++j) { const int idx = (k1 * (n1 + j)) & 4095; v[j] = part ? -ct[(idx - 1024) & 4095] : ct[idx]; }
                u32x4 w; w.x = pk2(v[0], v[1]); w.y = pk2(v[2], v[3]); w.z = pk2(v[4], v[5]); w.w = pk2(v[6], v[7]);
                *(u32x4*)(Fm + (size_t)k1 * 8192 + e0) = w;
            }
        }
    }
    __syncthreads();
    {
        const int gt = X.c * NTHR + tid;
        if (gt < SEQ * 8) { const int pos = gt >> 3, i = gt & 7; const float invf = powf(500000.0f, -(float)i * 0.125f); const float ang = (float)pos * invf;
            ((float*)(ws + WS_TAB))[gt] = cosf(ang); ((float*)(ws + WS_TAB + TAB_SIN))[gt] = sinf(ang); }
        if (gt < 2 * 768) { const int dir = gt / 768, col = gt % 768; const float l0 = lb_logits[(dir * DEPTH + 0) * 768 + col], l1 = lb_logits[(dir * DEPTH + 1) * 768 + col];
            float* lb = (float*)(ws + WS_TAB + TAB_LB);
            lb[(dir * DEPTH + 0) * 768 + col] = 0.f;
            lb[(dir * DEPTH + 1) * 768 + col] = 1.0f / (1.0f + expf(l0 - l1)); }
    }
    for (int rp = 0; rp < (PRO_REP == 6 ? 2 : 1); ++rp)
    for (int m = X.gw; m < TOK; m += X.ngw) { float v[32]; load_row32(x + (size_t)m * DM, lane, v); ln_row(v, lane, emb_g, emb_b, out + (size_t)m * DM, (bf16*)(ws + WS_XA) + (size_t)m * DM); }
}
#define GAS __attribute__((address_space(1)))
typedef GAS unsigned gu32;
typedef GAS unsigned long long gu64;
#define RLX_AGENT __ATOMIC_RELAXED, __HIP_MEMORY_SCOPE_AGENT
#define VM_WAIT() asm volatile("s_waitcnt vmcnt(0)" ::: "memory")
__device__ __forceinline__ unsigned long long rt() { return __builtin_amdgcn_s_memrealtime(); }
#define XB_TMO      128
#define XB_XCNT(j)  (256  + 64 * (j))
#define XB_XSUB(j)  (1280 + 64 * (j))
#define XB_XGEN(j)  (2304 + 64 * (j))
#define XB_TOP      3328
#define XB_TOPGEN   3392
#define XCD_BAR_WORDS 3456
#define XB_SPIN_CAP (1u << 22)

__device__ __forceinline__ unsigned xb_ld(unsigned* p)              { return __hip_atomic_load(p, __ATOMIC_RELAXED, __HIP_MEMORY_SCOPE_AGENT); }
__device__ __forceinline__ unsigned xb_add(unsigned* p, unsigned v) { return __hip_atomic_fetch_add(p, v, __ATOMIC_RELAXED, __HIP_MEMORY_SCOPE_AGENT); }
__device__ __forceinline__ unsigned xb_xcc_id() { return (unsigned)__builtin_amdgcn_s_getreg((3 << 11) | 20) & 0xFu; }
#define XB_SPIN(cond, bar) do { unsigned _sp = 0; while (cond) { __builtin_amdgcn_s_sleep(1); \
    if ((++_sp & 255u) == 0u) { if (xb_ld(&(bar)[XB_TMO])) break; if (_sp > XB_SPIN_CAP) { atomicAdd(&(bar)[XB_TMO], 1u); break; } } } } while (0)

struct XcdBarrier {
    unsigned* bar; unsigned x;
    volatile LAS unsigned* st;
};

__device__ __forceinline__ XcdBarrier xcd_barrier_post(unsigned* bar, volatile LAS unsigned* st) {
    XcdBarrier b; b.bar = bar; b.x = xb_xcc_id(); b.st = st;
    if (threadIdx.x == 0) (void)xb_add(&bar[XB_XCNT(b.x)], 1u);
    return b;
}
__device__ __forceinline__ void xcd_barrier_complete(unsigned* bar, unsigned x, unsigned& nloc, unsigned& nx) {
    const unsigned G = gridDim.x * gridDim.y * gridDim.z;
    unsigned sum, cnt, mine, sp = 0u;
    for (;;) {
        sum = 0u; cnt = 0u; mine = 0u;
#pragma unroll
        for (unsigned j = 0; j < 16; ++j) { const unsigned c = xb_ld(&bar[XB_XCNT(j)]); sum += c; cnt += (c > 0u) ? 1u : 0u; mine = (j == x) ? c : mine; }
        if (sum == G) break;
        __builtin_amdgcn_s_sleep(1);
        if ((++sp & 255u) == 0u) { if (xb_ld(&bar[XB_TMO])) break; if (sp > XB_SPIN_CAP) { atomicAdd(&bar[XB_TMO], 1u); break; } }
    }
    nloc = mine > 0u ? mine : 1u; nx = cnt > 0u ? cnt : 1u;
}

__device__ __forceinline__ void xcd_barrier(const XcdBarrier& b) {
    asm volatile("s_waitcnt vmcnt(0)" ::: "memory");
    __syncthreads();
    if (threadIdx.x == 0) {
        unsigned* bar = b.bar;
        __builtin_amdgcn_s_waitcnt(0);
        unsigned nloc = b.st[0], nx = b.st[1];
        if (nloc == 0u) { xcd_barrier_complete(bar, b.x, nloc, nx); b.st[0] = nloc; b.st[1] = nx; }
        const unsigned old = xb_add(&bar[XB_XSUB(b.x)], 1u);
        const unsigned gen = old / nloc;
        if (old + 1u == (gen + 1u) * nloc) {
            __builtin_amdgcn_fence(__ATOMIC_RELEASE, "agent");
            asm volatile("s_waitcnt vmcnt(0)" ::: "memory");
            const unsigned og = xb_add(&bar[XB_TOP], 1u);
            const unsigned tg = og / nx;
            if (og + 1u == (tg + 1u) * nx) xb_add(&bar[XB_TOPGEN], 1u);
            else XB_SPIN(xb_ld(&bar[XB_TOPGEN]) == tg, bar);
            __builtin_amdgcn_fence(__ATOMIC_ACQUIRE, "agent");
            xb_add(&bar[XB_XGEN(b.x)], 1u);
            asm volatile("s_waitcnt vmcnt(0)" ::: "memory");
        } else {
            XB_SPIN(xb_ld(&bar[XB_XGEN(b.x)]) == gen, bar);
            __builtin_amdgcn_fence(__ATOMIC_ACQUIRE, "agent");
            asm volatile("s_waitcnt vmcnt(0)" ::: "memory");
        }
    }
    __syncthreads();
}

__device__ __forceinline__ void attn_naive(const Ctx& X, const bf16* h, const float* rc, const float* rs, bf16* ya) {
    for (int idx = X.c * NTHR + X.tid; idx < TOK * 4; idx += X.G * NTHR) {
        const int tk = idx >> 2, hh = idx & 3, b = tk / SEQ, p = tk % SEQ;
        float mx = -1e30f, l = 0.f; float o[64];
#pragma unroll
        for (int d = 0; d < 64; ++d) o[d] = 0.f;
        for (int g = 0; g < 3; ++g) {
            const int dil = (g == 0) ? 1 : (g == 1 ? 4 : 16), head = g * 4 + hh;
            float q[64];
            { const bf16* qp = h + (size_t)tk * HW + H_QA + head * 64;
#pragma unroll
              for (int i = 0; i < 8; ++i) { const u32x4 w = *(const u32x4*)(qp + i * 8); q[i * 8 + 0] = bflo(w.x); q[i * 8 + 1] = bfhi(w.x); q[i * 8 + 2] = bflo(w.y); q[i * 8 + 3] = bfhi(w.y);
                  q[i * 8 + 4] = bflo(w.z); q[i * 8 + 5] = bfhi(w.z); q[i * 8 + 6] = bflo(w.w); q[i * 8 + 7] = bfhi(w.w); }
#pragma unroll
              for (int i = 0; i < 8; ++i) { const float c = rc[p * 8 + i], s = rs[p * 8 + i], t1 = q[i], t2 = q[8 + i]; q[i] = t1 * c - t2 * s; q[8 + i] = t2 * c + t1 * s; }
#pragma unroll
              for (int d = 0; d < 64; ++d) q[d] *= 0.125f; }
            for (int j = -64; j <= 64; ++j) {
                const int kp = p + j * dil; if (kp < 0 || kp >= SEQ) continue;
                const bf16* kr = h + (size_t)(b * SEQ + kp) * HW + H_KA + head * 64;
                float s = 0.f;
                { const u32x4 w0 = *(const u32x4*)(kr), w1 = *(const u32x4*)(kr + 8);
                  const float k1[8] = {bflo(w0.x), bfhi(w0.x), bflo(w0.y), bfhi(w0.y), bflo(w0.z), bfhi(w0.z), bflo(w0.w), bfhi(w0.w)};
                  const float k2[8] = {bflo(w1.x), bfhi(w1.x), bflo(w1.y), bfhi(w1.y), bflo(w1.z), bfhi(w1.z), bflo(w1.w), bfhi(w1.w)};
#pragma unroll
                  for (int i = 0; i < 8; ++i) { const float c = rc[kp * 8 + i], sn = rs[kp * 8 + i]; s += q[i] * (k1[i] * c - k2[i] * sn) + q[8 + i] * (k2[i] * c + k1[i] * sn); } }
#pragma unroll
                for (int i = 2; i < 8; ++i) { const u32x4 w = *(const u32x4*)(kr + i * 8);
                    s += q[i * 8 + 0] * bflo(w.x) + q[i * 8 + 1] * bfhi(w.x) + q[i * 8 + 2] * bflo(w.y) + q[i * 8 + 3] * bfhi(w.y) + q[i * 8 + 4] * bflo(w.z) + q[i * 8 + 5] * bfhi(w.z) + q[i * 8 + 6] * bflo(w.w) + q[i * 8 + 7] * bfhi(w.w); }
                const float mn = fmaxf(mx, s), corr = __expf(mx - mn), pr = __expf(s - mn);
                l = l * corr + pr; mx = mn;
                const bf16* vr = h + (size_t)(b * SEQ + kp) * HW + H_VA + head * 64;
#pragma unroll
                for (int i = 0; i < 8; ++i) { const u32x4 w = *(const u32x4*)(vr + i * 8);
                    o[i * 8 + 0] = o[i * 8 + 0] * corr + pr * bflo(w.x); o[i * 8 + 1] = o[i * 8 + 1] * corr + pr * bfhi(w.x); o[i * 8 + 2] = o[i * 8 + 2] * corr + pr * bflo(w.y); o[i * 8 + 3] = o[i * 8 + 3] * corr + pr * bfhi(w.y);
                    o[i * 8 + 4] = o[i * 8 + 4] * corr + pr * bflo(w.z); o[i * 8 + 5] = o[i * 8 + 5] * corr + pr * bfhi(w.z); o[i * 8 + 6] = o[i * 8 + 6] * corr + pr * bflo(w.w); o[i * 8 + 7] = o[i * 8 + 7] * corr + pr * bfhi(w.w); }
            }
        }
        const float il = 1.0f / l; bf16* op = ya + (size_t)tk * 256 + hh * 64;
#pragma unroll
        for (int i = 0; i < 8; ++i) { u32x4 w; w.x = pk2(o[i * 8] * il, o[i * 8 + 1] * il); w.y = pk2(o[i * 8 + 2] * il, o[i * 8 + 3] * il); w.z = pk2(o[i * 8 + 4] * il, o[i * 8 + 5] * il); w.w = pk2(o[i * 8 + 6] * il, o[i * 8 + 7] * il);
            *(u32x4*)(op + i * 8) = w; }
    }
}
__device__ __forceinline__ void hgrn_prep_naive(const Ctx& X, const bf16* h, const float* lbl  , float* FD, float* KY) {
    const size_t n = (size_t)2 * TOK * 768;
    for (size_t i = (size_t)X.c * NTHR + X.tid; i < n; i += (size_t)X.G * NTHR) {
        const int dir = (int)(i / ((size_t)TOK * 768)); const size_t r = i % ((size_t)TOK * 768); const int tk = (int)(r / 768), col = (int)(r % 768);
        const float z = bf2f(h[(size_t)tk * HW + (dir ? H_FB : H_FF) + col]); const float lb = lbl[dir * DEPTH * 768 + col];
        const float s = 1.0f / (1.0f + expf(-z));
        FD[i] = lb + (1.0f - lb) * s; KY[i] = (1.0f - lb) * (1.0f - s);
    }
}
__device__ __forceinline__ void hgrn_scan_naive(const Ctx& X, const bf16* h, const float* FD, const float* KY, float* O  ) {
    LAS float* sf = (LAS float*)X.lds; LAS float* sk = sf + 512; LAS float* sq = sk + 512;
    for (int it = X.c; it < 6; it += X.G) {
        const int grp = X.tid >> 7, v = X.tid & 127, ch = it * 4 + grp;
        const int dir = ch / 12, b = (ch % 12) / 6, hd = ch % 6;
        float S[128];
#pragma unroll
        for (int k = 0; k < 128; ++k) S[k] = 0.f;
        for (int st = 0; st < SEQ; ++st) {
            const int t = dir ? (SEQ - 1 - st) : st; const size_t tk = (size_t)b * SEQ + t;
            const size_t e = ((size_t)dir * TOK + tk) * 768 + hd * 128 + v;
            const float f = FD[e], ky = KY[e], qv = bf2f(h[tk * HW + H_Q + hd * 128 + v]), vv = bf2f(h[tk * HW + H_I + hd * 128 + v]);
            __syncthreads();
            sf[X.tid] = f; sk[X.tid] = ky; sq[X.tid] = qv;
            __syncthreads();
            float o = 0.f;
            const LAS f32x4* pf = (const LAS f32x4*)(sf + grp * 128); const LAS f32x4* pk = (const LAS f32x4*)(sk + grp * 128); const LAS f32x4* pq = (const LAS f32x4*)(sq + grp * 128);
#pragma unroll
            for (int k4 = 0; k4 < 32; ++k4) { const f32x4 a = pf[k4], c = pk[k4], d = pq[k4];
#pragma unroll
                for (int e2 = 0; e2 < 4; ++e2) { S[k4 * 4 + e2] = a[e2] * S[k4 * 4 + e2] + c[e2] * vv; o += d[e2] * S[k4 * 4 + e2]; } }
            O[e] = o;
        }
    }
}
__device__ __forceinline__ void hgrn_combine_naive(const Ctx& X, const bf16* h, const float* O, const float* norm_g, bf16* yh) {
    for (int it = X.gw; it < TOK * 6; it += X.ngw) {
        const int tk = it / 6, hd = it % 6; const size_t e = (size_t)tk * 768 + hd * 128 + X.lane * 2;
        const f32x2 a = *(const f32x2*)(O + e), b = *(const f32x2*)(O + (size_t)TOK * 768 + e);
        const float o0 = a[0] + b[0], o1 = a[1] + b[1];
        const float ms = wave_sum(o0 * o0 + o1 * o1) * (1.0f / 128.0f); const float r = 1.0f / sqrtf(ms + 1e-6f);
        const unsigned gw = *(const unsigned*)(h + (size_t)tk * HW + H_G + hd * 128 + X.lane * 2); const float g0 = bflo(gw), g1 = bfhi(gw);
        const f32x2 ng = *(const f32x2*)(norm_g + hd * 128 + X.lane * 2);
        const float y0 = o0 * r * ng[0] * (g0 / (1.0f + expf(-g0))), y1 = o1 * r * ng[1] * (g1 / (1.0f + expf(-g1)));
        *(unsigned*)(yh + e) = pk2(y0, y1);
    }
}
__device__ __forceinline__ void fourier_reduce(const Ctx& X, const float* FP, bf16* yf) {
    for (int i = X.c * NTHR + X.tid; i < SEQ * 1024 / 4; i += X.G * NTHR) {
        const int k1 = i >> 8, c4 = (i & 255) * 4;
        f32x4 s = *(const f32x4*)(FP + (size_t)k1 * 1024 + c4);
#pragma unroll
        for (int ks = 1; ks < 4; ++ks) s = s + *(const f32x4*)(FP + (size_t)ks * SEQ * 1024 + (size_t)k1 * 1024 + c4);
        const int b = c4 >> 9, j = c4 & 511; u32x2 w; w.x = pk2(s[0], s[1]); w.y = pk2(s[2], s[3]);
        *(u32x2*)(yf + (size_t)(b * SEQ + k1) * 512 + j) = w;
    }
}
__device__ __forceinline__ void ln_phase(const Ctx& X, const float* vpre, const float* g, const float* b, float* xres, bf16* xa) {
    for (int m = X.gw; m < TOK; m += X.ngw) { float v[32]; load_row32(vpre + (size_t)m * DM, X.lane, v); ln_row(v, X.lane, g, b, xres + (size_t)m * DM, xa + (size_t)m * DM); }
}

__device__ __forceinline__ float dot2bf(unsigned w, unsigned x, float acc) { return __builtin_amdgcn_fdot2_f32_bf16(__builtin_bit_cast(bf16x2_t, w), __builtin_bit_cast(bf16x2_t, x), acc, false); }
template <int CTRL> __device__ __forceinline__ unsigned dpp_u(unsigned v) { return (unsigned)__builtin_amdgcn_update_dpp(0, (int)v, CTRL, 0xF, 0xF, true); }
__device__ __forceinline__ unsigned peer_key(float f, int idx) { unsigned u = __float_as_uint(f); u = (u & 0x80000000u) ? ~u : (u | 0x80000000u); return (u & ~127u) | (unsigned)(127 - idx); }
__device__ __forceinline__ float peer_unkey(unsigned k) { const unsigned u = k & ~127u; return (u & 0x80000000u) ? __uint_as_float(u & 0x7fffffffu) : __uint_as_float(~u); }
__device__ __forceinline__ int peer_stair(int s) {
    int i, base;
    if (s < 16) { i = 0; base = 0; } else if (s < 24) { i = 1; base = 16; } else if (s < 29) { i = 2; base = 24; } else if (s < 33) { i = 3; base = 29; } else if (s < 36) { i = 4; base = 33; }
    else if (s < 38) { i = 5; base = 36; } else if (s < 40) { i = 6; base = 38; } else if (s < 42) { i = 7; base = 40; } else { i = 8 + (s - 42); base = s; }
    i = i > 15 ? 15 : i; return (i << 4) | (s - base);
}
#define MFMA8(a, b, c) __builtin_amdgcn_mfma_f32_16x16x32_fp8_fp8((a), (b), (c), 0, 0, 0)
__device__ __forceinline__ long pack64(unsigned lo, unsigned hi) { return (long)(((unsigned long long)hi << 32) | lo); }
__device__ __forceinline__ float gelu_erf(float x) { return 0.5f * x * (1.0f + erff(x * 0.70710678118654752f)); }
__device__ __forceinline__ void peer_phase(const Ctx& X, const float* scores, const unsigned char* U8, const unsigned char* V8, const float* xres, float* xout, bf16* xa, const float* lng, const float* lnb,
                                           const float* Uf, const float* Vf, const float* Wq, const float* Kf) {
    const int lane = X.lane;
        LAS float* sc = (LAS float*)(X.lds + X.wave * 12288);
    LAS float* tops = sc + 2048;
    LAS int* topi = (LAS int*)(tops + 256);
    LAS int* le = topi + 256;
    LAS float* lg = (LAS float*)(le + 128);
    const float NEG = -3.0e38f;
    for (int tk = X.gw; tk < TOK; tk += X.ngw) {
        const float* srow = scores + (size_t)tk * 2048;
#if defined(PEER_NAIVE_SC)
        { (void)srow;
          float qa[32];
#pragma unroll
          for (int i = 0; i < 32; ++i) qa[i] = 0.f;
          for (int dm = 0; dm < DM; ++dm) { const float xv = xres[(size_t)tk * DM + dm];
#pragma unroll
              for (int i = 0; i < 32; ++i) qa[i] += xv * Wq[(size_t)dm * DM + i * 64 + lane]; }
#pragma unroll
          for (int i = 0; i < 32; ++i) sc[i * 64 + lane] = qa[i];
          LDS_WAIT();
          float sv[32];
#pragma unroll
          for (int r = 0; r < 16; ++r) { const int p = r & 1;
              float s0 = 0.f, s1 = 0.f;
              for (int d = 0; d < 128; ++d) { const float qv = sc[r * 128 + d]; s0 += qv * Kf[((size_t)p * 128 + lane) * 128 + d]; s1 += qv * Kf[((size_t)p * 128 + 64 + lane) * 128 + d]; }
              sv[2 * r] = s0; sv[2 * r + 1] = s1; }
          LDS_WAIT();
#pragma unroll
          for (int r = 0; r < 16; ++r) { sc[r * 128 + lane] = sv[2 * r]; sc[r * 128 + 64 + lane] = sv[2 * r + 1]; }
          LDS_WAIT(); }
#else
#pragma unroll
        for (int i = 0; i < 8; ++i) *(LAS f32x4*)(sc + i * 256 + lane * 4) = *(const f32x4*)(srow + i * 256 + lane * 4);
        LDS_WAIT();
#endif
        { const int l15 = lane & 15, q4 = lane >> 4;
#pragma unroll 1
          for (int pass = 0; pass < 4; ++pass) {
              const int r = pass * 4 + q4; unsigned kv[8];
#pragma unroll
              for (int j = 0; j < 8; ++j) kv[j] = peer_key(sc[r * 128 + l15 + 16 * j], l15 + 16 * j);
#pragma unroll
              for (int it = 0; it < 16; ++it) {
                  unsigned m = max(max(max(kv[0], kv[1]), max(kv[2], kv[3])), max(max(kv[4], kv[5]), max(kv[6], kv[7])));
                  m = max(m, dpp_u<0xB1>(m)); m = max(m, dpp_u<0x4E>(m)); m = max(m, dpp_u<0x141>(m)); m = max(m, dpp_u<0x140>(m));
#pragma unroll
                  for (int j = 0; j < 8; ++j) kv[j] = (kv[j] == m) ? 0u : kv[j];
                  if (l15 == 0) { tops[r * 16 + it] = peer_unkey(m); topi[r * 16 + it] = 127 - (int)(m & 127u); }
              }
          }
          LDS_WAIT();
#pragma unroll 1
          for (int pass = 0; pass < 2; ++pass) {
              const int hd = pass * 4 + q4; unsigned kv[4]; int ij[4];
#pragma unroll
              for (int jj = 0; jj < 4; ++jj) { const int s = l15 * 4 + jj; ij[jj] = peer_stair(s);
                  const float v = tops[(2 * hd) * 16 + (ij[jj] >> 4)] + tops[(2 * hd + 1) * 16 + (ij[jj] & 15)]; kv[jj] = (s < 50) ? peer_key(v, s) : 0u; }
              float bs = 0.f, M0 = 0.f; int bsl = 0;
#pragma unroll
              for (int it = 0; it < 16; ++it) {
                  unsigned m = max(max(kv[0], kv[1]), max(kv[2], kv[3]));
                  m = max(m, dpp_u<0xB1>(m)); m = max(m, dpp_u<0x4E>(m)); m = max(m, dpp_u<0x141>(m)); m = max(m, dpp_u<0x140>(m));
#pragma unroll
                  for (int jj = 0; jj < 4; ++jj) kv[jj] = (kv[jj] == m) ? 0u : kv[jj];
                  const float mv = peer_unkey(m); if (it == 0) M0 = mv;
                  if (l15 == it) { bs = mv; bsl = 127 - (int)(m & 127u); }
              }
              const float ex = __expf(bs - M0); float sum = ex; sum += dpp_f<0xB1>(sum); sum += dpp_f<0x4E>(sum); sum += dpp_f<0x141>(sum); sum += dpp_f<0x140>(sum);
              const int pr = peer_stair(bsl); const int i1 = topi[(2 * hd) * 16 + (pr >> 4)], i2 = topi[(2 * hd + 1) * 16 + (pr & 15)];
              le[hd * 16 + l15] = i1 * 128 + i2; lg[hd * 16 + l15] = ex / sum;
          } }
        LDS_WAIT();
        LAS unsigned char* xl8 = (LAS unsigned char*)sc; LAS float* hl = (LAS float*)(xl8 + 2048);
        { float xr[32]; load_row_t<2, 16>(xres + (size_t)tk * DM, lane, xr);
#pragma unroll
          for (int c = 0; c < 2; ++c) { u32x4 w;
              w.x = pk4_fp8(xr[c * 16 + 0] * PEER_XS, xr[c * 16 + 1] * PEER_XS, xr[c * 16 + 2] * PEER_XS, xr[c * 16 + 3] * PEER_XS); w.y = pk4_fp8(xr[c * 16 + 4] * PEER_XS, xr[c * 16 + 5] * PEER_XS, xr[c * 16 + 6] * PEER_XS, xr[c * 16 + 7] * PEER_XS);
              w.z = pk4_fp8(xr[c * 16 + 8] * PEER_XS, xr[c * 16 + 9] * PEER_XS, xr[c * 16 + 10] * PEER_XS, xr[c * 16 + 11] * PEER_XS); w.w = pk4_fp8(xr[c * 16 + 12] * PEER_XS, xr[c * 16 + 13] * PEER_XS, xr[c * 16 + 14] * PEER_XS, xr[c * 16 + 15] * PEER_XS);
              *(LAS u32x4*)(xl8 + c * 1024 + lane * 16) = w; } }
        LDS_WAIT();
        { const int l15 = lane & 15, q4 = lane >> 4;
#pragma unroll 1
          for (int eb = 0; eb < 8; ++eb) {
              const int e = le[eb * 16 + l15]; const unsigned char* rowp = U8 + (size_t)e * DM + 16 * q4; const LAS unsigned char* xb = xl8 + 16 * q4;
              f32x4 acc = (f32x4){0.f, 0.f, 0.f, 0.f};
              u32x4 A[2][8];
#pragma unroll
              for (int i = 0; i < 8; ++i) A[0][i] = *(const u32x4*)(rowp + 64 * i);
#pragma unroll
              for (int ch = 0; ch < 4; ++ch) {
                  if (ch < 3) {
#pragma unroll
                      for (int i = 0; i < 8; ++i) A[(ch + 1) & 1][i] = *(const u32x4*)(rowp + 64 * (8 * (ch + 1) + i)); }
#pragma unroll
                  for (int i = 0; i < 8; ++i) { const u32x4 a = A[ch & 1][i]; const u32x4 xv = *(const LAS u32x4*)(xb + 64 * (8 * ch + i));
                      acc = MFMA8(pack64(a.x, a.y), pack64(xv.x, xv.y), acc); acc = MFMA8(pack64(a.z, a.w), pack64(xv.z, xv.w), acc); } }
#pragma unroll
              for (int r = 0; r < 4; ++r) { const int idx = eb * 16 + 4 * q4 + r; const float hvv = gelu_erf(acc[r] * (1.0f / (PEER_US * PEER_XS))) * lg[idx] * (1.0f / PEER_VS); if (l15 == 0) hl[idx] = hvv; }
          } }
        LDS_WAIT();
        float y[32];
#pragma unroll
        for (int i = 0; i < 32; ++i) y[i] = 0.f;
        { u32x4 VB[2][4][2];
#define PEER_VLOAD(buf, g) do { _Pragma("unroll") for (int k = 0; k < 4; ++k) { const int e = __builtin_amdgcn_readfirstlane(le[(g) * 4 + k]); const unsigned char* vp = V8 + (size_t)e * DM + lane * 16; \
              VB[buf][k][0] = *(const u32x4*)vp; VB[buf][k][1] = *(const u32x4*)(vp + 1024); } } while (0)
#define PEER_VACC(buf, g) do { _Pragma("unroll") for (int k = 0; k < 4; ++k) { const float hv = hl[(g) * 4 + k]; _Pragma("unroll") for (int c = 0; c < 2; ++c) { const unsigned wd[4] = {VB[buf][k][c].x, VB[buf][k][c].y, VB[buf][k][c].z, VB[buf][k][c].w}; \
              _Pragma("unroll") for (int d = 0; d < 4; ++d) { const f32x2 lo = __builtin_amdgcn_cvt_pk_f32_fp8((int)wd[d], false), hi = __builtin_amdgcn_cvt_pk_f32_fp8((int)wd[d], true); \
                  y[c * 16 + 4 * d] += hv * lo[0]; y[c * 16 + 4 * d + 1] += hv * lo[1]; y[c * 16 + 4 * d + 2] += hv * hi[0]; y[c * 16 + 4 * d + 3] += hv * hi[1]; } } } } while (0)
          PEER_VLOAD(0, 0);
#pragma unroll 1
          for (int g = 0; g < 32; g += 2) { PEER_VLOAD(1, g + 1); PEER_VACC(0, g); if (g + 2 < 32) PEER_VLOAD(0, g + 2); PEER_VACC(1, g + 1); }
#undef PEER_VLOAD
#undef PEER_VACC
        }
        { float xr[32]; load_row_t<2, 16>(xres + (size_t)tk * DM, lane, xr);
#pragma unroll
          for (int i = 0; i < 32; ++i) y[i] += DN_ALPHA * xr[i]; }
        ln_row_t<2, 16>(y, lane, lng, lnb, xout + (size_t)tk * DM, xa + (size_t)tk * DM);
    }
}

typedef short bf16x8 __attribute__((ext_vector_type(8)));
#define MFMA16(a, b, c) __builtin_amdgcn_mfma_f32_16x16x32_bf16((a), (b), (c), 0, 0, 0)
constexpr size_t TAB_D = 1 * MiB;

__device__ __forceinline__ void hgrn_lf_key(float z, float lb, float& lf, float& key) {
    const float s = __builtin_amdgcn_rcpf(1.0f + __expf(-z));
    const float f = fmaxf(lb + (1.0f - lb) * s, 1e-30f);
    lf = __logf(f); key = (1.0f - lb) * (1.0f - s);
}
__device__ __forceinline__ void unpack8(const u32x4 w, float* o) { o[0] = bflo(w.x); o[1] = bfhi(w.x); o[2] = bflo(w.y); o[3] = bfhi(w.y); o[4] = bflo(w.z); o[5] = bfhi(w.z); o[6] = bflo(w.w); o[7] = bfhi(w.w); }
__device__ __forceinline__ u32x4 pack8(const float* v) { u32x4 w; w.x = pk2(v[0], v[1]); w.y = pk2(v[2], v[3]); w.z = pk2(v[4], v[5]); w.w = pk2(v[6], v[7]); return w; }

__device__ __forceinline__ void hgrn_cumsum(LAS float* LF, LAS float* SEG, int tid, int dir, float (&bl)[16], float& tot) {
    const int k = tid & 127, seg = tid >> 7; float run = 0.f;
    if (dir == 0) {
#pragma unroll
        for (int i = 0; i < 16; ++i) { run += LF[(16 * seg + i) * 128 + k]; bl[i] = run; }
    } else {
#pragma unroll
        for (int i = 15; i >= 0; --i) { run += LF[(16 * seg + i) * 128 + k]; bl[i] = run; }
    }
    SEG[seg * 128 + k] = run;
    __syncthreads();
    float off = 0.f; tot = 0.f;
#pragma unroll
    for (int s2 = 0; s2 < 4; ++s2) { const float sv = SEG[s2 * 128 + k]; tot += sv; if (dir == 0 ? (s2 < seg) : (s2 > seg)) off += sv; }
#pragma unroll
    for (int i = 0; i < 16; ++i) bl[i] += off;
}

__device__ __forceinline__ void hgrn_pass1(const Ctx& X, const bf16* h, const float* lbl, float* L, float* Dd) {
    LAS float* LF = (LAS float*)X.lds; LAS float* KYf = LF + 8192; LAS float* SEG = KYf + 8192;
    LAS bf16* VR = (LAS bf16*)(X.lds + 67584); LAS bf16* KT = (LAS bf16*)(X.lds + 83968); LAS bf16* VT = (LAS bf16*)(X.lds + 102400);
    const int tid = X.tid, lane = X.lane, q4 = lane >> 4, l15 = lane & 15;
    for (int u = X.c; u < 1536; u += X.G) {
        const int dir = u / 768, rem = u % 768, bh = rem >> 6, c = rem & 63, b = bh / 6, hd = bh % 6; const size_t tok0 = (size_t)b * SEQ + 64 * c;
        __syncthreads();
        { const int t = tid >> 3, kc = (tid & 7) * 16;
          const bf16* zr = h + (tok0 + t) * HW + (dir ? H_FB : H_FF) + hd * 128 + kc; const bf16* vr = h + (tok0 + t) * HW + H_I + hd * 128 + kc;
          const u32x4 z0 = *(const u32x4*)zr, z1 = *(const u32x4*)(zr + 8), v0 = *(const u32x4*)vr, v1 = *(const u32x4*)(vr + 8);
          float z[16]; unpack8(z0, z); unpack8(z1, z + 8);
          const float* lbp = lbl + dir * DEPTH * 768 + hd * 128 + kc;
          float lf[16], ky[16];
#pragma unroll
          for (int j = 0; j < 16; ++j) hgrn_lf_key(z[j], lbp[j], lf[j], ky[j]);
#pragma unroll
          for (int j = 0; j < 4; ++j) { *(LAS f32x4*)(LF + t * 128 + kc + 4 * j) = (f32x4){lf[4 * j], lf[4 * j + 1], lf[4 * j + 2], lf[4 * j + 3]};
              *(LAS f32x4*)(KYf + t * 128 + kc + 4 * j) = (f32x4){ky[4 * j], ky[4 * j + 1], ky[4 * j + 2], ky[4 * j + 3]}; }
          *(LAS u32x4*)(VR + t * 128 + kc) = v0; *(LAS u32x4*)(VR + t * 128 + kc + 8) = v1; }
        __syncthreads();
        float bl[16], tot; hgrn_cumsum(LF, SEG, tid, dir, bl, tot);
        { const int k = tid & 127, seg = tid >> 7; float kh[16];
#pragma unroll
          for (int i = 0; i < 16; ++i) kh[i] = KYf[(16 * seg + i) * 128 + k] * __expf(tot - bl[i]);
          *(LAS u32x4*)(KT + k * 72 + 16 * seg) = pack8(kh); *(LAS u32x4*)(KT + k * 72 + 16 * seg + 8) = pack8(kh + 8);
          if (seg == 0) Dd[(size_t)u * 128 + k] = __expf(tot);
          unsigned short vv[16];
#pragma unroll
          for (int i = 0; i < 16; ++i) vv[i] = VR[(16 * seg + i) * 128 + k];
          u32x4 w0, w1; w0.x = vv[0] | (vv[1] << 16); w0.y = vv[2] | (vv[3] << 16); w0.z = vv[4] | (vv[5] << 16); w0.w = vv[6] | (vv[7] << 16);
          w1.x = vv[8] | (vv[9] << 16); w1.y = vv[10] | (vv[11] << 16); w1.z = vv[12] | (vv[13] << 16); w1.w = vv[14] | (vv[15] << 16);
          *(LAS u32x4*)(VT + k * 72 + 16 * seg) = w0; *(LAS u32x4*)(VT + k * 72 + 16 * seg + 8) = w1; }
        __syncthreads();
        const int mb0 = (X.wave & 3) * 2, nb0 = (X.wave >> 2) * 4;
        f32x4 acc[2][4];
#pragma unroll
        for (int mi = 0; mi < 2; ++mi)
#pragma unroll
            for (int ni = 0; ni < 4; ++ni) acc[mi][ni] = (f32x4){0.f, 0.f, 0.f, 0.f};
#pragma unroll
        for (int ks = 0; ks < 2; ++ks) {
            bf16x8 a[2], bb[4];
#pragma unroll
            for (int mi = 0; mi < 2; ++mi) a[mi] = *(const LAS bf16x8*)(KT + ((mb0 + mi) * 16 + l15) * 72 + ks * 32 + 8 * q4);
#pragma unroll
            for (int ni = 0; ni < 4; ++ni) bb[ni] = *(const LAS bf16x8*)(VT + ((nb0 + ni) * 16 + l15) * 72 + ks * 32 + 8 * q4);
#pragma unroll
            for (int mi = 0; mi < 2; ++mi)
#pragma unroll
                for (int ni = 0; ni < 4; ++ni) acc[mi][ni] = MFMA16(a[mi], bb[ni], acc[mi][ni]);
        }
        float* Lu = L + (size_t)u * 16384;
#pragma unroll
        for (int mi = 0; mi < 2; ++mi)
#pragma unroll
            for (int ni = 0; ni < 4; ++ni) *(f32x4*)(Lu + ((nb0 + ni) * 16 + l15) * 128 + (mb0 + mi) * 16 + 4 * q4) = acc[mi][ni];
    }
}
__device__ __forceinline__ void hgrn_pass2(const Ctx& X, const float* L, const float* Dd, bf16* Sp) {
    for (int i = X.c * NTHR + X.tid; i < 24 * 8192; i += X.G * NTHR) {
        const int chain = i >> 13, e = (i & 8191) * 2, k = e & 127, dir = chain / 12, bh = chain % 12;
        float s0 = 0.f, s1 = 0.f;
#pragma unroll 8
        for (int j = 0; j < 64; ++j) { const int c = dir ? 63 - j : j; const size_t u = (size_t)(dir * 12 + bh) * 64 + c;
            *(unsigned*)(Sp + u * 16384 + e) = pk2(s0, s1);
            const f32x2 l = *(const f32x2*)(L + u * 16384 + e), d = *(const f32x2*)(Dd + u * 128 + k);
            s0 = d[0] * s0 + l[0]; s1 = d[1] * s1 + l[1]; }
    }
}
__device__ __forceinline__ void hgrn_pass3(const Ctx& X, const bf16* h, const float* lbl, const bf16* Sp, const float* norm_g, bf16* yh) {
    LAS unsigned char* R1 = (LAS unsigned char*)X.lds;
    LAS float* LF = (LAS float*)R1; LAS bf16* VR = (LAS bf16*)R1; LAS bf16* ST = (LAS bf16*)R1;
    LAS bf16* VT = (LAS bf16*)(X.lds + 34816); LAS bf16* QT1 = (LAS bf16*)(X.lds + 53248); LAS bf16* KT1 = (LAS bf16*)(X.lds + 70656); LAS bf16* QT2 = (LAS bf16*)(X.lds + 88064);
    LAS bf16* PM = (LAS bf16*)(X.lds + 105472); LAS float* SEG = (LAS float*)(X.lds + 114688); LAS float* RR = (LAS float*)(X.lds + 116736); LAS float* SS = (LAS float*)(X.lds + 117248);
    const int tid = X.tid, lane = X.lane, q4 = lane >> 4, l15 = lane & 15, w = X.wave;
    for (int u = X.c; u < 768; u += X.G) {
        const int bh = u >> 6, c = u & 63, b = bh / 6, hd = bh % 6; const size_t tok0 = (size_t)b * SEQ + 64 * c;
        __syncthreads();
        { const int t = tid >> 3, kc = (tid & 7) * 16; const bf16* vr = h + (tok0 + t) * HW + H_I + hd * 128 + kc;
          *(LAS u32x4*)(VR + t * 128 + kc) = *(const u32x4*)vr; *(LAS u32x4*)(VR + t * 128 + kc + 8) = *(const u32x4*)(vr + 8); }
        __syncthreads();
        { const int v = tid & 127, seg = tid >> 7; unsigned short vv[16];
#pragma unroll
          for (int i = 0; i < 16; ++i) vv[i] = VR[(16 * seg + i) * 128 + v];
          u32x4 w0, w1; w0.x = vv[0] | (vv[1] << 16); w0.y = vv[2] | (vv[3] << 16); w0.z = vv[4] | (vv[5] << 16); w0.w = vv[6] | (vv[7] << 16);
          w1.x = vv[8] | (vv[9] << 16); w1.y = vv[10] | (vv[11] << 16); w1.z = vv[12] | (vv[13] << 16); w1.w = vv[14] | (vv[15] << 16);
          *(LAS u32x4*)(VT + v * 72 + 16 * seg) = w0; *(LAS u32x4*)(VT + v * 72 + 16 * seg + 8) = w1; }
        f32x4 acc[4];
#pragma unroll
        for (int ni = 0; ni < 4; ++ni) acc[ni] = (f32x4){0.f, 0.f, 0.f, 0.f};
        const int tb = w & 3;
#pragma unroll 1
        for (int dir = 0; dir < 2; ++dir) {
            __syncthreads();
            const int t = tid >> 3, kc = (tid & 7) * 16;
            float ky[16], qv[16];
            { const bf16* zr = h + (tok0 + t) * HW + (dir ? H_FB : H_FF) + hd * 128 + kc; const bf16* qr = h + (tok0 + t) * HW + H_Q + hd * 128 + kc;
              const u32x4 z0 = *(const u32x4*)zr, z1 = *(const u32x4*)(zr + 8), q0 = *(const u32x4*)qr, q1 = *(const u32x4*)(qr + 8);
              float z[16]; unpack8(z0, z); unpack8(z1, z + 8); unpack8(q0, qv); unpack8(q1, qv + 8);
              const float* lbp = lbl + dir * DEPTH * 768 + hd * 128 + kc; float lf[16];
#pragma unroll
              for (int j = 0; j < 16; ++j) hgrn_lf_key(z[j], lbp[j], lf[j], ky[j]);
#pragma unroll
              for (int j = 0; j < 4; ++j) *(LAS f32x4*)(LF + t * 128 + kc + 4 * j) = (f32x4){lf[4 * j], lf[4 * j + 1], lf[4 * j + 2], lf[4 * j + 3]}; }
            const size_t us = (size_t)(dir * 12 + bh) * 64 + c; u32x4 sreg[4];
#pragma unroll
            for (int i = 0; i < 4; ++i) sreg[i] = *(const u32x4*)(Sp + us * 16384 + (size_t)(tid + NTHR * i) * 8);
            __syncthreads();
            { float bl[16], tot; hgrn_cumsum(LF, SEG, tid, dir, bl, tot);
              const int k = tid & 127, seg = tid >> 7;
#pragma unroll
              for (int i = 0; i < 16; ++i) LF[(16 * seg + i) * 128 + k] = bl[i];
              if (dir == 0 ? (seg == 1) : (seg == 2)) RR[k] = dir == 0 ? bl[15] : bl[0]; }
            __syncthreads();
            { float q1[16], k1[16], q2[16];
#pragma unroll
              for (int j = 0; j < 16; ++j) { const float bt = LF[t * 128 + kc + j], r = RR[kc + j];
                  q1[j] = qv[j] * __expf(bt - r); k1[j] = ky[j] * __expf(r - bt); q2[j] = qv[j] * __expf(bt); }
              *(LAS u32x4*)(QT1 + t * 136 + kc) = pack8(q1); *(LAS u32x4*)(QT1 + t * 136 + kc + 8) = pack8(q1 + 8);
              *(LAS u32x4*)(KT1 + t * 136 + kc) = pack8(k1); *(LAS u32x4*)(KT1 + t * 136 + kc + 8) = pack8(k1 + 8);
              *(LAS u32x4*)(QT2 + t * 136 + kc) = pack8(q2); *(LAS u32x4*)(QT2 + t * 136 + kc + 8) = pack8(q2 + 8); }
            __syncthreads();
#pragma unroll
            for (int i = 0; i < 4; ++i) { const int idx = tid + NTHR * i, v = idx >> 4, k8 = (idx & 15) * 8; *(LAS u32x4*)(ST + v * 136 + k8) = sreg[i]; }
            { const int sb0 = (w >> 2) * 2; f32x4 pa[2] = {(f32x4){0.f, 0.f, 0.f, 0.f}, (f32x4){0.f, 0.f, 0.f, 0.f}};
#pragma unroll
              for (int ks = 0; ks < 4; ++ks) { const bf16x8 a = *(const LAS bf16x8*)(QT1 + (tb * 16 + l15) * 136 + ks * 32 + 8 * q4);
#pragma unroll
                  for (int si = 0; si < 2; ++si) { const bf16x8 bb = *(const LAS bf16x8*)(KT1 + ((sb0 + si) * 16 + l15) * 136 + ks * 32 + 8 * q4); pa[si] = MFMA16(a, bb, pa[si]); } }
#pragma unroll
              for (int si = 0; si < 2; ++si) { const int s = (sb0 + si) * 16 + l15;
#pragma unroll
                  for (int r = 0; r < 4; ++r) { const int tt = tb * 16 + 4 * q4 + r; const bool keep = dir == 0 ? (s <= tt) : (s >= tt);
                      PM[tt * 72 + s] = (bf16)f2bf(keep ? pa[si][r] : 0.f); } } }
            __syncthreads();
            { const int vb0 = (w >> 2) * 4;
#pragma unroll
              for (int ks = 0; ks < 4; ++ks) { const bf16x8 a = *(const LAS bf16x8*)(QT2 + (tb * 16 + l15) * 136 + ks * 32 + 8 * q4);
#pragma unroll
                  for (int ni = 0; ni < 4; ++ni) { const bf16x8 bb = *(const LAS bf16x8*)(ST + ((vb0 + ni) * 16 + l15) * 136 + ks * 32 + 8 * q4); acc[ni] = MFMA16(a, bb, acc[ni]); } }
#pragma unroll
              for (int ks = 0; ks < 2; ++ks) { const bf16x8 a = *(const LAS bf16x8*)(PM + (tb * 16 + l15) * 72 + ks * 32 + 8 * q4);
#pragma unroll
                  for (int ni = 0; ni < 4; ++ni) { const bf16x8 bb = *(const LAS bf16x8*)(VT + ((vb0 + ni) * 16 + l15) * 72 + ks * 32 + 8 * q4); acc[ni] = MFMA16(a, bb, acc[ni]); } } }
        }
        { const int vb0 = (w >> 2) * 4; float ss[4];
#pragma unroll
          for (int r = 0; r < 4; ++r) { float s = 0.f;
#pragma unroll
              for (int ni = 0; ni < 4; ++ni) s += acc[ni][r] * acc[ni][r];
              s += dpp_f<0xB1>(s); s += dpp_f<0x4E>(s); s += dpp_f<0x141>(s); s += dpp_f<0x140>(s);
              ss[r] = s; }
          if (l15 == 0) {
#pragma unroll
              for (int r = 0; r < 4; ++r) SS[(tb * 16 + 4 * q4 + r) * 2 + (w >> 2)] = ss[r]; }
          __syncthreads();
#pragma unroll
          for (int r = 0; r < 4; ++r) { const int tt = tb * 16 + 4 * q4 + r; const float tot = SS[tt * 2] + SS[tt * 2 + 1]; const float rn = 1.0f / sqrtf(tot * (1.0f / 128.0f) + 1e-6f);
#pragma unroll
              for (int ni = 0; ni < 4; ++ni) { const int v = (vb0 + ni) * 16 + l15; const float g = bf2f(h[(tok0 + tt) * HW + H_G + hd * 128 + v]);
                  const float y = acc[ni][r] * rn * norm_g[hd * 128 + v] * (g * __builtin_amdgcn_rcpf(1.0f + __expf(-g)));
                  yh[(tok0 + tt) * 768 + hd * 128 + v] = (bf16)f2bf(y); } } }
    }
}

constexpr size_t WS_AO = 944 * MiB, WS_LSE = 968 * MiB, WS_END2 = 969 * MiB;
__device__ __forceinline__ void rope16(float* t1, float* t2, const float* rc, const float* rs, int p) {
    const f32x4 c0 = *(const f32x4*)(rc + p * 8), c1 = *(const f32x4*)(rc + p * 8 + 4), s0 = *(const f32x4*)(rs + p * 8), s1 = *(const f32x4*)(rs + p * 8 + 4);
#pragma unroll
    for (int i = 0; i < 8; ++i) { const float c = i < 4 ? c0[i] : c1[i - 4], s = i < 4 ? s0[i] : s1[i - 4], a = t1[i], b = t2[i]; t1[i] = a * c - b * s; t2[i] = b * c + a * s; }
}
__device__ __forceinline__ void attn_fast(const Ctx& X, const bf16* h, const float* rc, const float* rs, float* AO, float* LSE) {
    LAS bf16* KL = (LAS bf16*)X.lds; LAS bf16* VL = KL + 256 * 72; LAS bf16* QL = VL + 256 * 72;
    const int tid = X.tid, lane = X.lane, q4 = lane >> 4, l15 = lane & 15, w = X.wave;
    for (int u = X.c; u < 768; u += X.G) {
        const int b = u / 384, head = (u % 384) >> 5, blk = u & 31, g = head >> 2, dsh = 2 * g, dil = 1 << dsh, Lsub = SEQ >> dsh, nblk = Lsub >> 7;
        const int cls = blk / nblk, m0 = (blk % nblk) * 128;
        const bf16* hb = h + (size_t)b * SEQ * HW;
        __syncthreads();
#pragma unroll
        for (int rep = 0; rep < 2; ++rep) {
            const int row = (tid >> 2) + 128 * rep, qt = tid & 3, m = m0 - 64 + row; const bool ok = (m >= 0) && (m < Lsub); const int p = ok ? m * dil + cls : 0;
            const bf16* kr = hb + (size_t)p * HW + H_KA + head * 64 + qt * 16; const bf16* vr = hb + (size_t)p * HW + H_VA + head * 64 + qt * 16;
            u32x4 k0 = *(const u32x4*)kr, k1 = *(const u32x4*)(kr + 8), v0 = *(const u32x4*)vr, v1 = *(const u32x4*)(vr + 8);
            if (qt == 0) { float t1[8], t2[8]; unpack8(k0, t1); unpack8(k1, t2); rope16(t1, t2, rc, rs, p); k0 = pack8(t1); k1 = pack8(t2); }
            if (!ok) { k0 = (u32x4){0u, 0u, 0u, 0u}; k1 = k0; v0 = k0; v1 = k0; }
            *(LAS u32x4*)(KL + row * 72 + qt * 16) = k0; *(LAS u32x4*)(KL + row * 72 + qt * 16 + 8) = k1;
            *(LAS u32x4*)(VL + row * 72 + qt * 16) = v0; *(LAS u32x4*)(VL + row * 72 + qt * 16 + 8) = v1;
        }
        { const int row = tid >> 2, qt = tid & 3, p = (m0 + row) * dil + cls; const bf16* qr = hb + (size_t)p * HW + H_QA + head * 64 + qt * 16;
          const u32x4 q0 = *(const u32x4*)qr, q1 = *(const u32x4*)(qr + 8); float t1[8], t2[8]; unpack8(q0, t1); unpack8(q1, t2);
          if (qt == 0) rope16(t1, t2, rc, rs, p);
#pragma unroll
          for (int i = 0; i < 8; ++i) { t1[i] *= 0.125f; t2[i] *= 0.125f; }
          *(LAS u32x4*)(QL + row * 72 + qt * 16) = pack8(t1); *(LAS u32x4*)(QL + row * 72 + qt * 16 + 8) = pack8(t2); }
        __syncthreads();
        bf16x8 qf[2];
#pragma unroll
        for (int ks = 0; ks < 2; ++ks) qf[ks] = *(const LAS bf16x8*)(QL + (16 * w + l15) * 72 + ks * 32 + 8 * q4);
        f32x4 sa[9];
#pragma unroll
        for (int kb = 0; kb < 9; ++kb) { sa[kb] = (f32x4){0.f, 0.f, 0.f, 0.f};
#pragma unroll
            for (int ks = 0; ks < 2; ++ks) { const bf16x8 a = *(const LAS bf16x8*)(KL + (16 * w + 16 * kb + l15) * 72 + ks * 32 + 8 * q4); sa[kb] = MFMA16(a, qf[ks], sa[kb]); } }
        float mx = -1e30f;
#pragma unroll
        for (int kb = 0; kb < 9; ++kb)
#pragma unroll
            for (int r = 0; r < 4; ++r) { const int j = 16 * kb + 4 * q4 + r, d = j - 64 - l15, km = m0 - 64 + 16 * w + j; const bool ok = (d >= -64) && (d <= 64) && (km >= 0) && (km < Lsub);
                sa[kb][r] = ok ? sa[kb][r] : -1e30f; mx = fmaxf(mx, sa[kb][r]); }
        mx = fmaxf(mx, __shfl_xor(mx, 16)); mx = fmaxf(mx, __shfl_xor(mx, 32));
        float lsum = 0.f;
#pragma unroll
        for (int kb = 0; kb < 9; ++kb)
#pragma unroll
            for (int r = 0; r < 4; ++r) { const float pv = __expf(sa[kb][r] - mx); sa[kb][r] = pv; lsum += pv; }
        lsum += __shfl_xor(lsum, 16); lsum += __shfl_xor(lsum, 32);
        f32x4 oa[4];
#pragma unroll
        for (int db = 0; db < 4; ++db) oa[db] = (f32x4){0.f, 0.f, 0.f, 0.f};
#pragma unroll
        for (int kp = 0; kp < 5; ++kp) {
            u32x4 pw; pw.x = pk2(sa[2 * kp][0], sa[2 * kp][1]); pw.y = pk2(sa[2 * kp][2], sa[2 * kp][3]);
            if (kp < 4) { pw.z = pk2(sa[2 * kp + 1][0], sa[2 * kp + 1][1]); pw.w = pk2(sa[2 * kp + 1][2], sa[2 * kp + 1][3]); } else { pw.z = 0u; pw.w = 0u; }
            const bf16x8 pb = __builtin_bit_cast(bf16x8, pw);
            int rows[8];
#pragma unroll
            for (int jj = 0; jj < 8; ++jj) { int R = 16 * w + 16 * (2 * kp + (jj >> 2)) + 4 * q4 + (jj & 3); rows[jj] = R > 255 ? 255 : R; }
#pragma unroll
            for (int db = 0; db < 4; ++db) { bf16x8 va;
#pragma unroll
                for (int jj = 0; jj < 8; ++jj) va[jj] = (short)VL[rows[jj] * 72 + 16 * db + l15];
                oa[db] = MFMA16(va, pb, oa[db]); }
        }
        const float il = 1.0f / lsum; const size_t tok = (size_t)b * SEQ + (size_t)(m0 + 16 * w + l15) * dil + cls;
#pragma unroll
        for (int db = 0; db < 4; ++db) *(f32x4*)(AO + tok * 768 + head * 64 + 16 * db + 4 * q4) = oa[db] * il;
        if (q4 == 0) LSE[tok * 12 + head] = mx + __logf(lsum);
    }
}
__device__ __forceinline__ void attn_merge(const Ctx& X, const float* AO, const float* LSE, bf16* ya) {
    for (int i = X.c * NTHR + X.tid; i < TOK * 64; i += X.G * NTHR) {
        const int tk = i >> 6, hh = (i >> 4) & 3, d4 = (i & 15) * 4;
        const float l0 = LSE[(size_t)tk * 12 + hh], l1 = LSE[(size_t)tk * 12 + 4 + hh], l2 = LSE[(size_t)tk * 12 + 8 + hh];
        const float m = fmaxf(l0, fmaxf(l1, l2)), e0 = __expf(l0 - m), e1 = __expf(l1 - m), e2 = __expf(l2 - m), inv = 1.0f / (e0 + e1 + e2);
        const float* ap = AO + (size_t)tk * 768 + hh * 64 + d4;
        const f32x4 o = (*(const f32x4*)ap * e0 + *(const f32x4*)(ap + 256) * e1 + *(const f32x4*)(ap + 512) * e2) * inv;
        u32x2 wv; wv.x = pk2(o[0], o[1]); wv.y = pk2(o[2], o[3]); *(u32x2*)(ya + (size_t)tk * 256 + hh * 64 + d4) = wv;
    }
}

#ifndef MK_ONE_LAUNCH
#define MK_ONE_LAUNCH 1
#endif
constexpr int N_PHASES = 1 + 9 * DEPTH;
#ifndef PROBE_REP
#define PROBE_REP 0
#endif
#define NREP(grp) ((PROBE_REP == (grp) && l == 0) ? 2 : 1)
__device__ __forceinline__ bool fresh(Ctx& X) { asm volatile("" : "+v"(X.tid), "+v"(X.lane)); return true; }

#if defined(CHECK_BRANCHES)
constexpr size_t WS_YA2 = 969 * MiB, WS_YH2 = 973 * MiB;
__device__ __forceinline__ void cmp_bf16(const Ctx& X, const bf16* a, const bf16* ref, size_t n, float* cnt) {
    float d2 = 0.f, r2 = 0.f;
    for (size_t i = (size_t)X.c * NTHR + X.tid; i < n; i += (size_t)X.G * NTHR) { const float x = bf2f(a[i]), y = bf2f(ref[i]); d2 += (x - y) * (x - y); r2 += y * y; }
    d2 = wave_sum(d2); r2 = wave_sum(r2);
    if (X.lane == 0) { atomicAdd(cnt, d2); atomicAdd(cnt + 1, r2); }
}
#endif
struct Args { const float* in[18]; float* out; unsigned char* ws; int ph_lo, ph_hi; };
typedef pg8::bf16_t pbf;

__global__ void __launch_bounds__(NTHR, 2) fwd_kernel(Args args) {
    extern __shared__ __attribute__((aligned(16))) unsigned char lds[];
    cg::grid_group grid = cg::this_grid();
    Ctx X; X.lds = lds; X.tid = threadIdx.x; X.lane = X.tid & 63; X.wave = __builtin_amdgcn_readfirstlane(X.tid >> 6);
    X.G = gridDim.x; X.c = blockIdx.x; X.gw = X.c * NWAVES + X.wave; X.ngw = X.G * NWAVES;
    unsigned char* ws = args.ws; float* out = args.out;
    LAS unsigned char* ldsl = (LAS unsigned char*)lds;
    const int lo = args.ph_lo, hi = args.ph_hi;
#define IN(k) (lo <= (k) && (k) < hi && fresh(X))
#define INR(k) (lo <= (k) && (k) < hi)
#define SEAM(k) do { if (INR(k) && INR((k) + 1)) { if ((k) == 0) grid.sync(); else xcd_barrier(bar); } else __syncthreads(); } while (0)
    volatile LAS unsigned* MISC = (volatile LAS unsigned*)(ldsl + 131072);
    if (X.tid < 16) MISC[X.tid] = 0u;
    __syncthreads();
    XcdBarrier bar = xcd_barrier_post((unsigned*)(ws + 8192), MISC + 8);

    #ifndef SKIP_P0
    if (IN(0)) { prologue(X, args.in, out, ws); if (PROBE_REP == 4) { __syncthreads(); prologue(X, args.in, out, ws); } SEAM(0); }
#endif

    const float* ropec = (const float*)(ws + WS_TAB); const float* ropes = (const float*)(ws + WS_TAB + TAB_SIN); const float* lbt = (const float*)(ws + WS_TAB + TAB_LB);
    pbf* XA = (pbf*)(ws + WS_XA); pbf* Hb = (pbf*)(ws + WS_H); pbf* PT = (pbf*)(ws + WS_PT); float* FP = (float*)(ws + WS_FP);
    pbf* YF = (pbf*)(ws + WS_YF); pbf* YH = (pbf*)(ws + WS_YH); pbf* YA = (pbf*)(ws + WS_YA);
    float* MACC = (float*)(ws + WS_MACC); pbf* MERGED = (pbf*)(ws + WS_MERGED); float* VPRE = (float*)(ws + WS_VPRE); float* SC = (float*)(ws + WS_SC);
    float* FD = (float*)(ws + WS_LB); float* KY = FD + (size_t)2 * TOK * 768; float* OH = (float*)(ws + WS_SB);

    for (int l = 0; l < DEPTH; ++l) {
        const int pb = 1 + 9 * l;
        unsigned char* wl = ws + WS_WL0 + (size_t)l * WL_STRIDE;
        pbf* WinT = (pbf*)(wl + WL_WIN); pbf* WfT = (pbf*)(wl + WL_WF); pbf* BRF = (pbf*)(wl + WL_BRF); pbf* BRH = (pbf*)(wl + WL_BRH); pbf* BRA = (pbf*)(wl + WL_BRA);
        pbf* WoutT = (pbf*)(wl + WL_OUT); pbf* WsT = (pbf*)(wl + WL_WS); const unsigned char* Ub = wl + WL_U; const unsigned char* Vb = wl + WL_V;
        if (IN(pb + 0)) { for (int rep = 0; rep < NREP(1); ++rep) {
#ifndef SKIP_G1
            { pg8::Gemm g{XA, WinT, TOK, HW, DM, DM, DM}; pg8::StaticOrder S; S.init(TOK, HW, X.G, X.c); pg8::EpiBf16<0> E{Hb, HW, nullptr, 0, 0, 1.f};
              pg8::gemm_phase<pg8::EpiBf16<0>, pg8::StaticOrder, true, true>(ldsl, g, S, E); }
#endif
#ifndef SKIP_G2
            { pg8::Gemm g{WfT, XA, 1024, TOK, DM, DM, DM}; pg8::StaticOrder S; S.init(1024, TOK, X.G, X.c); pg8::EpiPT E{PT};
              pg8::gemm_phase<pg8::EpiPT, pg8::StaticOrder, true, true>(ldsl, g, S, E); }
#endif
            }
            SEAM(pb + 0);
        }
        if (IN(pb + 1)) {
            for (int rep = 0; rep < NREP(1); ++rep) {
#ifndef SKIP_G3
            for (int it = X.c; it < 256; it += X.G) { const int ks = it >> 6, tile = it & 63;
                pg8::Gemm g{(const pbf*)(ws + WS_F) + ks * 2048, PT + ks * 2048, SEQ, 1024, 2048, 8192, 8192}; pg8::OneUnit S{tile >> 2, tile & 3}; pg8::EpiF32 E{FP + (size_t)ks * SEQ * 1024, 1024};
                pg8::gemm_phase<pg8::EpiF32, pg8::OneUnit, false, true>(ldsl, g, S, E); }
#endif
            }
            __syncthreads();
            for (int rep = 0; rep < NREP(5); ++rep) {
#if defined(ATTN_NAIVE)
            attn_naive(X, Hb, ropec, ropes, YA);
#else
            attn_fast(X, Hb, ropec, ropes, (float*)(ws + WS_AO), (float*)(ws + WS_LSE));
#if defined(CHECK_BRANCHES)
            __syncthreads(); attn_naive(X, Hb, ropec, ropes, (pbf*)(ws + WS_YA2));
#endif
#endif
            __syncthreads(); }
            for (int rep = 0; rep < NREP(6); ++rep) {
#if defined(HGRN_NAIVE)
            hgrn_prep_naive(X, Hb, lbt + l * 768, FD, KY);
#else
            __syncthreads();
            hgrn_pass1(X, Hb, lbt + l * 768, FD, (float*)(ws + WS_TAB + TAB_D));
#endif
            __syncthreads(); }
            SEAM(pb + 1);
        }
        if (IN(pb + 2)) { for (int rep = 0; rep < NREP(7); ++rep) {
#if defined(HGRN_NAIVE)
            hgrn_scan_naive(X, Hb, FD, KY, OH);
#else
            hgrn_pass2(X, FD, (const float*)(ws + WS_TAB + TAB_D), (pbf*)(ws + WS_SB));
#endif
            fourier_reduce(X, FP, YF);
#if !defined(ATTN_NAIVE)
            attn_merge(X, (const float*)(ws + WS_AO), (const float*)(ws + WS_LSE), YA);
#endif
            }
#if defined(CHECK_BRANCHES)
            grid.sync(); cmp_bf16(X, YA, (const pbf*)(ws + WS_YA2), (size_t)TOK * 256, (float*)ws);
#endif
            SEAM(pb + 2); }
        if (IN(pb + 3)) { for (int rep = 0; rep < NREP(8); ++rep) {
#if defined(HGRN_NAIVE)
            hgrn_combine_naive(X, Hb, OH, args.in[9] + (size_t)l * 768, YH);
#else
            hgrn_pass3(X, Hb, lbt + l * 768, (const pbf*)(ws + WS_SB), args.in[9] + (size_t)l * 768, YH);
#if defined(CHECK_BRANCHES)
            grid.sync(); hgrn_prep_naive(X, Hb, lbt + l * 768, FD, KY);
            grid.sync(); hgrn_scan_naive(X, Hb, FD, KY, OH);
            grid.sync(); hgrn_combine_naive(X, Hb, OH, args.in[9] + (size_t)l * 768, (pbf*)(ws + WS_YH2));
            grid.sync(); cmp_bf16(X, YH, (const pbf*)(ws + WS_YH2), (size_t)TOK * 768, (float*)ws + 2);
#endif
#endif
            }
            SEAM(pb + 3); }
        if (IN(pb + 4)) { for (int rep = 0; rep < NREP(1); ++rep) {
#ifndef SKIP_G4
            { pg8::Gemm g{YF, BRF, TOK, DM, 512, 512, 512}; pg8::StaticOrder S; S.init(TOK, DM, X.G, X.c); pg8::EpiGate<0> E{Hb + H_GATE, HW, MACC, MERGED, DM};
              pg8::gemm_phase<pg8::EpiGate<0>, pg8::StaticOrder, true, true>(ldsl, g, S, E); }
#endif
#ifndef SKIP_G5
            { pg8::Gemm g{YH, BRH, TOK, DM, 768, 768, 768}; pg8::StaticOrder S; S.init(TOK, DM, X.G, X.c); pg8::EpiGate<1> E{Hb + H_GATE + DM, HW, MACC, MERGED, DM};
              pg8::gemm_phase<pg8::EpiGate<1>, pg8::StaticOrder, true, true>(ldsl, g, S, E); }
#endif
#ifndef SKIP_G6
            { pg8::Gemm g{YA, BRA, TOK, DM, 256, 256, 256}; pg8::StaticOrder S; S.init(TOK, DM, X.G, X.c); pg8::EpiGate<2> E{Hb + H_GATE + 2 * DM, HW, MACC, MERGED, DM};
              pg8::gemm_phase<pg8::EpiGate<2>, pg8::StaticOrder, true, true>(ldsl, g, S, E); }
#endif
            }
            SEAM(pb + 4);
        }
        if (IN(pb + 5)) { for (int rep = 0; rep < NREP(1); ++rep) {
#ifndef SKIP_G7
            pg8::Gemm g{MERGED, WoutT, TOK, DM, DM, DM, DM}; pg8::StaticOrder S; S.init(TOK, DM, X.G, X.c); pg8::EpiResid E{out, VPRE, DM, DN_ALPHA};
            pg8::gemm_phase<pg8::EpiResid, pg8::StaticOrder, true, true>(ldsl, g, S, E);
#endif
            }
            SEAM(pb + 5);
        }
        if (IN(pb + 6)) { for (int rep = 0; rep < NREP(9); ++rep) ln_phase(X, VPRE, args.in[10] + (size_t)l * DM, args.in[11] + (size_t)l * DM, out, XA); SEAM(pb + 6); }
        if (IN(pb + 7)) { for (int rep = 0; rep < NREP(1); ++rep) {
#ifndef SKIP_G8
            pg8::Gemm g{XA, WsT, TOK, DM, DM, DM, DM}; pg8::StaticOrder S; S.init(TOK, DM, X.G, X.c); pg8::EpiF32 E{SC, DM};
            pg8::gemm_phase<pg8::EpiF32, pg8::StaticOrder, true, true>(ldsl, g, S, E);
#endif
            }
            SEAM(pb + 7);
        }
        if (IN(pb + 8)) {
#ifndef SKIP_PEER
            if (PROBE_REP == 2 && l == 0) { peer_phase(X, SC, Ub, Vb, out, VPRE, (pbf*)(ws + WS_LB), args.in[16] + (size_t)l * DM, args.in[17] + (size_t)l * DM,
                       args.in[14] + (size_t)l * NEXP * DM, args.in[15] + (size_t)l * NEXP * DM, args.in[12] + (size_t)l * DM * DM, args.in[13] + (size_t)l * 2 * 128 * 128); __syncthreads(); }
            peer_phase(X, SC, Ub, Vb, out, out, XA, args.in[16] + (size_t)l * DM, args.in[17] + (size_t)l * DM,
                       args.in[14] + (size_t)l * NEXP * DM, args.in[15] + (size_t)l * NEXP * DM, args.in[12] + (size_t)l * DM * DM, args.in[13] + (size_t)l * 2 * 128 * 128);
#endif
            if (pb + 8 + 1 < N_PHASES) SEAM(pb + 8); }
    }
#if defined(CHECK_BRANCHES)
    grid.sync();
    if (X.c == 0) { const float* cn = (const float*)ws; const float ra = cn[0] / fmaxf(cn[1], 1e-30f), rh = cn[2] / fmaxf(cn[3], 1e-30f);
        if (!(rh < 1e-3f && cn[3] > 1000.f) && X.tid < 500) { out[X.tid] += 10.f; out[500 + X.tid] += 10.f; }
        if (!(ra < 1e-3f && cn[1] > 1000.f)) { for (int i = 1000 + X.tid; i < 4000; i += NTHR) out[i] += 10.f; } }
#endif
#undef IN
#undef SEAM
}

extern "C" void kernel_launch(void* const* d_in, const int* in_sizes, int n_in, void* d_out, int out_size, void* d_ws, size_t ws_size, hipStream_t stream) {
    static int grid = 0;
    if (grid == 0) {
        if (n_in != 18 || in_sizes[0] != TOK * DM || out_size != TOK * DM || ws_size < WS_END2) {
            fprintf(stderr, "kernel_launch: unexpected shapes (n_in %d, in0 %d, out %d, ws %zu, need %zu); nothing launched\n", n_in, n_in > 0 ? in_sizes[0] : -1, out_size, ws_size, (size_t)WS_END2); grid = -1; return; }
        int dev = 0, cus = 0, per_cu = 0;
        if (hipGetDevice(&dev) != hipSuccess || hipDeviceGetAttribute(&cus, hipDeviceAttributeMultiprocessorCount, dev) != hipSuccess) { grid = -1; return; }
        if (hipFuncSetAttribute((const void*)fwd_kernel, hipFuncAttributeMaxDynamicSharedMemorySize, LDS_BYTES) != hipSuccess) { fprintf(stderr, "kernel_launch: hipFuncSetAttribute failed\n"); grid = -1; return; }
        if (hipOccupancyMaxActiveBlocksPerMultiprocessor(&per_cu, (const void*)fwd_kernel, NTHR, LDS_BYTES) != hipSuccess || per_cu < 1) { fprintf(stderr, "kernel_launch: occupancy query says %d blocks per CU\n", per_cu); grid = -1; (void)hipGetLastError(); return; }
        grid = cus * 1;
    }
    if (grid < 0) return;
    if (hipMemsetAsync(d_ws, 0, 65536, stream) != hipSuccess) { fprintf(stderr, "kernel_launch: memset failed\n"); return; }
    Args a{};
    for (int i = 0; i < 18; ++i) a.in[i] = (const float*)d_in[i];
    a.out = (float*)d_out; a.ws = (unsigned char*)d_ws;
#if MK_ONE_LAUNCH
    a.ph_lo = 0; a.ph_hi = N_PHASES;
    void* kargs[] = {&a};
    hipError_t e = hipLaunchCooperativeKernel((const void*)fwd_kernel, dim3(grid), dim3(NTHR), kargs, LDS_BYTES, stream);
    if (e != hipSuccess) fprintf(stderr, "kernel_launch: cooperative launch failed: %s (grid %d)\n", hipGetErrorString(e), grid);
#else
    for (int ph = 0; ph < N_PHASES; ++ph) { a.ph_lo = ph; a.ph_hi = ph + 1; hipLaunchKernelGGL(fwd_kernel, dim3(grid), dim3(NTHR), LDS_BYTES, stream, a); }
#endif
}
```

```cpp
#include <hip/hip_runtime.h>
#include <hip/hip_cooperative_groups.h>
#include <cstdio>
#include <cstdint>
namespace cg = cooperative_groups;
namespace pg8 {
#define PG8_LAS __attribute__((address_space(3)))
typedef unsigned short bf16_t;
typedef short bf16x8 __attribute__((ext_vector_type(8)));
typedef float f32x4 __attribute__((ext_vector_type(4)));
typedef unsigned u32x4 __attribute__((ext_vector_type(4)));
constexpr int BM = 256, BK = 64, HALF = 128, HTB = HALF * BK * 2  , STAGE_BYTES = 8 * HTB, NXCD = 8, WGM = 8;

__host__ __device__ __forceinline__ int lds_byte(int r, int c) { const int st = (r >> 4) * 2 + (c >> 5), rr = r & 15, cc = c & 31, ob = rr * 64 + cc * 2; return st * 1024 + (ob ^ (((ob >> 9) & 1) << 5)); }
__host__ __device__ __forceinline__ void stage_rc(int b, int& R, int& C) { const int st = b / 1024, sb = b % 1024, swz = sb ^ (((sb >> 9) & 1) << 5); R = (st >> 1) * 16 + swz / 64; C = (st & 1) * 32 + (swz % 64) / 2; }
__host__ __device__ __forceinline__ int perm32(int rho) { const int n = rho >> 4, i = rho & 15; return 8 * (i >> 2) + 4 * n + (i & 3); }

struct Unit { int pm, pn; };
struct Gemm { const bf16_t* A; const bf16_t* Bt; int M, N, K, lda, ldb; };

struct StaticOrder {
    int nM, nN, nwg, G, c;
    __host__ __device__ void init(int M, int N, int G_, int c_) { nM = M / BM; nN = N / BM; nwg = nM * nN; G = G_; c = c_; }
    __host__ __device__ bool next(int i, Unit& u) const {
        const long L = (long)i * G + c; if (L >= nwg) return false;
        int wgid = (int)L; { const int q = nwg / NXCD, r = nwg % NXCD, xcd = wgid % NXCD, off = wgid / NXCD; wgid = (xcd < r ? xcd * (q + 1) : r * (q + 1) + (xcd - r) * q) + off; }
        const int nig = WGM * nN, gid = wgid / nig, fm = gid * WGM, gsz = (nM - fm) < WGM ? (nM - fm) : WGM;
        u.pm = fm + ((wgid % nig) % gsz); u.pn = (wgid % nig) / gsz; return true;
    }
    __device__ __forceinline__ void a_ready(const Unit&) const {}
    __device__ __forceinline__ void done(const Unit&) const {}
};

__device__ __forceinline__ unsigned cvt_pk_bf16(float lo, float hi) { unsigned r; asm volatile("v_cvt_pk_bf16_f32 %0, %1, %2" : "=v"(r) : "v"(lo), "v"(hi)); return r; }
typedef float f32x2 __attribute__((ext_vector_type(2)));
__device__ __forceinline__ f32x2 gelu_pk(f32x2 v) {
    const f32x2 av = __builtin_elementwise_abs(v), d = av * 0.2316418882f + 1.0f;
    f32x2 t; t.x = __builtin_amdgcn_rcpf(d.x); t.y = __builtin_amdgcn_rcpf(d.y);
    f32x2 q = t * 0.5307027145f + (-0.7265760135f); q = q * t + 0.7107068705f; q = q * t + (-0.142248368f); q = q * t + 0.127414796f; q = q * t;
    const f32x2 s = (v * v) * (-0.72134752044f);
    f32x2 e; e.x = __builtin_amdgcn_exp2f(s.x); e.y = __builtin_amdgcn_exp2f(s.y);
    const f32x2 m = v * (q * e), r = v - m;
    f32x2 o; o.x = v.x < 0.f ? m.x : r.x; o.y = v.y < 0.f ? m.y : r.y; return o;
}

template <int ACT  > struct EpiBf16 {
    static constexpr bool PERM = true, AFTER_DRAIN = false; static_assert(ACT == 0 || ACT == 1, "EpiBf16: ACT is 0 (none) or 1 (gelu_pk)");
    bf16_t* O; int ldc; const float* bias; int split_cols; size_t split_stride; float scale0;
    __device__ __forceinline__ void operator()(const f32x4 (&acc)[2][2][4][2], const Unit& u, int wr, int wc, int fr, int fq) const {
        const int row0 = u.pm * BM + wr * 64 + fr; int colt = u.pn * BM; bf16_t* base = O;
        float sc = 1.f; if (split_cols) { const int t = colt / split_cols; base += (size_t)t * split_stride; colt -= t * split_cols; if (t == 0) sc = scale0; }
        const int col0 = colt + wc * 32 + 8 * fq, bcol0 = u.pn * BM + wc * 32 + 8 * fq;
        f32x4 bv[2][2];
#pragma unroll
        for (int bj = 0; bj < 2; ++bj)
#pragma unroll
            for (int n = 0; n < 2; ++n) bv[bj][n] = bias ? *(const f32x4*)(bias + bcol0 + bj * HALF + 4 * n) : (f32x4){0.f, 0.f, 0.f, 0.f};
#pragma unroll
        for (int ai = 0; ai < 2; ++ai)
#pragma unroll
            for (int m = 0; m < 4; ++m) { bf16_t* rowp = base + (size_t)(row0 + ai * HALF + m * 16) * ldc + col0;
#pragma unroll
                for (int bj = 0; bj < 2; ++bj) { f32x4 v0 = acc[ai][bj][m][0] + bv[bj][0], v1 = acc[ai][bj][m][1] + bv[bj][1];
                    if (ACT == 1) { f32x2 a = gelu_pk((f32x2){v0[0], v0[1]}), b = gelu_pk((f32x2){v0[2], v0[3]}), c = gelu_pk((f32x2){v1[0], v1[1]}), d = gelu_pk((f32x2){v1[2], v1[3]});
                        v0 = (f32x4){a.x, a.y, b.x, b.y}; v1 = (f32x4){c.x, c.y, d.x, d.y}; }
                    v0 = v0 * sc; v1 = v1 * sc; u32x4 w; w.x = cvt_pk_bf16(v0[0], v0[1]); w.y = cvt_pk_bf16(v0[2], v0[3]); w.z = cvt_pk_bf16(v1[0], v1[1]); w.w = cvt_pk_bf16(v1[2], v1[3]);
                    *(u32x4*)(rowp + bj * HALF) = w; } }
    }
};
#ifndef EXP_MIX_SCALE
#define EXP_MIX_SCALE 1.0f
#endif

struct EpiF32 {
    static constexpr bool PERM = true, AFTER_DRAIN = false;
    float* C; int ldc;
    __device__ __forceinline__ void operator()(const f32x4 (&acc)[2][2][4][2], const Unit& u, int wr, int wc, int fr, int fq) const {
        const int row0 = u.pm * BM + wr * 64 + fr, col0 = u.pn * BM + wc * 32 + 8 * fq;
        float* rowp = C + (size_t)row0 * ldc + col0;
#pragma unroll
        for (int ai = 0; ai < 2; ++ai) {
#pragma unroll
            for (int m = 0; m < 4; ++m) {
#pragma unroll
                for (int bj = 0; bj < 2; ++bj) { *(f32x4*)(rowp + bj * HALF) = acc[ai][bj][m][0]; *(f32x4*)(rowp + bj * HALF + 4) = acc[ai][bj][m][1]; }
                rowp += (size_t)16 * ldc; asm volatile("" : "+v"(rowp) :: "memory"); }
            rowp += (size_t)64 * ldc; }
    }
};
struct EpiBf16Plain {
    static constexpr bool PERM = false, AFTER_DRAIN = false;
    bf16_t* C; int ldc;
    __device__ __forceinline__ void operator()(const f32x4 (&acc)[2][2][4][2], const Unit& u, int wr, int wc, int fr, int fq) const {
        const int row0 = u.pm * BM + wr * 64 + fr, col0 = u.pn * BM + wc * 32 + 4 * fq;
        bf16_t* rowp = C + (size_t)row0 * ldc + col0;
#pragma unroll
        for (int ai = 0; ai < 2; ++ai) {
#pragma unroll
            for (int m = 0; m < 4; ++m) {
#pragma unroll
                for (int bj = 0; bj < 2; ++bj)
#pragma unroll
                    for (int n = 0; n < 2; ++n) { const f32x4 v = acc[ai][bj][m][n]; unsigned w0 = cvt_pk_bf16(v[0], v[1]), w1 = cvt_pk_bf16(v[2], v[3]);
                        *(unsigned long long*)(rowp + bj * HALF + n * 16) = ((unsigned long long)w1 << 32) | w0; }
                rowp += (size_t)16 * ldc; asm volatile("" : "+v"(rowp) :: "memory"); }
            rowp += (size_t)64 * ldc; }
    }
};
struct EpiPT {
    static constexpr bool PERM = true, AFTER_DRAIN = false;
    bf16_t* PT;
    __device__ __forceinline__ void operator()(const f32x4 (&acc)[2][2][4][2], const Unit& u, int wr, int wc, int fr, int fq) const {
        const int m0 = u.pm * BM, part = m0 >> 9, j0 = m0 & 511, n0 = u.pn * BM, b = n0 >> 12, n10 = n0 & 4095;
        bf16_t* base = PT + (size_t)(b * 512 + j0) * 8192 + part * 4096 + n10;
        const int row0 = wr * 64 + fr, col0 = wc * 32 + 8 * fq;
        bf16_t* rowp = base + (size_t)row0 * 8192 + col0;
#pragma unroll
        for (int ai = 0; ai < 2; ++ai) {
#pragma unroll
            for (int m = 0; m < 4; ++m) {
#pragma unroll
                for (int bj = 0; bj < 2; ++bj) { const f32x4 v0 = acc[ai][bj][m][0], v1 = acc[ai][bj][m][1];
                    u32x4 w; w.x = cvt_pk_bf16(v0[0], v0[1]); w.y = cvt_pk_bf16(v0[2], v0[3]); w.z = cvt_pk_bf16(v1[0], v1[1]); w.w = cvt_pk_bf16(v1[2], v1[3]);
                    *(u32x4*)(rowp + bj * HALF) = w; }
                rowp += 16 * 8192; asm volatile("" : "+v"(rowp) :: "memory"); }
            rowp += 64 * 8192; }
    }
};
typedef unsigned u32x2 __attribute__((ext_vector_type(2)));
template <int MODE> struct EpiGate {
    static constexpr bool PERM = true, AFTER_DRAIN = false;
    const bf16_t* gate; int ldg; bf16_t* out; int ldc;
    __device__ __forceinline__ void operator()(const f32x4 (&acc)[2][2][4][2], const Unit& u, int wr, int wc, int fr, int fq) const {
        const int row0 = u.pm * BM + wr * 64 + fr, col0 = u.pn * BM + wc * 32 + 8 * fq;
        const bf16_t* gp = gate + (size_t)row0 * ldg + col0; bf16_t* op = out + (size_t)row0 * ldc + col0;
#pragma unroll
        for (int ai = 0; ai < 2; ++ai) {
#pragma unroll
            for (int m = 0; m < 4; ++m) {
#pragma unroll
                for (int bj = 0; bj < 2; ++bj) { const int c = bj * HALF;
                    const u32x4 gw = *(const u32x4*)(gp + c);
                    const unsigned gwd[4] = {gw.x, gw.y, gw.z, gw.w};
                    float v[8];
#pragma unroll
                    for (int e2 = 0; e2 < 8; ++e2) { const float g = (e2 & 1) ? __uint_as_float(gwd[e2 >> 1] & 0xffff0000u) : __uint_as_float(gwd[e2 >> 1] << 16);
                        v[e2] = acc[ai][bj][m][e2 >> 2][e2 & 3] * __builtin_amdgcn_rcpf(1.0f + __expf(-g)); }
                    if (MODE != 0) { const u32x4 pw = *(const u32x4*)(op + c); const unsigned pwd[4] = {pw.x, pw.y, pw.z, pw.w};
#pragma unroll
                        for (int e2 = 0; e2 < 8; ++e2) v[e2] += (e2 & 1) ? __uint_as_float(pwd[e2 >> 1] & 0xffff0000u) : __uint_as_float(pwd[e2 >> 1] << 16); }
                    u32x4 w; w.x = cvt_pk_bf16(v[0], v[1]); w.y = cvt_pk_bf16(v[2], v[3]); w.z = cvt_pk_bf16(v[4], v[5]); w.w = cvt_pk_bf16(v[6], v[7]); *(u32x4*)(op + c) = w; }
                gp += (size_t)16 * ldg; op += (size_t)16 * ldc; asm volatile("" : "+v"(gp), "+v"(op) :: "memory"); }
            gp += (size_t)64 * ldg; op += (size_t)64 * ldc; }
    }
};
struct EpiResid {
    static constexpr bool PERM = true, AFTER_DRAIN = false;
    const float* base; float* C; int ldc; float alpha;
    __device__ __forceinline__ void operator()(const f32x4 (&acc)[2][2][4][2], const Unit& u, int wr, int wc, int fr, int fq) const {
        const int row0 = u.pm * BM + wr * 64 + fr, col0 = u.pn * BM + wc * 32 + 8 * fq;
        const float* bp = base + (size_t)row0 * ldc + col0; float* cp = C + (size_t)row0 * ldc + col0;
#pragma unroll
        for (int ai = 0; ai < 2; ++ai) {
#pragma unroll
            for (int m = 0; m < 4; ++m) {
#pragma unroll
                for (int bj = 0; bj < 2; ++bj) { const f32x4 b0 = *(const f32x4*)(bp + bj * HALF), b1 = *(const f32x4*)(bp + bj * HALF + 4);
                    *(f32x4*)(cp + bj * HALF) = b0 * alpha + acc[ai][bj][m][0] * EXP_MIX_SCALE; *(f32x4*)(cp + bj * HALF + 4) = b1 * alpha + acc[ai][bj][m][1] * EXP_MIX_SCALE; }
                bp += (size_t)16 * ldc; cp += (size_t)16 * ldc; asm volatile("" : "+v"(bp), "+v"(cp) :: "memory"); }
            bp += (size_t)64 * ldc; cp += (size_t)64 * ldc; }
    }
};
struct OneUnit {
    int pm, pn;
    __device__ __forceinline__ bool next(int i, Unit& u) const { if (i > 0) return false; u.pm = pm; u.pn = pn; return true; }
    __device__ __forceinline__ void a_ready(const Unit&) const {}
    __device__ __forceinline__ void done(const Unit&) const {}
};
template <class Epi, class Sched, bool ALIGN_EPI = false, bool SP2 = false>
__device__ __forceinline__ void gemm_phase(PG8_LAS unsigned char* lds, const Gemm g, const Sched& S, const Epi& E) {
    int tid_ = threadIdx.x; asm volatile("" : "+v"(tid_));
    const int tid = tid_, wid = __builtin_amdgcn_readfirstlane(tid >> 6), lane = tid & 63, wr = wid >> 2, wc = wid & 3, fr = lane & 15, fq = lane >> 4;
    int K_ = g.K; asm volatile("" : "+s"(K_));
    const int K = K_, nt = K / BK;
    unsigned voffA[2], voffB[2];
#pragma unroll
    for (int i = 0; i < 2; ++i) { int R, C; stage_rc(tid * 16 + i * 8192, R, C); const int Rb = Epi::PERM ? ((R & ~31) + perm32(R & 31)) : R;
        voffA[i] = (unsigned)(R * g.lda + C) * 2u; voffB[i] = (unsigned)(Rb * g.ldb + C) * 2u; }
    const size_t kstep = (size_t)(BK * 2);
    const size_t hstepA = (size_t)HALF * g.lda * 2, hstepB = (size_t)HALF * g.ldb * 2;
    const size_t tstepA = 2 * hstepA, tstepB = 2 * hstepB;
    const unsigned ldsw = (unsigned)wid * 1024u;
    const int aoff = lds_byte(wr * 64 + fr, fq * 8), boff = lds_byte(wc * 32 + fr, fq * 8);
#define PG8_SA(b, h) (((b) * 2 + (h)) * HTB)
#define PG8_SB(b, h) ((4 + (b) * 2 + (h)) * HTB)
#define PG8_STAGE(bufoff, gbase, voff) do { _Pragma("unroll") for (int _i = 0; _i < 2; ++_i) \
        __builtin_amdgcn_global_load_lds((const unsigned*)((const char*)(gbase) + (voff)[_i]), (PG8_LAS unsigned*)(lds + (bufoff) + ldsw + _i * 8192), 16, 0, 0); } while (0)
#define PG8_LDA(dst, b, h) do { _Pragma("unroll") for (int m = 0; m < 4; ++m) _Pragma("unroll") for (int k = 0; k < 2; ++k) dst[m][k] = *(const PG8_LAS bf16x8*)(lds + PG8_SA(b, h) + aoff + m * 2048 + k * 1024); } while (0)
#define PG8_LDB(dst, b, h) do { _Pragma("unroll") for (int n = 0; n < 2; ++n) _Pragma("unroll") for (int k = 0; k < 2; ++k) dst[n][k] = *(const PG8_LAS bf16x8*)(lds + PG8_SB(b, h) + boff + n * 2048 + k * 1024); } while (0)
#define PG8_MMA(ai, bj, At, Bt) do { __builtin_amdgcn_s_setprio(1); _Pragma("unroll") for (int m = 0; m < 4; ++m) _Pragma("unroll") for (int n = 0; n < 2; ++n) _Pragma("unroll") for (int k = 0; k < 2; ++k) \
        acc[ai][bj][m][n] = __builtin_amdgcn_mfma_f32_16x16x32_bf16(Bt[n][k], At[m][k], acc[ai][bj][m][n], 0, 0, 0); __builtin_amdgcn_s_setprio(0); } while (0)
#define PG8_WAIT_V(n) asm volatile("s_waitcnt vmcnt(" #n ")" ::: "memory")
#define PG8_WAIT_L(n) asm volatile("s_waitcnt lgkmcnt(" #n ")" ::: "memory")
#define PG8_BAR __builtin_amdgcn_s_barrier()
#define PG8_SCHED __builtin_amdgcn_sched_barrier(0)
    Unit cur, nxt; int ui = 0;
    if (!S.next(0, cur)) return;
    f32x4 acc[2][2][4][2];
#pragma unroll
    for (int a = 0; a < 2; ++a)
#pragma unroll
        for (int b = 0; b < 2; ++b)
#pragma unroll
            for (int m = 0; m < 4; ++m)
#pragma unroll
                for (int n = 0; n < 2; ++n) acc[a][b][m][n] = (f32x4){0.f, 0.f, 0.f, 0.f};
    bf16x8 At[4][2], B0[2][2], B1[2][2];
    const char* cA = (const char*)g.A + (size_t)cur.pm * tstepA; const char* cB = (const char*)g.Bt + (size_t)cur.pn * tstepB;
    S.a_ready(cur);
    if constexpr (SP2) {
        PG8_STAGE(PG8_SB(0, 0), cB, voffB); PG8_STAGE(PG8_SB(0, 1), cB + hstepB, voffB); PG8_STAGE(PG8_SA(0, 0), cA, voffA); PG8_STAGE(PG8_SA(0, 1), cA + hstepA, voffA);
        if (wr == 1) PG8_BAR;
        PG8_WAIT_V(2); PG8_BAR;
        PG8_STAGE(PG8_SB(1, 0), cB + kstep, voffB); PG8_STAGE(PG8_SA(1, 0), cA + kstep, voffA); PG8_STAGE(PG8_SB(1, 1), cB + hstepB + kstep, voffB);
        PG8_WAIT_V(6); PG8_BAR;
    } else {
        PG8_STAGE(PG8_SB(0, 0), cB, voffB); PG8_STAGE(PG8_SA(0, 0), cA, voffA); PG8_STAGE(PG8_SB(0, 1), cB + hstepB, voffB); PG8_STAGE(PG8_SA(0, 1), cA + hstepA, voffA);
        if (wr == 1) PG8_BAR;
        PG8_WAIT_V(4); PG8_BAR;
        PG8_STAGE(PG8_SB(1, 0), cB + kstep, voffB); PG8_STAGE(PG8_SA(1, 0), cA + kstep, voffA); PG8_STAGE(PG8_SB(1, 1), cB + hstepB + kstep, voffB);
        PG8_WAIT_V(6); PG8_BAR;
    }
    for (;;) {
        const bool has_next = S.next(ui + 1, nxt);
        const char* nA = has_next ? (const char*)g.A + (size_t)nxt.pm * tstepA : cA; const char* nB = has_next ? (const char*)g.Bt + (size_t)nxt.pn * tstepB : cB;
        for (int t = 0; t < nt; t += 2) {
            const bool last = (t == nt - 2);
            const char* a1 = cA + (size_t)(t + 1) * kstep;
            const char* a2 = last ? nA : cA + (size_t)(t + 2) * kstep; const char* b2 = last ? nB : cB + (size_t)(t + 2) * kstep;
            const char* a3 = a2 + kstep; const char* b3 = b2 + kstep;
            if (last && has_next) S.a_ready(nxt);
            if constexpr (SP2) {
            PG8_LDB(B0, 0, 0); PG8_LDB(B1, 0, 1); PG8_SCHED; PG8_LDA(At, 0, 0); PG8_STAGE(PG8_SA(1, 1), a1 + hstepA, voffA);
            PG8_WAIT_V(8); PG8_WAIT_L(0); PG8_BAR; PG8_MMA(0, 0, At, B0); PG8_MMA(0, 1, At, B1); PG8_BAR; PG8_SCHED;
            PG8_LDA(At, 0, 1); PG8_STAGE(PG8_SB(0, 0), b2, voffB); PG8_STAGE(PG8_SB(0, 1), b2 + hstepB, voffB); PG8_STAGE(PG8_SA(0, 0), a2, voffA);
            PG8_WAIT_V(8); PG8_WAIT_L(0); PG8_BAR; PG8_MMA(1, 0, At, B0); PG8_MMA(1, 1, At, B1); PG8_BAR; PG8_SCHED;
            PG8_LDB(B0, 1, 0); PG8_LDB(B1, 1, 1); PG8_SCHED; PG8_LDA(At, 1, 0); PG8_STAGE(PG8_SA(0, 1), a2 + hstepA, voffA);
            PG8_WAIT_V(8); PG8_WAIT_L(0); PG8_BAR; PG8_MMA(0, 0, At, B0); PG8_MMA(0, 1, At, B1); PG8_BAR; PG8_SCHED;
            PG8_LDA(At, 1, 1); PG8_STAGE(PG8_SB(1, 0), b3, voffB); PG8_STAGE(PG8_SB(1, 1), b3 + hstepB, voffB); PG8_STAGE(PG8_SA(1, 0), a3, voffA);
            PG8_WAIT_V(8); PG8_WAIT_L(0); PG8_BAR; PG8_MMA(1, 0, At, B0); PG8_MMA(1, 1, At, B1); PG8_BAR; PG8_SCHED;
            } else {
            PG8_LDB(B0, 0, 0); PG8_SCHED; PG8_LDA(At, 0, 0); PG8_STAGE(PG8_SA(1, 1), a1 + hstepA, voffA);
            PG8_WAIT_L(8); PG8_BAR; PG8_WAIT_L(0); PG8_MMA(0, 0, At, B0); PG8_BAR; PG8_SCHED;
            PG8_LDB(B1, 0, 1); PG8_STAGE(PG8_SB(0, 0), b2, voffB);
            PG8_BAR; PG8_WAIT_L(0); PG8_MMA(0, 1, At, B1); PG8_BAR;
            PG8_LDA(At, 0, 1); PG8_STAGE(PG8_SA(0, 0), a2, voffA);
            PG8_BAR; PG8_WAIT_L(0); PG8_MMA(1, 0, At, B0); PG8_BAR; PG8_SCHED;
            PG8_STAGE(PG8_SB(0, 1), b2 + hstepB, voffB);
            PG8_WAIT_V(6); PG8_BAR; PG8_MMA(1, 1, At, B1); PG8_BAR;
            PG8_LDB(B0, 1, 0); PG8_SCHED; PG8_LDA(At, 1, 0); PG8_STAGE(PG8_SA(0, 1), a2 + hstepA, voffA);
            PG8_WAIT_L(8); PG8_BAR; PG8_WAIT_L(0); PG8_MMA(0, 0, At, B0); PG8_BAR; PG8_SCHED;
            PG8_LDB(B1, 1, 1); PG8_STAGE(PG8_SB(1, 0), b3, voffB);
            PG8_BAR; PG8_WAIT_L(0); PG8_MMA(0, 1, At, B1); PG8_BAR;
            PG8_LDA(At, 1, 1); PG8_STAGE(PG8_SA(1, 0), a3, voffA);
            PG8_BAR; PG8_WAIT_L(0); PG8_MMA(1, 0, At, B0); PG8_BAR; PG8_SCHED;
            PG8_STAGE(PG8_SB(1, 1), b3 + hstepB, voffB);
            PG8_WAIT_V(6); PG8_BAR; PG8_MMA(1, 1, At, B1); PG8_BAR;
            }
        }
        if constexpr (ALIGN_EPI) { if (wr == 0) PG8_BAR; }
        if constexpr (!Epi::AFTER_DRAIN) { E(acc, cur, wr, wc, fr, fq); S.done(cur); }
        if (!has_next) break;
#pragma unroll
        for (int a = 0; a < 2; ++a)
#pragma unroll
            for (int b = 0; b < 2; ++b)
#pragma unroll
                for (int m = 0; m < 4; ++m)
#pragma unroll
                    for (int n = 0; n < 2; ++n) acc[a][b][m][n] = (f32x4){0.f, 0.f, 0.f, 0.f};
        cur = nxt; cA = nA; cB = nB; ++ui;
        if constexpr (ALIGN_EPI) { if (wr == 1) PG8_BAR; }
    }
    PG8_WAIT_V(0);
    if constexpr (!ALIGN_EPI) { if (wr == 0) PG8_BAR; }
    PG8_BAR;
    if constexpr (Epi::AFTER_DRAIN) { E.fused(acc, cur, wr, wc, fr, fq, lds, wid, lane); S.done(cur); }
#undef PG8_SA
#undef PG8_SB
#undef PG8_STAGE
#undef PG8_LDA
#undef PG8_LDB
#undef PG8_MMA
#undef PG8_WAIT_V
#undef PG8_WAIT_L
#undef PG8_BAR
#undef PG8_SCHED
}
}

#define LAS __attribute__((address_space(3)))
typedef unsigned short bf16;
typedef float f32x4 __attribute__((ext_vector_type(4)));
typedef float f32x2 __attribute__((ext_vector_type(2)));
typedef unsigned u32x4 __attribute__((ext_vector_type(4)));
typedef unsigned u32x2 __attribute__((ext_vector_type(2)));
typedef __bf16 bf16x2_t __attribute__((ext_vector_type(2)));

constexpr int NWAVES = 8, NTHR = 512;
constexpr int BATCH = 2, SEQ = 4096, DM = 2048, TOK = BATCH * SEQ, DEPTH = 2;
constexpr int W_IN = 12800, HW = 12288;
constexpr int H_FF = 0, H_FB = 768, H_Q = 1536, H_I = 2304, H_G = 3072, H_QA = 3840, H_KA = 4608, H_VA = 5376, H_GATE = 6144;
constexpr int NEXP = 16384;
constexpr float DN_ALPHA = 1.41421356237309515f;
constexpr float LN_EPS = 1e-5f;
constexpr int LDS_BYTES = 147456;

constexpr size_t MiB = 1u << 20;
constexpr size_t WS_WL0 = 1 * MiB, WL_STRIDE = 202 * MiB;
constexpr size_t WL_WIN = 0, WL_WF = 48 * MiB, WL_BRF = 52 * MiB, WL_BRH = 54 * MiB, WL_BRA = 57 * MiB, WL_OUT = 58 * MiB, WL_WS = 66 * MiB, WL_U = 74 * MiB, WL_V = 138 * MiB;
constexpr size_t WS_F = 405 * MiB;
constexpr size_t WS_H = 469 * MiB;
constexpr size_t WS_PT = 661 * MiB;
constexpr size_t WS_FP = 677 * MiB;
constexpr size_t WS_LB = 741 * MiB;
constexpr size_t WS_SB = 837 * MiB;
constexpr size_t WS_YF = 885 * MiB, WS_YH = 893 * MiB, WS_YA = 905 * MiB;
constexpr size_t WS_XA = 909 * MiB;
constexpr size_t WS_TAB = 941 * MiB;
constexpr size_t WS_END = 944 * MiB;
constexpr size_t WS_VPRE = WS_H, WS_SC = WS_H + 64 * MiB, WS_MACC = WS_FP, WS_MERGED = WS_LB;
constexpr size_t TAB_SIN = 128 * 1024, TAB_LB = 256 * 1024;
constexpr size_t WS_WQB = WS_H, WS_WFB = WS_H + 16 * MiB, WS_CST = WS_H + 20 * MiB, WS_KD2 = WS_H + 21 * MiB;

struct Ctx { unsigned char* lds; int tid, lane, wave, G, c, gw, ngw; };

__device__ __forceinline__ unsigned f2bf(float f) { unsigned u = __float_as_uint(f); return (u + 0x7fffu + ((u >> 16) & 1u)) >> 16; }
__device__ __forceinline__ unsigned pk2(float lo, float hi) { return f2bf(lo) | (f2bf(hi) << 16); }
__device__ __forceinline__ float bf2f(unsigned short b) { return __uint_as_float((unsigned)b << 16); }
__device__ __forceinline__ float bflo(unsigned w) { return __uint_as_float(w << 16); }
__device__ __forceinline__ float bfhi(unsigned w) { return __uint_as_float(w & 0xffff0000u); }
#define LDS_WAIT() asm volatile("s_waitcnt lgkmcnt(0)" ::: "memory")

template <int CTRL> __device__ __forceinline__ float dpp_f(float v) { return __int_as_float(__builtin_amdgcn_update_dpp(0, __float_as_int(v), CTRL, 0xF, 0xF, true)); }
__device__ __forceinline__ float rdlane(float v, int l) { return __int_as_float(__builtin_amdgcn_readlane(__float_as_int(v), l)); }
__device__ __forceinline__ float wave_max(float v) {
    v = fmaxf(v, dpp_f<0xB1>(v)); v = fmaxf(v, dpp_f<0x4E>(v)); v = fmaxf(v, dpp_f<0x141>(v)); v = fmaxf(v, dpp_f<0x140>(v));
    return fmaxf(fmaxf(rdlane(v, 0), rdlane(v, 16)), fmaxf(rdlane(v, 32), rdlane(v, 48)));
}
__device__ __forceinline__ float wave_sum(float v) {
    v += dpp_f<0xB1>(v); v += dpp_f<0x4E>(v); v += dpp_f<0x141>(v); v += dpp_f<0x140>(v);
    return (rdlane(v, 0) + rdlane(v, 16)) + (rdlane(v, 32) + rdlane(v, 48));
}

__device__ __forceinline__ void transpose_item(const float* W, int ldw, int K, int N, bf16* WT, LAS float* scr, int item, int lane) {
    const int nblk = N / 32, kb = item / nblk, nb = item % nblk, k0 = 64 * kb, n0 = 32 * nb;
    f32x4 rv[8];
#pragma unroll
    for (int i = 0; i < 8; ++i) rv[i] = *(const f32x4*)(W + (size_t)(k0 + 8 * i + (lane >> 3)) * ldw + n0 + (lane & 7) * 4);
#pragma unroll
    for (int i = 0; i < 8; ++i) { LAS float* d = scr + (8 * i + (lane >> 3)) * 33 + (lane & 7) * 4; d[0] = rv[i][0]; d[1] = rv[i][1]; d[2] = rv[i][2]; d[3] = rv[i][3]; }
    LDS_WAIT(); asm volatile("" ::: "memory");
    const int c = lane & 7;
#pragma unroll
    for (int j = 0; j < 4; ++j) { const int n = (lane >> 3) + 8 * j; const LAS float* s = scr + (8 * c) * 33 + n;
        u32x4 o; o.x = pk2(s[0 * 33], s[1 * 33]); o.y = pk2(s[2 * 33], s[3 * 33]); o.z = pk2(s[4 * 33], s[5 * 33]); o.w = pk2(s[6 * 33], s[7 * 33]);
        *(u32x4*)(WT + (size_t)(n0 + n) * K + k0 + 8 * c) = o; }
    LDS_WAIT(); asm volatile("" ::: "memory");
}
__device__ __forceinline__ void ln_row(const float (&v)[32], int lane, const float* g, const float* b, float* of, bf16* ob) {
    float s = 0.f;
#pragma unroll
    for (int i = 0; i < 32; ++i) s += v[i];
    const float mean = wave_sum(s) * (1.f / DM);
    float s2 = 0.f;
#pragma unroll
    for (int i = 0; i < 32; ++i) { const float d = v[i] - mean; s2 += d * d; }
    const float rstd = 1.0f / sqrtf(wave_sum(s2) * (1.f / DM) + LN_EPS);
#pragma unroll
    for (int c = 0; c < 4; ++c) { const int e0 = c * 512 + lane * 8;
        const f32x4 g0 = *(const f32x4*)(g + e0), g1 = *(const f32x4*)(g + e0 + 4), b0 = *(const f32x4*)(b + e0), b1 = *(const f32x4*)(b + e0 + 4);
        f32x4 o0, o1;
#pragma unroll
        for (int e = 0; e < 4; ++e) { o0[e] = (v[c * 8 + e] - mean) * rstd * g0[e] + b0[e]; o1[e] = (v[c * 8 + 4 + e] - mean) * rstd * g1[e] + b1[e]; }
        *(f32x4*)(of + e0) = o0; *(f32x4*)(of + e0 + 4) = o1;
        u32x4 w; w.x = pk2(o0[0], o0[1]); w.y = pk2(o0[2], o0[3]); w.z = pk2(o1[0], o1[1]); w.w = pk2(o1[2], o1[3]);
        *(u32x4*)(ob + e0) = w; }
}
__device__ __forceinline__ void load_row32(const float* src, int lane, float (&v)[32]) {
#pragma unroll
    for (int c = 0; c < 4; ++c) { const f32x4 a = *(const f32x4*)(src + c * 512 + lane * 8), b = *(const f32x4*)(src + c * 512 + lane * 8 + 4);
#pragma unroll
        for (int e = 0; e < 4; ++e) { v[c * 8 + e] = a[e]; v[c * 8 + 4 + e] = b[e]; } }
}

template <int CH, int EPC> __device__ __forceinline__ void load_row_t(const float* src, int lane, float (&v)[32]) {
#pragma unroll
    for (int c = 0; c < CH; ++c)
#pragma unroll
        for (int q = 0; q < EPC / 4; ++q) { const f32x4 a = *(const f32x4*)(src + c * 64 * EPC + lane * EPC + 4 * q);
#pragma unroll
            for (int e = 0; e < 4; ++e) v[c * EPC + 4 * q + e] = a[e]; }
}
template <int CH, int EPC> __device__ __forceinline__ void ln_row_t(const float (&v)[32], int lane, const float* g, const float* b, float* of, bf16* ob) {
    float s = 0.f;
#pragma unroll
    for (int i = 0; i < 32; ++i) s += v[i];
    const float mean = wave_sum(s) * (1.f / DM);
    float s2 = 0.f;
#pragma unroll
    for (int i = 0; i < 32; ++i) { const float d = v[i] - mean; s2 += d * d; }
    const float rstd = 1.0f / sqrtf(wave_sum(s2) * (1.f / DM) + LN_EPS);
#pragma unroll
    for (int c = 0; c < CH; ++c)
#pragma unroll
        for (int q = 0; q < EPC / 8; ++q) { const int e0 = c * 64 * EPC + lane * EPC + 8 * q, i0 = c * EPC + 8 * q;
            const f32x4 g0 = *(const f32x4*)(g + e0), g1 = *(const f32x4*)(g + e0 + 4), b0 = *(const f32x4*)(b + e0), b1 = *(const f32x4*)(b + e0 + 4);
            f32x4 o0, o1;
#pragma unroll
            for (int e = 0; e < 4; ++e) { o0[e] = (v[i0 + e] - mean) * rstd * g0[e] + b0[e]; o1[e] = (v[i0 + 4 + e] - mean) * rstd * g1[e] + b1[e]; }
            *(f32x4*)(of + e0) = o0; *(f32x4*)(of + e0 + 4) = o1;
            u32x4 w; w.x = pk2(o0[0], o0[1]); w.y = pk2(o0[2], o0[3]); w.z = pk2(o1[0], o1[1]); w.w = pk2(o1[2], o1[3]);
            *(u32x4*)(ob + e0) = w; }
}
constexpr float PEER_US = 64.0f, PEER_VS = 16.0f, PEER_XS = 32.0f;
__device__ __forceinline__ unsigned pk4_fp8(float a, float b, float c, float d) { int w = __builtin_amdgcn_cvt_pk_fp8_f32(a, b, 0, false); return (unsigned)__builtin_amdgcn_cvt_pk_fp8_f32(c, d, w, true); }
__device__ __forceinline__ void prologue(const Ctx& X, const float* const* in, float* out, unsigned char* ws) {
    const float* x = in[0]; const float* emb_g = in[1]; const float* emb_b = in[2]; const float* w_in = in[3];
    const float* w_brf = in[4]; const float* w_brh = in[5]; const float* w_bra = in[6]; const float* w_out = in[7];
    const float* lb_logits = in[8]; const float* w_query = in[12]; const float* sub_keys = in[13]; const float* peer_u = in[14]; const float* peer_v = in[15];
    const int lane = X.lane, tid = X.tid;
#ifndef PRO_REP
#define PRO_REP 0
#endif
    for (int rp = 0; rp < (PRO_REP == 1 ? 2 : 1); ++rp) {
        LAS float* scr = (LAS float*)(X.lds + X.wave * 16384);
        constexpr int I_WIN = (DM / 64) * (HW / 32), I_BRF = (512 / 64) * (DM / 32), I_BRH = (768 / 64) * (DM / 32), I_BRA = (256 / 64) * (DM / 32), I_OUT = (DM / 64) * (DM / 32);
        constexpr int PER_L = I_WIN + I_BRF + I_BRH + I_BRA + I_OUT;
        for (int it = X.gw; it < DEPTH * PER_L; it += X.ngw) {
            const int l = it / PER_L; int r = it % PER_L; unsigned char* wl = ws + WS_WL0 + (size_t)l * WL_STRIDE;
            if (r < I_WIN) { transpose_item(w_in + (size_t)l * DM * W_IN + 512, W_IN, DM, HW, (bf16*)(wl + WL_WIN), scr, r, lane); continue; } r -= I_WIN;
            if (r < I_BRF) { transpose_item(w_brf + (size_t)l * 512 * DM, DM, 512, DM, (bf16*)(wl + WL_BRF), scr, r, lane); continue; } r -= I_BRF;
            if (r < I_BRH) { transpose_item(w_brh + (size_t)l * 768 * DM, DM, 768, DM, (bf16*)(wl + WL_BRH), scr, r, lane); continue; } r -= I_BRH;
            if (r < I_BRA) { transpose_item(w_bra + (size_t)l * 256 * DM, DM, 256, DM, (bf16*)(wl + WL_BRA), scr, r, lane); continue; } r -= I_BRA;
            transpose_item(w_out + (size_t)l * DM * DM, DM, DM, DM, (bf16*)(wl + WL_OUT), scr, r, lane);
        }
    }
    for (int rp = 0; rp < (PRO_REP == 2 ? 2 : 1); ++rp) {
        const size_t n16 = (size_t)NEXP * DM / 16; const size_t gt = (size_t)X.c * NTHR + tid, gs = (size_t)X.G * NTHR;
        for (int l = 0; l < DEPTH; ++l) {
            const float* su = peer_u + (size_t)l * NEXP * DM; const float* sv = peer_v + (size_t)l * NEXP * DM;
            unsigned char* du = ws + WS_WL0 + (size_t)l * WL_STRIDE + WL_U; unsigned char* dv = ws + WS_WL0 + (size_t)l * WL_STRIDE + WL_V;
            for (size_t i = gt; i < n16; i += gs) {
                u32x4 w, z;
                { const f32x4 a0 = *(const f32x4*)(su + i * 16) * PEER_US, a1 = *(const f32x4*)(su + i * 16 + 4) * PEER_US, a2 = *(const f32x4*)(su + i * 16 + 8) * PEER_US, a3 = *(const f32x4*)(su + i * 16 + 12) * PEER_US;
                  w.x = pk4_fp8(a0[0], a0[1], a0[2], a0[3]); w.y = pk4_fp8(a1[0], a1[1], a1[2], a1[3]); w.z = pk4_fp8(a2[0], a2[1], a2[2], a2[3]); w.w = pk4_fp8(a3[0], a3[1], a3[2], a3[3]); }
                { const f32x4 a0 = *(const f32x4*)(sv + i * 16) * PEER_VS, a1 = *(const f32x4*)(sv + i * 16 + 4) * PEER_VS, a2 = *(const f32x4*)(sv + i * 16 + 8) * PEER_VS, a3 = *(const f32x4*)(sv + i * 16 + 12) * PEER_VS;
                  z.x = pk4_fp8(a0[0], a0[1], a0[2], a0[3]); z.y = pk4_fp8(a1[0], a1[1], a1[2], a1[3]); z.z = pk4_fp8(a2[0], a2[1], a2[2], a2[3]); z.w = pk4_fp8(a3[0], a3[1], a3[2], a3[3]); }
                *(u32x4*)(du + i * 16) = w; *(u32x4*)(dv + i * 16) = z;
            }
        }
    }
    __syncthreads();
    {
        const size_t gt = (size_t)X.c * NTHR + tid, gs = (size_t)X.G * NTHR;
        for (int l = 0; l < DEPTH; ++l) {
            bf16* wfb = (bf16*)(ws + WS_WFB) + (size_t)l * DM * 512; bf16* wqb = (bf16*)(ws + WS_WQB) + (size_t)l * DM * DM;
            for (size_t i = gt; i < (size_t)DM * 512 / 8; i += gs) { const size_t d = i >> 6, c8 = (i & 63) * 8; const float* s = w_in + (size_t)l * DM * W_IN + d * W_IN + c8;
                const f32x4 v0 = *(const f32x4*)s, v1 = *(const f32x4*)(s + 4); u32x4 w; w.x = pk2(v0[0], v0[1]); w.y = pk2(v0[2], v0[3]); w.z = pk2(v1[0], v1[1]); w.w = pk2(v1[2], v1[3]); *(u32x4*)(wfb + d * 512 + c8) = w; }
            for (size_t i = gt; i < (size_t)DM * DM / 8; i += gs) { const float* s = w_query + (size_t)l * DM * DM + i * 8;
                const f32x4 v0 = *(const f32x4*)s, v1 = *(const f32x4*)(s + 4); u32x4 w; w.x = pk2(v0[0], v0[1]); w.y = pk2(v0[2], v0[3]); w.z = pk2(v1[0], v1[1]); w.w = pk2(v1[2], v1[3]); *(u32x4*)(wqb + i * 8) = w; }
            bf16* kd = (bf16*)(ws + WS_KD2) + (size_t)l * 256 * 256;
            for (size_t i = gt; i < 256 * 256; i += gs) { const int m = (int)(i >> 8), k = (int)(i & 255), p = m >> 7, pp = k >> 7;
                kd[i] = (p == pp) ? (bf16)f2bf(sub_keys[(((size_t)l * 2 + p) * 128 + (m & 127)) * 128 + (k & 127)]) : (bf16)0; }
        }
        bf16* cst = (bf16*)(ws + WS_CST);
        for (size_t i = gt; i < 1024 * 512; i += gs) { const int m = (int)(i >> 9), k = (int)(i & 511), part = m >> 9, g = (m >> 7) & 3, k2 = m & 127, gg = k >> 7, n2 = k & 127;
            const int mm = (k2 * n2 - part * 32) & 127;
            cst[i] = (g == gg) ? (bf16)f2bf(cospif((float)mm * (1.0f / 64.0f))) : (bf16)0; }
    }
    __syncthreads();
    for (int rp = 0; rp < (PRO_REP == 5 ? 2 : 1); ++rp) {
        LAS float* ct = (LAS float*)X.lds;
        const float norm = 1.0f / sqrtf((float)SEQ * 128.0f);
        for (int i = tid; i < 4096; i += NTHR) ct[i] = cospif((float)i * (1.0f / 2048.0f)) * norm;
        __syncthreads();
        bf16* Fm = (bf16*)(ws + WS_F);
        for (int k1 = X.c; k1 < SEQ; k1 += X.G) {
#pragma unroll
            for (int rep = 0; rep < 2; ++rep) {
                const int e0 = (tid + rep * NTHR) * 8;
                const int part = e0 >> 12, n1 = e0 & 4095;
                float v[8];
#pragma unroll
                for (int j = 0; j < 8; ++j) { const int idx = (k1 * (n1 + j)) & 4095; v[j] = part ? -ct[(idx - 1024) & 4095] : ct[idx]; }
                u32x4 w; w.x = pk2(v[0], v[1]); w.y = pk2(v[2], v[3]); w.z = pk2(v[4], v[5]); w.w = pk2(v[6], v[7]);
                *(u32x4*)(Fm + (size_t)k1 * 8192 + e0) = w;
            }
        }
    }
    __syncthreads();
    {
        const int gt = X.c * NTHR + tid;
        if (gt < SEQ * 8) { const int pos = gt >> 3, i = gt & 7; const float invf = powf(500000.0f, -(float)i * 0.125f); const float ang = (float)pos * invf;
            ((float*)(ws + WS_TAB))[gt] = cosf(ang); ((float*)(ws + WS_TAB + TAB_SIN))[gt] = sinf(ang); }
        if (gt < 2 * 768) { const int dir = gt / 768, col = gt % 768; const float l0 = lb_logits[(dir * DEPTH + 0) * 768 + col], l1 = lb_logits[(dir * DEPTH + 1) * 768 + col];
            float* lb = (float*)(ws + WS_TAB + TAB_LB);
            lb[(dir * DEPTH + 0) * 768 + col] = 0.f;
            lb[(dir * DEPTH + 1) * 768 + col] = 1.0f / (1.0f + expf(l0 - l1)); }
    }
    for (int rp = 0; rp < (PRO_REP == 6 ? 2 : 1); ++rp)
    for (int m = X.gw; m < TOK; m += X.ngw) { float v[32]; load_row32(x + (size_t)m * DM, lane, v); ln_row(v, lane, emb_g, emb_b, out + (size_t)m * DM, (bf16*)(ws + WS_XA) + (size_t)m * DM); }
}
#define GAS __attribute__((address_space(1)))
typedef GAS unsigned gu32;
typedef GAS unsigned long long gu64;
#define RLX_AGENT __ATOMIC_RELAXED, __HIP_MEMORY_SCOPE_AGENT
#define VM_WAIT() asm volatile("s_waitcnt vmcnt(0)" ::: "memory")
__device__ __forceinline__ unsigned long long rt() { return __builtin_amdgcn_s_memrealtime(); }
#define XB_TMO      128
#define XB_XCNT(j)  (256  + 64 * (j))
#define XB_XSUB(j)  (1280 + 64 * (j))
#define XB_XGEN(j)  (2304 + 64 * (j))
#define XB_TOP      3328
#define XB_TOPGEN   3392
#define XCD_BAR_WORDS 3456
#define XB_SPIN_CAP (1u << 22)

__device__ __forceinline__ unsigned xb_ld(unsigned* p)              { return __hip_atomic_load(p, __ATOMIC_RELAXED, __HIP_MEMORY_SCOPE_AGENT); }
__device__ __forceinline__ unsigned xb_add(unsigned* p, unsigned v) { return __hip_atomic_fetch_add(p, v, __ATOMIC_RELAXED, __HIP_MEMORY_SCOPE_AGENT); }
__device__ __forceinline__ unsigned xb_xcc_id() { return (unsigned)__builtin_amdgcn_s_getreg((3 << 11) | 20) & 0xFu; }
#define XB_SPIN(cond, bar) do { unsigned _sp = 0; while (cond) { __builtin_amdgcn_s_sleep(1); \
    if ((++_sp & 255u) == 0u) { if (xb_ld(&(bar)[XB_TMO])) break; if (_sp > XB_SPIN_CAP) { atomicAdd(&(bar)[XB_TMO], 1u); break; } } } } while (0)

struct XcdBarrier {
    unsigned* bar; unsigned x;
    volatile LAS unsigned* st;
};

__device__ __forceinline__ XcdBarrier xcd_barrier_post(unsigned* bar, volatile LAS unsigned* st) {
    XcdBarrier b; b.bar = bar; b.x = xb_xcc_id(); b.st = st;
    if (threadIdx.x == 0) (void)xb_add(&bar[XB_XCNT(b.x)], 1u);
    return b;
}
__device__ __forceinline__ void xcd_barrier_complete(unsigned* bar, unsigned x, unsigned& nloc, unsigned& nx) {
    const unsigned G = gridDim.x * gridDim.y * gridDim.z;
    unsigned sum, cnt, mine, sp = 0u;
    for (;;) {
        sum = 0u; cnt = 0u; mine = 0u;
#pragma unroll
        for (unsigned j = 0; j < 16; ++j) { const unsigned c = xb_ld(&bar[XB_XCNT(j)]); sum += c; cnt += (c > 0u) ? 1u : 0u; mine = (j == x) ? c : mine; }
        if (sum == G) break;
        __builtin_amdgcn_s_sleep(1);
        if ((++sp & 255u) == 0u) { if (xb_ld(&bar[XB_TMO])) break; if (sp > XB_SPIN_CAP) { atomicAdd(&bar[XB_TMO], 1u); break; } }
    }
    nloc = mine > 0u ? mine : 1u; nx = cnt > 0u ? cnt : 1u;
}

__device__ __forceinline__ void xcd_barrier(const XcdBarrier& b) {
    asm volatile("s_waitcnt vmcnt(0)" ::: "memory");
    __syncthreads();
    if (threadIdx.x == 0) {
        unsigned* bar = b.bar;
        __builtin_amdgcn_s_waitcnt(0);
        unsigned nloc = b.st[0], nx = b.st[1];
        if (nloc == 0u) { xcd_barrier_complete(bar, b.x, nloc, nx); b.st[0] = nloc; b.st[1] = nx; }
        const unsigned old = xb_add(&bar[XB_XSUB(b.x)], 1u);
        const unsigned gen = old / nloc;
        if (old + 1u == (gen + 1u) * nloc) {
            __builtin_amdgcn_fence(__ATOMIC_RELEASE, "agent");
            asm volatile("s_waitcnt vmcnt(0)" ::: "memory");
            const unsigned og = xb_add(&bar[XB_TOP], 1u);
            const unsigned tg = og / nx;
            if (og + 1u == (tg + 1u) * nx) xb_add(&bar[XB_TOPGEN], 1u);
            else XB_SPIN(xb_ld(&bar[XB_TOPGEN]) == tg, bar);
            __builtin_amdgcn_fence(__ATOMIC_ACQUIRE, "agent");
            xb_add(&bar[XB_XGEN(b.x)], 1u);
            asm volatile("s_waitcnt vmcnt(0)" ::: "memory");
        } else {
            XB_SPIN(xb_ld(&bar[XB_XGEN(b.x)]) == gen, bar);
            __builtin_amdgcn_fence(__ATOMIC_ACQUIRE, "agent");
            asm volatile("s_waitcnt vmcnt(0)" ::: "memory");
        }
    }
    __syncthreads();
}

__device__ __forceinline__ void attn_naive(const Ctx& X, const bf16* h, const float* rc, const float* rs, bf16* ya) {
    for (int idx = X.c * NTHR + X.tid; idx < TOK * 4; idx += X.G * NTHR) {
        const int tk = idx >> 2, hh = idx & 3, b = tk / SEQ, p = tk % SEQ;
        float mx = -1e30f, l = 0.f; float o[64];
#pragma unroll
        for (int d = 0; d < 64; ++d) o[d] = 0.f;
        for (int g = 0; g < 3; ++g) {
            const int dil = (g == 0) ? 1 : (g == 1 ? 4 : 16), head = g * 4 + hh;
            float q[64];
            { const bf16* qp = h + (size_t)tk * HW + H_QA + head * 64;
#pragma unroll
              for (int i = 0; i < 8; ++i) { const u32x4 w = *(const u32x4*)(qp + i * 8); q[i * 8 + 0] = bflo(w.x); q[i * 8 + 1] = bfhi(w.x); q[i * 8 + 2] = bflo(w.y); q[i * 8 + 3] = bfhi(w.y);
                  q[i * 8 + 4] = bflo(w.z); q[i * 8 + 5] = bfhi(w.z); q[i * 8 + 6] = bflo(w.w); q[i * 8 + 7] = bfhi(w.w); }
#pragma unroll
              for (int i = 0; i < 8; ++i) { const float c = rc[p * 8 + i], s = rs[p * 8 + i], t1 = q[i], t2 = q[8 + i]; q[i] = t1 * c - t2 * s; q[8 + i] = t2 * c + t1 * s; }
#pragma unroll
              for (int d = 0; d < 64; ++d) q[d] *= 0.125f; }
            for (int j = -64; j <= 64; ++j) {
                const int kp = p + j * dil; if (kp < 0 || kp >= SEQ) continue;
                const bf16* kr = h + (size_t)(b * SEQ + kp) * HW + H_KA + head * 64;
                float s = 0.f;
                { const u32x4 w0 = *(const u32x4*)(kr), w1 = *(const u32x4*)(kr + 8);
                  const float k1[8] = {bflo(w0.x), bfhi(w0.x), bflo(w0.y), bfhi(w0.y), bflo(w0.z), bfhi(w0.z), bflo(w0.w), bfhi(w0.w)};
                  const float k2[8] = {bflo(w1.x), bfhi(w1.x), bflo(w1.y), bfhi(w1.y), bflo(w1.z), bfhi(w1.z), bflo(w1.w), bfhi(w1.w)};
#pragma unroll
                  for (int i = 0; i < 8; ++i) { const float c = rc[kp * 8 + i], sn = rs[kp * 8 + i]; s += q[i] * (k1[i] * c - k2[i] * sn) + q[8 + i] * (k2[i] * c + k1[i] * sn); } }
#pragma unroll
                for (int i = 2; i < 8; ++i) { const u32x4 w = *(const u32x4*)(kr + i * 8);
                    s += q[i * 8 + 0] * bflo(w.x) + q[i * 8 + 1] * bfhi(w.x) + q[i * 8 + 2] * bflo(w.y) + q[i * 8 + 3] * bfhi(w.y) + q[i * 8 + 4] * bflo(w.z) + q[i * 8 + 5] * bfhi(w.z) + q[i * 8 + 6] * bflo(w.w) + q[i * 8 + 7] * bfhi(w.w); }
                const float mn = fmaxf(mx, s), corr = __expf(mx - mn), pr = __expf(s - mn);
                l = l * corr + pr; mx = mn;
                const bf16* vr = h + (size_t)(b * SEQ + kp) * HW + H_VA + head * 64;
#pragma unroll
                for (int i = 0; i < 8; ++i) { const u32x4 w = *(const u32x4*)(vr + i * 8);
                    o[i * 8 + 0] = o[i * 8 + 0] * corr + pr * bflo(w.x); o[i * 8 + 1] = o[i * 8 + 1] * corr + pr * bfhi(w.x); o[i * 8 + 2] = o[i * 8 + 2] * corr + pr * bflo(w.y); o[i * 8 + 3] = o[i * 8 + 3] * corr + pr * bfhi(w.y);
                    o[i * 8 + 4] = o[i * 8 + 4] * corr + pr * bflo(w.z); o[i * 8 + 5] = o[i * 8 + 5] * corr + pr * bfhi(w.z); o[i * 8 + 6] = o[i * 8 + 6] * corr + pr * bflo(w.w); o[i * 8 + 7] = o[i * 8 + 7] * corr + pr * bfhi(w.w); }
            }
        }
        const float il = 1.0f / l; bf16* op = ya + (size_t)tk * 256 + hh * 64;
#pragma unroll
        for (int i = 0; i < 8; ++i) { u32x4 w; w.x = pk2(o[i * 8] * il, o[i * 8 + 1] * il); w.y = pk2(o[i * 8 + 2] * il, o[i * 8 + 3] * il); w.z = pk2(o[i * 8 + 4] * il, o[i * 8 + 5] * il); w.w = pk2(o[i * 8 + 6] * il, o[i * 8 + 7] * il);
            *(u32x4*)(op + i * 8) = w; }
    }
}
__device__ __forceinline__ void hgrn_prep_naive(const Ctx& X, const bf16* h, const float* lbl  , float* FD, float* KY) {
    const size_t n = (size_t)2 * TOK * 768;
    for (size_t i = (size_t)X.c * NTHR + X.tid; i < n; i += (size_t)X.G * NTHR) {
        const int dir = (int)(i / ((size_t)TOK * 768)); const size_t r = i % ((size_t)TOK * 768); const int tk = (int)(r / 768), col = (int)(r % 768);
        const float z = bf2f(h[(size_t)tk * HW + (dir ? H_FB : H_FF) + col]); const float lb = lbl[dir * DEPTH * 768 + col];
        const float s = 1.0f / (1.0f + expf(-z));
        FD[i] = lb + (1.0f - lb) * s; KY[i] = (1.0f - lb) * (1.0f - s);
    }
}
__device__ __forceinline__ void hgrn_scan_naive(const Ctx& X, const bf16* h, const float* FD, const float* KY, float* O  ) {
    LAS float* sf = (LAS float*)X.lds; LAS float* sk = sf + 512; LAS float* sq = sk + 512;
    for (int it = X.c; it < 6; it += X.G) {
        const int grp = X.tid >> 7, v = X.tid & 127, ch = it * 4 + grp;
        const int dir = ch / 12, b = (ch % 12) / 6, hd = ch % 6;
        float S[128];
#pragma unroll
        for (int k = 0; k < 128; ++k) S[k] = 0.f;
        for (int st = 0; st < SEQ; ++st) {
            const int t = dir ? (SEQ - 1 - st) : st; const size_t tk = (size_t)b * SEQ + t;
            const size_t e = ((size_t)dir * TOK + tk) * 768 + hd * 128 + v;
            const float f = FD[e], ky = KY[e], qv = bf2f(h[tk * HW + H_Q + hd * 128 + v]), vv = bf2f(h[tk * HW + H_I + hd * 128 + v]);
            __syncthreads();
            sf[X.tid] = f; sk[X.tid] = ky; sq[X.tid] = qv;
            __syncthreads();
            float o = 0.f;
            const LAS f32x4* pf = (const LAS f32x4*)(sf + grp * 128); const LAS f32x4* pk = (const LAS f32x4*)(sk + grp * 128); const LAS f32x4* pq = (const LAS f32x4*)(sq + grp * 128);
#pragma unroll
            for (int k4 = 0; k4 < 32; ++k4) { const f32x4 a = pf[k4], c = pk[k4], d = pq[k4];
#pragma unroll
                for (int e2 = 0; e2 < 4; ++e2) { S[k4 * 4 + e2] = a[e2] * S[k4 * 4 + e2] + c[e2] * vv; o += d[e2] * S[k4 * 4 + e2]; } }
            O[e] = o;
        }
    }
}
__device__ __forceinline__ void hgrn_combine_naive(const Ctx& X, const bf16* h, const float* O, const float* norm_g, bf16* yh) {
    for (int it = X.gw; it < TOK * 6; it += X.ngw) {
        const int tk = it / 6, hd = it % 6; const size_t e = (size_t)tk * 768 + hd * 128 + X.lane * 2;
        const f32x2 a = *(const f32x2*)(O + e), b = *(const f32x2*)(O + (size_t)TOK * 768 + e);
        const float o0 = a[0] + b[0], o1 = a[1] + b[1];
        const float ms = wave_sum(o0 * o0 + o1 * o1) * (1.0f / 128.0f); const float r = 1.0f / sqrtf(ms + 1e-6f);
        const unsigned gw = *(const unsigned*)(h + (size_t)tk * HW + H_G + hd * 128 + X.lane * 2); const float g0 = bflo(gw), g1 = bfhi(gw);
        const f32x2 ng = *(const f32x2*)(norm_g + hd * 128 + X.lane * 2);
        const float y0 = o0 * r * ng[0] * (g0 / (1.0f + expf(-g0))), y1 = o1 * r * ng[1] * (g1 / (1.0f + expf(-g1)));
        *(unsigned*)(yh + e) = pk2(y0, y1);
    }
}
__device__ __forceinline__ void fourier_reduce(const Ctx& X, const float* FP, bf16* yf) {
    for (int i = X.c * NTHR + X.tid; i < SEQ * 1024 / 4; i += X.G * NTHR) {
        const int k1 = i >> 8, c4 = (i & 255) * 4;
        f32x4 s = *(const f32x4*)(FP + (size_t)k1 * 1024 + c4);
#pragma unroll
        for (int ks = 1; ks < 4; ++ks) s = s + *(const f32x4*)(FP + (size_t)ks * SEQ * 1024 + (size_t)k1 * 1024 + c4);
        const int b = c4 >> 9, j = c4 & 511; u32x2 w; w.x = pk2(s[0], s[1]); w.y = pk2(s[2], s[3]);
        *(u32x2*)(yf + (size_t)(b * SEQ + k1) * 512 + j) = w;
    }
}
__device__ __forceinline__ void ln_phase(const Ctx& X, const float* vpre, const float* g, const float* b, float* xres, bf16* xa) {
    for (int m = X.gw; m < TOK; m += X.ngw) { float v[32]; load_row32(vpre + (size_t)m * DM, X.lane, v); ln_row(v, X.lane, g, b, xres + (size_t)m * DM, xa + (size_t)m * DM); }
}

__device__ __forceinline__ float dot2bf(unsigned w, unsigned x, float acc) { return __builtin_amdgcn_fdot2_f32_bf16(__builtin_bit_cast(bf16x2_t, w), __builtin_bit_cast(bf16x2_t, x), acc, false); }
template <int CTRL> __device__ __forceinline__ unsigned dpp_u(unsigned v) { return (unsigned)__builtin_amdgcn_update_dpp(0, (int)v, CTRL, 0xF, 0xF, true); }
__device__ __forceinline__ unsigned peer_key(float f, int idx) { unsigned u = __float_as_uint(f); u = (u & 0x80000000u) ? ~u : (u | 0x80000000u); return (u & ~127u) | (unsigned)(127 - idx); }
__device__ __forceinline__ float peer_unkey(unsigned k) { const unsigned u = k & ~127u; return (u & 0x80000000u) ? __uint_as_float(u & 0x7fffffffu) : __uint_as_float(~u); }
__device__ __forceinline__ int peer_stair(int s) {
    int i, base;
    if (s < 16) { i = 0; base = 0; } else if (s < 24) { i = 1; base = 16; } else if (s < 29) { i = 2; base = 24; } else if (s < 33) { i = 3; base = 29; } else if (s < 36) { i = 4; base = 33; }
    else if (s < 38) { i = 5; base = 36; } else if (s < 40) { i = 6; base = 38; } else if (s < 42) { i = 7; base = 40; } else { i = 8 + (s - 42); base = s; }
    i = i > 15 ? 15 : i; return (i << 4) | (s - base);
}
#define MFMA8(a, b, c) __builtin_amdgcn_mfma_f32_16x16x32_fp8_fp8((a), (b), (c), 0, 0, 0)
__device__ __forceinline__ long pack64(unsigned lo, unsigned hi) { return (long)(((unsigned long long)hi << 32) | lo); }
__device__ __forceinline__ float gelu_erf(float x) { return 0.5f * x * (1.0f + erff(x * 0.70710678118654752f)); }
__device__ __forceinline__ void peer_phase(const Ctx& X, const float* scores, const unsigned char* U8, const unsigned char* V8, const float* xres, float* xout, bf16* xa, const float* lng, const float* lnb,
                                           const float* Uf, const float* Vf, const float* Wq, const float* Kf) {
    const int lane = X.lane;
        LAS float* sc = (LAS float*)(X.lds + X.wave * 12288);
    LAS float* tops = sc + 2048;
    LAS int* topi = (LAS int*)(tops + 256);
    LAS int* le = topi + 256;
    LAS float* lg = (LAS float*)(le + 128);
    const float NEG = -3.0e38f;
    for (int tk = X.gw; tk < TOK; tk += X.ngw) {
        const float* srow = scores + (size_t)tk * 2048;
#if defined(PEER_NAIVE_SC)
        { (void)srow;
          float qa[32];
#pragma unroll
          for (int i = 0; i < 32; ++i) qa[i] = 0.f;
          for (int dm = 0; dm < DM; ++dm) { const float xv = xres[(size_t)tk * DM + dm];
#pragma unroll
              for (int i = 0; i < 32; ++i) qa[i] += xv * Wq[(size_t)dm * DM + i * 64 + lane]; }
#pragma unroll
          for (int i = 0; i < 32; ++i) sc[i * 64 + lane] = qa[i];
          LDS_WAIT();
          float sv[32];
#pragma unroll
          for (int r = 0; r < 16; ++r) { const int p = r & 1;
              float s0 = 0.f, s1 = 0.f;
              for (int d = 0; d < 128; ++d) { const float qv = sc[r * 128 + d]; s0 += qv * Kf[((size_t)p * 128 + lane) * 128 + d]; s1 += qv * Kf[((size_t)p * 128 + 64 + lane) * 128 + d]; }
              sv[2 * r] = s0; sv[2 * r + 1] = s1; }
          LDS_WAIT();
#pragma unroll
          for (int r = 0; r < 16; ++r) { sc[r * 128 + lane] = sv[2 * r]; sc[r * 128 + 64 + lane] = sv[2 * r + 1]; }
          LDS_WAIT(); }
#else
#pragma unroll
        for (int i = 0; i < 8; ++i) *(LAS f32x4*)(sc + i * 256 + lane * 4) = *(const f32x4*)(srow + i * 256 + lane * 4);
        LDS_WAIT();
#endif
        { const int l15 = lane & 15, q4 = lane >> 4;
#pragma unroll 1
          for (int pass = 0; pass < 4; ++pass) {
              const int r = pass * 4 + q4; unsigned kv[8];
#pragma unroll
              for (int j = 0; j < 8; ++j) kv[j] = peer_key(sc[r * 128 + l15 + 16 * j], l15 + 16 * j);
#pragma unroll
              for (int it = 0; it < 16; ++it) {
                  unsigned m = max(max(max(kv[0], kv[1]), max(kv[2], kv[3])), max(max(kv[4], kv[5]), max(kv[6], kv[7])));
                  m = max(m, dpp_u<0xB1>(m)); m = max(m, dpp_u<0x4E>(m)); m = max(m, dpp_u<0x141>(m)); m = max(m, dpp_u<0x140>(m));
#pragma unroll
                  for (int j = 0; j < 8; ++j) kv[j] = (kv[j] == m) ? 0u : kv[j];
                  if (l15 == 0) { tops[r * 16 + it] = peer_unkey(m); topi[r * 16 + it] = 127 - (int)(m & 127u); }
              }
          }
          LDS_WAIT();
#pragma unroll 1
          for (int pass = 0; pass < 2; ++pass) {
              const int hd = pass * 4 + q4; unsigned kv[4]; int ij[4];
#pragma unroll
              for (int jj = 0; jj < 4; ++jj) { const int s = l15 * 4 + jj; ij[jj] = peer_stair(s);
                  const float v = tops[(2 * hd) * 16 + (ij[jj] >> 4)] + tops[(2 * hd + 1) * 16 + (ij[jj] & 15)]; kv[jj] = (s < 50) ? peer_key(v, s) : 0u; }
              float bs = 0.f, M0 = 0.f; int bsl = 0;
#pragma unroll
              for (int it = 0; it < 16; ++it) {
                  unsigned m = max(max(kv[0], kv[1]), max(kv[2], kv[3]));
                  m = max(m, dpp_u<0xB1>(m)); m = max(m, dpp_u<0x4E>(m)); m = max(m, dpp_u<0x141>(m)); m = max(m, dpp_u<0x140>(m));
#pragma unroll
                  for (int jj = 0; jj < 4; ++jj) kv[jj] = (kv[jj] == m) ? 0u : kv[jj];
                  const float mv = peer_unkey(m); if (it == 0) M0 = mv;
                  if (l15 == it) { bs = mv; bsl = 127 - (int)(m & 127u); }
              }
              const float ex = __expf(bs - M0); float sum = ex; sum += dpp_f<0xB1>(sum); sum += dpp_f<0x4E>(sum); sum += dpp_f<0x141>(sum); sum += dpp_f<0x140>(sum);
              const int pr = peer_stair(bsl); const int i1 = topi[(2 * hd) * 16 + (pr >> 4)], i2 = topi[(2 * hd + 1) * 16 + (pr & 15)];
              le[hd * 16 + l15] = i1 * 128 + i2; lg[hd * 16 + l15] = ex / sum;
          } }
        LDS_WAIT();
        LAS unsigned char* xl8 = (LAS unsigned char*)sc; LAS float* hl = (LAS float*)(xl8 + 2048);
        { float xr[32]; load_row_t<2, 16>(xres + (size_t)tk * DM, lane, xr);
#pragma unroll
          for (int c = 0; c < 2; ++c) { u32x4 w;
              w.x = pk4_fp8(xr[c * 16 + 0] * PEER_XS, xr[c * 16 + 1] * PEER_XS, xr[c * 16 + 2] * PEER_XS, xr[c * 16 + 3] * PEER_XS); w.y = pk4_fp8(xr[c * 16 + 4] * PEER_XS, xr[c * 16 + 5] * PEER_XS, xr[c * 16 + 6] * PEER_XS, xr[c * 16 + 7] * PEER_XS);
              w.z = pk4_fp8(xr[c * 16 + 8] * PEER_XS, xr[c * 16 + 9] * PEER_XS, xr[c * 16 + 10] * PEER_XS, xr[c * 16 + 11] * PEER_XS); w.w = pk4_fp8(xr[c * 16 + 12] * PEER_XS, xr[c * 16 + 13] * PEER_XS, xr[c * 16 + 14] * PEER_XS, xr[c * 16 + 15] * PEER_XS);
              *(LAS u32x4*)(xl8 + c * 1024 + lane * 16) = w; } }
        LDS_WAIT();
        { const int l15 = lane & 15, q4 = lane >> 4;
#pragma unroll 1
          for (int eb = 0; eb < 8; ++eb) {
              const int e = le[eb * 16 + l15]; const unsigned char* rowp = U8 + (size_t)e * DM + 16 * q4; const LAS unsigned char* xb = xl8 + 16 * q4;
              f32x4 acc = (f32x4){0.f, 0.f, 0.f, 0.f};
              u32x4 A[2][8];
#pragma unroll
              for (int i = 0; i < 8; ++i) A[0][i] = *(const u32x4*)(rowp + 64 * i);
#pragma unroll
              for (int ch = 0; ch < 4; ++ch) {
                  if (ch < 3) {
#pragma unroll
                      for (int i = 0; i < 8; ++i) A[(ch + 1) & 1][i] = *(const u32x4*)(rowp + 64 * (8 * (ch + 1) + i)); }
#pragma unroll
                  for (int i = 0; i < 8; ++i) { const u32x4 a = A[ch & 1][i]; const u32x4 xv = *(const LAS u32x4*)(xb + 64 * (8 * ch + i));
                      acc = MFMA8(pack64(a.x, a.y), pack64(xv.x, xv.y), acc); acc = MFMA8(pack64(a.z, a.w), pack64(xv.z, xv.w), acc); } }
#pragma unroll
              for (int r = 0; r < 4; ++r) { const int idx = eb * 16 + 4 * q4 + r; const float hvv = gelu_erf(acc[r] * (1.0f / (PEER_US * PEER_XS))) * lg[idx] * (1.0f / PEER_VS); if (l15 == 0) hl[idx] = hvv; }
          } }
        LDS_WAIT();
        float y[32];
#pragma unroll
        for (int i = 0; i < 32; ++i) y[i] = 0.f;
        { u32x4 VB[2][4][2];
#define PEER_VLOAD(buf, g) do { _Pragma("unroll") for (int k = 0; k < 4; ++k) { const int e = __builtin_amdgcn_readfirstlane(le[(g) * 4 + k]); const unsigned char* vp = V8 + (size_t)e * DM + lane * 16; \
              VB[buf][k][0] = *(const u32x4*)vp; VB[buf][k][1] = *(const u32x4*)(vp + 1024); } } while (0)
#define PEER_VACC(buf, g) do { _Pragma("unroll") for (int k = 0; k < 4; ++k) { const float hv = hl[(g) * 4 + k]; _Pragma("unroll") for (int c = 0; c < 2; ++c) { const unsigned wd[4] = {VB[buf][k][c].x, VB[buf][k][c].y, VB[buf][k][c].z, VB[buf][k][c].w}; \
              _Pragma("unroll") for (int d = 0; d < 4; ++d) { const f32x2 lo = __builtin_amdgcn_cvt_pk_f32_fp8((int)wd[d], false), hi = __builtin_amdgcn_cvt_pk_f32_fp8((int)wd[d], true); \
                  y[c * 16 + 4 * d] += hv * lo[0]; y[c * 16 + 4 * d + 1] += hv * lo[1]; y[c * 16 + 4 * d + 2] += hv * hi[0]; y[c * 16 + 4 * d + 3] += hv * hi[1]; } } } } while (0)
          PEER_VLOAD(0, 0);
#pragma unroll 1
          for (int g = 0; g < 32; g += 2) { PEER_VLOAD(1, g + 1); PEER_VACC(0, g); if (g + 2 < 32) PEER_VLOAD(0, g + 2); PEER_VACC(1, g + 1); }
#undef PEER_VLOAD
#undef PEER_VACC
        }
        { float xr[32]; load_row_t<2, 16>(xres + (size_t)tk * DM, lane, xr);
#pragma unroll
          for (int i = 0; i < 32; ++i) y[i] += DN_ALPHA * xr[i]; }
        ln_row_t<2, 16>(y, lane, lng, lnb, xout + (size_t)tk * DM, xa + (size_t)tk * DM);
    }
}

typedef short bf16x8 __attribute__((ext_vector_type(8)));
#define MFMA16(a, b, c) __builtin_amdgcn_mfma_f32_16x16x32_bf16((a), (b), (c), 0, 0, 0)
constexpr size_t TAB_D = 1 * MiB;

__device__ __forceinline__ void hgrn_lf_key(float z, float lb, float& lf, float& key) {
    const float s = __builtin_amdgcn_rcpf(1.0f + __expf(-z));
    const float f = fmaxf(lb + (1.0f - lb) * s, 1e-30f);
    lf = __logf(f); key = (1.0f - lb) * (1.0f - s);
}
__device__ __forceinline__ void unpack8(const u32x4 w, float* o) { o[0] = bflo(w.x); o[1] = bfhi(w.x); o[2] = bflo(w.y); o[3] = bfhi(w.y); o[4] = bflo(w.z); o[5] = bfhi(w.z); o[6] = bflo(w.w); o[7] = bfhi(w.w); }
__device__ __forceinline__ u32x4 pack8(const float* v) { u32x4 w; w.x = pk2(v[0], v[1]); w.y = pk2(v[2], v[3]); w.z = pk2(v[4], v[5]); w.w = pk2(v[6], v[7]); return w; }

__device__ __forceinline__ void hgrn_cumsum(LAS float* LF, LAS float* SEG, int tid, int dir, float (&bl)[16], float& tot) {
    const int k = tid & 127, seg = tid >> 7; float run = 0.f;
    if (dir == 0) {
#pragma unroll
        for (int i = 0; i < 16; ++i) { run += LF[(16 * seg + i) * 128 + k]; bl[i] = run; }
    } else {
#pragma unroll
        for (int i = 15; i >= 0; --i) { run += LF[(16 * seg + i) * 128 + k]; bl[i] = run; }
    }
    SEG[seg * 128 + k] = run;
    __syncthreads();
    float off = 0.f; tot = 0.f;
#pragma unroll
    for (int s2 = 0; s2 < 4; ++s2) { const float sv = SEG[s2 * 128 + k]; tot += sv; if (dir == 0 ? (s2 < seg) : (s2 > seg)) off += sv; }
#pragma unroll
    for (int i = 0; i < 16; ++i) bl[i] += off;
}

__device__ __forceinline__ void hgrn_pass1(const Ctx& X, const bf16* h, const float* lbl, float* L, float* Dd) {
    LAS float* LF = (LAS float*)X.lds; LAS float* KYf = LF + 8192; LAS float* SEG = KYf + 8192;
    LAS bf16* VR = (LAS bf16*)(X.lds + 67584); LAS bf16* KT = (LAS bf16*)(X.lds + 83968); LAS bf16* VT = (LAS bf16*)(X.lds + 102400);
    const int tid = X.tid, lane = X.lane, q4 = lane >> 4, l15 = lane & 15;
    for (int u = X.c; u < 1536; u += X.G) {
        const int dir = u / 768, rem = u % 768, bh = rem >> 6, c = rem & 63, b = bh / 6, hd = bh % 6; const size_t tok0 = (size_t)b * SEQ + 64 * c;
        __syncthreads();
        { const int t = tid >> 3, kc = (tid & 7) * 16;
          const bf16* zr = h + (tok0 + t) * HW + (dir ? H_FB : H_FF) + hd * 128 + kc; const bf16* vr = h + (tok0 + t) * HW + H_I + hd * 128 + kc;
          const u32x4 z0 = *(const u32x4*)zr, z1 = *(const u32x4*)(zr + 8), v0 = *(const u32x4*)vr, v1 = *(const u32x4*)(vr + 8);
          float z[16]; unpack8(z0, z); unpack8(z1, z + 8);
          const float* lbp = lbl + dir * DEPTH * 768 + hd * 128 + kc;
          float lf[16], ky[16];
#pragma unroll
          for (int j = 0; j < 16; ++j) hgrn_lf_key(z[j], lbp[j], lf[j], ky[j]);
#pragma unroll
          for (int j = 0; j < 4; ++j) { *(LAS f32x4*)(LF + t * 128 + kc + 4 * j) = (f32x4){lf[4 * j], lf[4 * j + 1], lf[4 * j + 2], lf[4 * j + 3]};
              *(LAS f32x4*)(KYf + t * 128 + kc + 4 * j) = (f32x4){ky[4 * j], ky[4 * j + 1], ky[4 * j + 2], ky[4 * j + 3]}; }
          *(LAS u32x4*)(VR + t * 128 + kc) = v0; *(LAS u32x4*)(VR + t * 128 + kc + 8) = v1; }
        __syncthreads();
        float bl[16], tot; hgrn_cumsum(LF, SEG, tid, dir, bl, tot);
        { const int k = tid & 127, seg = tid >> 7; float kh[16];
#pragma unroll
          for (int i = 0; i < 16; ++i) kh[i] = KYf[(16 * seg + i) * 128 + k] * __expf(tot - bl[i]);
          *(LAS u32x4*)(KT + k * 72 + 16 * seg) = pack8(kh); *(LAS u32x4*)(KT + k * 72 + 16 * seg + 8) = pack8(kh + 8);
          if (seg == 0) Dd[(size_t)u * 128 + k] = __expf(tot);
          unsigned short vv[16];
#pragma unroll
          for (int i = 0; i < 16; ++i) vv[i] = VR[(16 * seg + i) * 128 + k];
          u32x4 w0, w1; w0.x = vv[0] | (vv[1] << 16); w0.y = vv[2] | (vv[3] << 16); w0.z = vv[4] | (vv[5] << 16); w0.w = vv[6] | (vv[7] << 16);
          w1.x = vv[8] | (vv[9] << 16); w1.y = vv[10] | (vv[11] << 16); w1.z = vv[12] | (vv[13] << 16); w1.w = vv[14] | (vv[15] << 16);
          *(LAS u32x4*)(VT + k * 72 + 16 * seg) = w0; *(LAS u32x4*)(VT + k * 72 + 16 * seg + 8) = w1; }
        __syncthreads();
        const int mb0 = (X.wave & 3) * 2, nb0 = (X.wave >> 2) * 4;
        f32x4 acc[2][4];
#pragma unroll
        for (int mi = 0; mi < 2; ++mi)
#pragma unroll
            for (int ni = 0; ni < 4; ++ni) acc[mi][ni] = (f32x4){0.f, 0.f, 0.f, 0.f};
#pragma unroll
        for (int ks = 0; ks < 2; ++ks) {
            bf16x8 a[2], bb[4];
#pragma unroll
            for (int mi = 0; mi < 2; ++mi) a[mi] = *(const LAS bf16x8*)(KT + ((mb0 + mi) * 16 + l15) * 72 + ks * 32 + 8 * q4);
#pragma unroll
            for (int ni = 0; ni < 4; ++ni) bb[ni] = *(const LAS bf16x8*)(VT + ((nb0 + ni) * 16 + l15) * 72 + ks * 32 + 8 * q4);
#pragma unroll
            for (int mi = 0; mi < 2; ++mi)
#pragma unroll
                for (int ni = 0; ni < 4; ++ni) acc[mi][ni] = MFMA16(a[mi], bb[ni], acc[mi][ni]);
        }
        float* Lu = L + (size_t)u * 16384;
#pragma unroll
        for (int mi = 0; mi < 2; ++mi)
#pragma unroll
            for (int ni = 0; ni < 4; ++ni) *(f32x4*)(Lu + ((nb0 + ni) * 16 + l15) * 128 + (mb0 + mi) * 16 + 4 * q4) = acc[mi][ni];
    }
}
__device__ __forceinline__ void hgrn_pass2(const Ctx& X, const float* L, const float* Dd, bf16* Sp) {
    for (int i = X.c * NTHR + X.tid; i < 24 * 16384; i += X.G * NTHR) {
        const int chain = i >> 14, e = i & 16383, k = e & 127, dir = chain / 12, bh = chain % 12;
        float s0 = 0.f;
#pragma unroll 16
        for (int j = 0; j < 64; ++j) { const int c = dir ? 63 - j : j; const size_t u = (size_t)(dir * 12 + bh) * 64 + c;
            Sp[u * 16384 + e] = (bf16)f2bf(s0);
            s0 = Dd[u * 128 + k] * s0 + L[u * 16384 + e]; }
    }
}
__device__ __forceinline__ void hgrn_pass3(const Ctx& X, const bf16* h, const float* lbl, const bf16* Sp, const float* norm_g, bf16* yh) {
    LAS unsigned char* R1 = (LAS unsigned char*)X.lds;
    LAS float* LF = (LAS float*)R1; LAS bf16* VR = (LAS bf16*)R1; LAS bf16* ST = (LAS bf16*)R1;
    LAS bf16* VT = (LAS bf16*)(X.lds + 34816); LAS bf16* QT1 = (LAS bf16*)(X.lds + 53248); LAS bf16* KT1 = (LAS bf16*)(X.lds + 70656); LAS bf16* QT2 = (LAS bf16*)(X.lds + 88064);
    LAS bf16* PM = (LAS bf16*)(X.lds + 105472); LAS float* SEG = (LAS float*)(X.lds + 114688); LAS float* RR = (LAS float*)(X.lds + 116736); LAS float* SS = (LAS float*)(X.lds + 117248);
    const int tid = X.tid, lane = X.lane, q4 = lane >> 4, l15 = lane & 15, w = X.wave;
    for (int u = X.c; u < 768; u += X.G) {
        const int bh = u >> 6, c = u & 63, b = bh / 6, hd = bh % 6; const size_t tok0 = (size_t)b * SEQ + 64 * c;
        __syncthreads();
        { const int t = tid >> 3, kc = (tid & 7) * 16; const bf16* vr = h + (tok0 + t) * HW + H_I + hd * 128 + kc;
          *(LAS u32x4*)(VR + t * 128 + kc) = *(const u32x4*)vr; *(LAS u32x4*)(VR + t * 128 + kc + 8) = *(const u32x4*)(vr + 8); }
        __syncthreads();
        { const int v = tid & 127, seg = tid >> 7; unsigned short vv[16];
#pragma unroll
          for (int i = 0; i < 16; ++i) vv[i] = VR[(16 * seg + i) * 128 + v];
          u32x4 w0, w1; w0.x = vv[0] | (vv[1] << 16); w0.y = vv[2] | (vv[3] << 16); w0.z = vv[4] | (vv[5] << 16); w0.w = vv[6] | (vv[7] << 16);
          w1.x = vv[8] | (vv[9] << 16); w1.y = vv[10] | (vv[11] << 16); w1.z = vv[12] | (vv[13] << 16); w1.w = vv[14] | (vv[15] << 16);
          *(LAS u32x4*)(VT + v * 72 + 16 * seg) = w0; *(LAS u32x4*)(VT + v * 72 + 16 * seg + 8) = w1; }
        f32x4 acc[4];
#pragma unroll
        for (int ni = 0; ni < 4; ++ni) acc[ni] = (f32x4){0.f, 0.f, 0.f, 0.f};
        const int tb = w & 3;
#pragma unroll 1
        for (int dir = 0; dir < 2; ++dir) {
            __syncthreads();
            const int t = tid >> 3, kc = (tid & 7) * 16;
            float ky[16], qv[16];
            { const bf16* zr = h + (tok0 + t) * HW + (dir ? H_FB : H_FF) + hd * 128 + kc; const bf16* qr = h + (tok0 + t) * HW + H_Q + hd * 128 + kc;
              const u32x4 z0 = *(const u32x4*)zr, z1 = *(const u32x4*)(zr + 8), q0 = *(const u32x4*)qr, q1 = *(const u32x4*)(qr + 8);
              float z[16]; unpack8(z0, z); unpack8(z1, z + 8); unpack8(q0, qv); unpack8(q1, qv + 8);
              const float* lbp = lbl + dir * DEPTH * 768 + hd * 128 + kc; float lf[16];
#pragma unroll
              for (int j = 0; j < 16; ++j) hgrn_lf_key(z[j], lbp[j], lf[j], ky[j]);
#pragma unroll
              for (int j = 0; j < 4; ++j) *(LAS f32x4*)(LF + t * 128 + kc + 4 * j) = (f32x4){lf[4 * j], lf[4 * j + 1], lf[4 * j + 2], lf[4 * j + 3]}; }
            const size_t us = (size_t)(dir * 12 + bh) * 64 + c; u32x4 sreg[4];
#pragma unroll
            for (int i = 0; i < 4; ++i) sreg[i] = *(const u32x4*)(Sp + us * 16384 + (size_t)(tid + NTHR * i) * 8);
            __syncthreads();
            { float bl[16], tot; hgrn_cumsum(LF, SEG, tid, dir, bl, tot);
              const int k = tid & 127, seg = tid >> 7;
#pragma unroll
              for (int i = 0; i < 16; ++i) LF[(16 * seg + i) * 128 + k] = bl[i];
              if (dir == 0 ? (seg == 1) : (seg == 2)) RR[k] = dir == 0 ? bl[15] : bl[0]; }
            __syncthreads();
            { float q1[16], k1[16], q2[16];
#pragma unroll
              for (int j = 0; j < 16; ++j) { const float bt = LF[t * 128 + kc + j], r = RR[kc + j];
                  q1[j] = qv[j] * __expf(bt - r); k1[j] = ky[j] * __expf(r - bt); q2[j] = qv[j] * __expf(bt); }
              *(LAS u32x4*)(QT1 + t * 136 + kc) = pack8(q1); *(LAS u32x4*)(QT1 + t * 136 + kc + 8) = pack8(q1 + 8);
              *(LAS u32x4*)(KT1 + t * 136 + kc) = pack8(k1); *(LAS u32x4*)(KT1 + t * 136 + kc + 8) = pack8(k1 + 8);
              *(LAS u32x4*)(QT2 + t * 136 + kc) = pack8(q2); *(LAS u32x4*)(QT2 + t * 136 + kc + 8) = pack8(q2 + 8); }
            __syncthreads();
#pragma unroll
            for (int i = 0; i < 4; ++i) { const int idx = tid + NTHR * i, v = idx >> 4, k8 = (idx & 15) * 8; *(LAS u32x4*)(ST + v * 136 + k8) = sreg[i]; }
            { const int sb0 = (w >> 2) * 2; f32x4 pa[2] = {(f32x4){0.f, 0.f, 0.f, 0.f}, (f32x4){0.f, 0.f, 0.f, 0.f}};
#pragma unroll
              for (int ks = 0; ks < 4; ++ks) { const bf16x8 a = *(const LAS bf16x8*)(QT1 + (tb * 16 + l15) * 136 + ks * 32 + 8 * q4);
#pragma unroll
                  for (int si = 0; si < 2; ++si) { const bf16x8 bb = *(const LAS bf16x8*)(KT1 + ((sb0 + si) * 16 + l15) * 136 + ks * 32 + 8 * q4); pa[si] = MFMA16(a, bb, pa[si]); } }
#pragma unroll
              for (int si = 0; si < 2; ++si) { const int s = (sb0 + si) * 16 + l15;
#pragma unroll
                  for (int r = 0; r < 4; ++r) { const int tt = tb * 16 + 4 * q4 + r; const bool keep = dir == 0 ? (s <= tt) : (s >= tt);
                      PM[tt * 72 + s] = (bf16)f2bf(keep ? pa[si][r] : 0.f); } } }
            __syncthreads();
            { const int vb0 = (w >> 2) * 4;
#pragma unroll
              for (int ks = 0; ks < 4; ++ks) { const bf16x8 a = *(const LAS bf16x8*)(QT2 + (tb * 16 + l15) * 136 + ks * 32 + 8 * q4);
#pragma unroll
                  for (int ni = 0; ni < 4; ++ni) { const bf16x8 bb = *(const LAS bf16x8*)(ST + ((vb0 + ni) * 16 + l15) * 136 + ks * 32 + 8 * q4); acc[ni] = MFMA16(a, bb, acc[ni]); } }
#pragma unroll
              for (int ks = 0; ks < 2; ++ks) { const bf16x8 a = *(const LAS bf16x8*)(PM + (tb * 16 + l15) * 72 + ks * 32 + 8 * q4);
#pragma unroll
                  for (int ni = 0; ni < 4; ++ni) { const bf16x8 bb = *(const LAS bf16x8*)(VT + ((vb0 + ni) * 16 + l15) * 72 + ks * 32 + 8 * q4); acc[ni] = MFMA16(a, bb, acc[ni]); } } }
        }
        { const int vb0 = (w >> 2) * 4; float ss[4];
#pragma unroll
          for (int r = 0; r < 4; ++r) { float s = 0.f;
#pragma unroll
              for (int ni = 0; ni < 4; ++ni) s += acc[ni][r] * acc[ni][r];
              s += dpp_f<0xB1>(s); s += dpp_f<0x4E>(s); s += dpp_f<0x141>(s); s += dpp_f<0x140>(s);
              ss[r] = s; }
          if (l15 == 0) {
#pragma unroll
              for (int r = 0; r < 4; ++r) SS[(tb * 16 + 4 * q4 + r) * 2 + (w >> 2)] = ss[r]; }
          __syncthreads();
#pragma unroll
          for (int r = 0; r < 4; ++r) { const int tt = tb * 16 + 4 * q4 + r; const float tot = SS[tt * 2] + SS[tt * 2 + 1]; const float rn = 1.0f / sqrtf(tot * (1.0f / 128.0f) + 1e-6f);
#pragma unroll
              for (int ni = 0; ni < 4; ++ni) { const int v = (vb0 + ni) * 16 + l15; const float g = bf2f(h[(tok0 + tt) * HW + H_G + hd * 128 + v]);
                  const float y = acc[ni][r] * rn * norm_g[hd * 128 + v] * (g * __builtin_amdgcn_rcpf(1.0f + __expf(-g)));
                  yh[(tok0 + tt) * 768 + hd * 128 + v] = (bf16)f2bf(y); } } }
    }
}

constexpr size_t WS_AO = 944 * MiB, WS_LSE = 968 * MiB, WS_END2 = 969 * MiB;
__device__ __forceinline__ void rope16(float* t1, float* t2, const float* rc, const float* rs, int p) {
    const f32x4 c0 = *(const f32x4*)(rc + p * 8), c1 = *(const f32x4*)(rc + p * 8 + 4), s0 = *(const f32x4*)(rs + p * 8), s1 = *(const f32x4*)(rs + p * 8 + 4);
#pragma unroll
    for (int i = 0; i < 8; ++i) { const float c = i < 4 ? c0[i] : c1[i - 4], s = i < 4 ? s0[i] : s1[i - 4], a = t1[i], b = t2[i]; t1[i] = a * c - b * s; t2[i] = b * c + a * s; }
}
__device__ __forceinline__ void attn_fast(const Ctx& X, const bf16* h, const float* rc, const float* rs, float* AO, float* LSE) {
    LAS bf16* KL = (LAS bf16*)X.lds; LAS bf16* VL = KL + 256 * 72; LAS bf16* QL = VL + 256 * 72;
    const int tid = X.tid, lane = X.lane, q4 = lane >> 4, l15 = lane & 15, w = X.wave;
    for (int u = X.c; u < 768; u += X.G) {
        const int b = u / 384, head = (u % 384) >> 5, blk = u & 31, g = head >> 2, dsh = 2 * g, dil = 1 << dsh, Lsub = SEQ >> dsh, nblk = Lsub >> 7;
        const int cls = blk / nblk, m0 = (blk % nblk) * 128;
        const bf16* hb = h + (size_t)b * SEQ * HW;
        __syncthreads();
#pragma unroll
        for (int rep = 0; rep < 2; ++rep) {
            const int row = (tid >> 2) + 128 * rep, qt = tid & 3, m = m0 - 64 + row; const bool ok = (m >= 0) && (m < Lsub); const int p = ok ? m * dil + cls : 0;
            const bf16* kr = hb + (size_t)p * HW + H_KA + head * 64 + qt * 16; const bf16* vr = hb + (size_t)p * HW + H_VA + head * 64 + qt * 16;
            u32x4 k0 = *(const u32x4*)kr, k1 = *(const u32x4*)(kr + 8), v0 = *(const u32x4*)vr, v1 = *(const u32x4*)(vr + 8);
            if (qt == 0) { float t1[8], t2[8]; unpack8(k0, t1); unpack8(k1, t2); rope16(t1, t2, rc, rs, p); k0 = pack8(t1); k1 = pack8(t2); }
            if (!ok) { k0 = (u32x4){0u, 0u, 0u, 0u}; k1 = k0; v0 = k0; v1 = k0; }
            *(LAS u32x4*)(KL + row * 72 + qt * 16) = k0; *(LAS u32x4*)(KL + row * 72 + qt * 16 + 8) = k1;
            *(LAS u32x4*)(VL + row * 72 + qt * 16) = v0; *(LAS u32x4*)(VL + row * 72 + qt * 16 + 8) = v1;
        }
        { const int row = tid >> 2, qt = tid & 3, p = (m0 + row) * dil + cls; const bf16* qr = hb + (size_t)p * HW + H_QA + head * 64 + qt * 16;
          const u32x4 q0 = *(const u32x4*)qr, q1 = *(const u32x4*)(qr + 8); float t1[8], t2[8]; unpack8(q0, t1); unpack8(q1, t2);
          if (qt == 0) rope16(t1, t2, rc, rs, p);
#pragma unroll
          for (int i = 0; i < 8; ++i) { t1[i] *= 0.125f; t2[i] *= 0.125f; }
          *(LAS u32x4*)(QL + row * 72 + qt * 16) = pack8(t1); *(LAS u32x4*)(QL + row * 72 + qt * 16 + 8) = pack8(t2); }
        __syncthreads();
        bf16x8 qf[2];
#pragma unroll
        for (int ks = 0; ks < 2; ++ks) qf[ks] = *(const LAS bf16x8*)(QL + (16 * w + l15) * 72 + ks * 32 + 8 * q4);
        f32x4 sa[9];
#pragma unroll
        for (int kb = 0; kb < 9; ++kb) { sa[kb] = (f32x4){0.f, 0.f, 0.f, 0.f};
#pragma unroll
            for (int ks = 0; ks < 2; ++ks) { const bf16x8 a = *(const LAS bf16x8*)(KL + (16 * w + 16 * kb + l15) * 72 + ks * 32 + 8 * q4); sa[kb] = MFMA16(a, qf[ks], sa[kb]); } }
        float mx = -1e30f;
#pragma unroll
        for (int kb = 0; kb < 9; ++kb)
#pragma unroll
            for (int r = 0; r < 4; ++r) { const int j = 16 * kb + 4 * q4 + r, d = j - 64 - l15, km = m0 - 64 + 16 * w + j; const bool ok = (d >= -64) && (d <= 64) && (km >= 0) && (km < Lsub);
                sa[kb][r] = ok ? sa[kb][r] : -1e30f; mx = fmaxf(mx, sa[kb][r]); }
        mx = fmaxf(mx, __shfl_xor(mx, 16)); mx = fmaxf(mx, __shfl_xor(mx, 32));
        float lsum = 0.f;
#pragma unroll
        for (int kb = 0; kb < 9; ++kb)
#pragma unroll
            for (int r = 0; r < 4; ++r) { const float pv = __expf(sa[kb][r] - mx); sa[kb][r] = pv; lsum += pv; }
        lsum += __shfl_xor(lsum, 16); lsum += __shfl_xor(lsum, 32);
        f32x4 oa[4];
#pragma unroll
        for (int db = 0; db < 4; ++db) oa[db] = (f32x4){0.f, 0.f, 0.f, 0.f};
#pragma unroll
        for (int kp = 0; kp < 5; ++kp) {
            u32x4 pw; pw.x = pk2(sa[2 * kp][0], sa[2 * kp][1]); pw.y = pk2(sa[2 * kp][2], sa[2 * kp][3]);
            if (kp < 4) { pw.z = pk2(sa[2 * kp + 1][0], sa[2 * kp + 1][1]); pw.w = pk2(sa[2 * kp + 1][2], sa[2 * kp + 1][3]); } else { pw.z = 0u; pw.w = 0u; }
            const bf16x8 pb = __builtin_bit_cast(bf16x8, pw);
            int rows[8];
#pragma unroll
            for (int jj = 0; jj < 8; ++jj) { int R = 16 * w + 16 * (2 * kp + (jj >> 2)) + 4 * q4 + (jj & 3); rows[jj] = R > 255 ? 255 : R; }
#pragma unroll
            for (int db = 0; db < 4; ++db) { bf16x8 va;
#pragma unroll
                for (int jj = 0; jj < 8; ++jj) va[jj] = (short)VL[rows[jj] * 72 + 16 * db + l15];
                oa[db] = MFMA16(va, pb, oa[db]); }
        }
        const float il = 1.0f / lsum; const size_t tok = (size_t)b * SEQ + (size_t)(m0 + 16 * w + l15) * dil + cls;
#pragma unroll
        for (int db = 0; db < 4; ++db) *(f32x4*)(AO + tok * 768 + head * 64 + 16 * db + 4 * q4) = oa[db] * il;
        if (q4 == 0) LSE[tok * 12 + head] = mx + __logf(lsum);
    }
}
__device__ __forceinline__ void attn_merge(const Ctx& X, const float* AO, const float* LSE, bf16* ya) {
    for (int i = X.c * NTHR + X.tid; i < TOK * 64; i += X.G * NTHR) {
        const int tk = i >> 6, hh = (i >> 4) & 3, d4 = (i & 15) * 4;
        const float l0 = LSE[(size_t)tk * 12 + hh], l1 = LSE[(size_t)tk * 12 + 4 + hh], l2 = LSE[(size_t)tk * 12 + 8 + hh];
        const float m = fmaxf(l0, fmaxf(l1, l2)), e0 = __expf(l0 - m), e1 = __expf(l1 - m), e2 = __expf(l2 - m), inv = 1.0f / (e0 + e1 + e2);
        const float* ap = AO + (size_t)tk * 768 + hh * 64 + d4;
        const f32x4 o = (*(const f32x4*)ap * e0 + *(const f32x4*)(ap + 256) * e1 + *(const f32x4*)(ap + 512) * e2) * inv;
        u32x2 wv; wv.x = pk2(o[0], o[1]); wv.y = pk2(o[2], o[3]); *(u32x2*)(ya + (size_t)tk * 256 + hh * 64 + d4) = wv;
    }
}

#ifndef MK_ONE_LAUNCH
#define MK_ONE_LAUNCH 1
#endif
constexpr int N_PHASES = 2 + 9 * DEPTH;
#ifndef PROBE_REP
#define PROBE_REP 0
#endif
#define NREP(grp) ((PROBE_REP == (grp) && l == 0) ? 2 : 1)
#define NREPG(grp) (((PROBE_REP == (grp) || PROBE_REP == 1) && l == 0) ? 2 : 1)
__device__ __forceinline__ bool fresh(Ctx& X) { asm volatile("" : "+v"(X.tid), "+v"(X.lane)); return true; }

#if defined(CHECK_BRANCHES)
constexpr size_t WS_YA2 = 969 * MiB, WS_YH2 = 973 * MiB;
__device__ __forceinline__ void cmp_bf16(const Ctx& X, const bf16* a, const bf16* ref, size_t n, float* cnt) {
    float d2 = 0.f, r2 = 0.f;
    for (size_t i = (size_t)X.c * NTHR + X.tid; i < n; i += (size_t)X.G * NTHR) { const float x = bf2f(a[i]), y = bf2f(ref[i]); d2 += (x - y) * (x - y); r2 += y * y; }
    d2 = wave_sum(d2); r2 = wave_sum(r2);
    if (X.lane == 0) { atomicAdd(cnt, d2); atomicAdd(cnt + 1, r2); }
}
#endif
struct Args { const float* in[18]; float* out; unsigned char* ws; int ph_lo, ph_hi; };
typedef pg8::bf16_t pbf;

__global__ void __launch_bounds__(NTHR, 2) fwd_kernel(Args args) {
    extern __shared__ __attribute__((aligned(16))) unsigned char lds[];
    cg::grid_group grid = cg::this_grid();
    Ctx X; X.lds = lds; X.tid = threadIdx.x; X.lane = X.tid & 63; X.wave = __builtin_amdgcn_readfirstlane(X.tid >> 6);
    X.G = gridDim.x; X.c = blockIdx.x; X.gw = X.c * NWAVES + X.wave; X.ngw = X.G * NWAVES;
    unsigned char* ws = args.ws; float* out = args.out;
    LAS unsigned char* ldsl = (LAS unsigned char*)lds;
    const int lo = args.ph_lo, hi = args.ph_hi;
#define IN(k) (lo <= (k) && (k) < hi && fresh(X))
#define INR(k) (lo <= (k) && (k) < hi)
#define SEAM(k) do { if (INR(k) && INR((k) + 1)) { if ((k) == 0) grid.sync(); else xcd_barrier(bar); } else __syncthreads(); } while (0)
    volatile LAS unsigned* MISC = (volatile LAS unsigned*)(ldsl + 131072);
    if (X.tid < 16) MISC[X.tid] = 0u;
    __syncthreads();
    XcdBarrier bar = xcd_barrier_post((unsigned*)(ws + 8192), MISC + 8);

    #ifndef SKIP_P0
    if (IN(0)) { prologue(X, args.in, out, ws); if (PROBE_REP == 4) { __syncthreads(); prologue(X, args.in, out, ws); } SEAM(0); }
#endif

    if (IN(1)) {
        const int G = X.G;
        for (int l = 0; l < DEPTH; ++l) {
            unsigned char* wl = ws + WS_WL0 + (size_t)l * WL_STRIDE;
            { pg8::Gemm g{(const pbf*)(ws + WS_CST), (const pbf*)(ws + WS_WFB) + (size_t)l * DM * 512, 1024, DM, 512, 512, 512}; pg8::StaticOrder S; S.init(1024, DM, G, (X.c + G - 32 * l) % G);
              pg8::EpiBf16<0> E{(pbf*)(wl + WL_WF), DM, nullptr, 0, 0, 1.f};
              pg8::gemm_phase<pg8::EpiBf16<0>, pg8::StaticOrder, false, true>(ldsl, g, S, E); }
        }
        for (int uid = (X.c + G - 64 % G) % G; uid < 128; uid += G) {
            const int lh = uid >> 3, l = lh >> 3, hd = lh & 7, pn = uid & 7; unsigned char* wl = ws + WS_WL0 + (size_t)l * WL_STRIDE;
            pg8::Gemm g{(const pbf*)(ws + WS_KD2) + (size_t)l * 256 * 256, (const pbf*)(ws + WS_WQB) + (size_t)l * DM * DM + hd * 256, 256, DM, 256, 256, DM}; pg8::OneUnit S{0, pn};
            pg8::EpiBf16<0> E{(pbf*)(wl + WL_WS) + (size_t)hd * 256 * DM, DM, nullptr, 0, 0, 1.f};
            pg8::gemm_phase<pg8::EpiBf16<0>, pg8::OneUnit, false, true>(ldsl, g, S, E); }
        SEAM(1);
    }
    const float* ropec = (const float*)(ws + WS_TAB); const float* ropes = (const float*)(ws + WS_TAB + TAB_SIN); const float* lbt = (const float*)(ws + WS_TAB + TAB_LB);
    pbf* XA = (pbf*)(ws + WS_XA); pbf* Hb = (pbf*)(ws + WS_H); pbf* PT = (pbf*)(ws + WS_PT); float* FP = (float*)(ws + WS_FP);
    pbf* YF = (pbf*)(ws + WS_YF); pbf* YH = (pbf*)(ws + WS_YH); pbf* YA = (pbf*)(ws + WS_YA);
    float* MACC = (float*)(ws + WS_MACC); pbf* MERGED = (pbf*)(ws + WS_MERGED); float* VPRE = (float*)(ws + WS_VPRE); float* SC = (float*)(ws + WS_SC);
    float* FD = (float*)(ws + WS_LB); float* KY = FD + (size_t)2 * TOK * 768; float* OH = (float*)(ws + WS_SB);

    for (int l = 0; l < DEPTH; ++l) {
        const int pb = 2 + 9 * l;
        unsigned char* wl = ws + WS_WL0 + (size_t)l * WL_STRIDE;
        pbf* WinT = (pbf*)(wl + WL_WIN); pbf* WfT = (pbf*)(wl + WL_WF); pbf* BRF = (pbf*)(wl + WL_BRF); pbf* BRH = (pbf*)(wl + WL_BRH); pbf* BRA = (pbf*)(wl + WL_BRA);
        pbf* WoutT = (pbf*)(wl + WL_OUT); pbf* WsT = (pbf*)(wl + WL_WS); const unsigned char* Ub = wl + WL_U; const unsigned char* Vb = wl + WL_V;
        if (IN(pb + 0)) { for (int rep = 0; rep < NREPG(11); ++rep) {
#ifndef SKIP_G1
            { pg8::Gemm g{XA, WinT, TOK, HW, DM, DM, DM}; pg8::StaticOrder S; S.init(TOK, HW, X.G, X.c); pg8::EpiBf16<0> E{Hb, HW, nullptr, 0, 0, 1.f};
              pg8::gemm_phase<pg8::EpiBf16<0>, pg8::StaticOrder, true, true>(ldsl, g, S, E); }
#endif
#ifndef SKIP_G2
            { pg8::Gemm g{WfT, XA, 1024, TOK, DM, DM, DM}; pg8::StaticOrder S; S.init(1024, TOK, X.G, X.c); pg8::EpiPT E{PT};
              pg8::gemm_phase<pg8::EpiPT, pg8::StaticOrder, true, true>(ldsl, g, S, E); }
#endif
            }
            SEAM(pb + 0);
        }
        if (IN(pb + 1)) {
            for (int rep = 0; rep < NREPG(12); ++rep) {
#ifndef SKIP_G3
            for (int it = X.c; it < 256; it += X.G) { const int ks = it >> 6, tile = it & 63;
                pg8::Gemm g{(const pbf*)(ws + WS_F) + ks * 2048, PT + ks * 2048, SEQ, 1024, 2048, 8192, 8192}; pg8::OneUnit S{tile >> 2, tile & 3}; pg8::EpiF32 E{FP + (size_t)ks * SEQ * 1024, 1024};
                pg8::gemm_phase<pg8::EpiF32, pg8::OneUnit, false, true>(ldsl, g, S, E); }
#endif
            }
            __syncthreads();
            for (int rep = 0; rep < NREP(5); ++rep) {
#if defined(ATTN_NAIVE)
            attn_naive(X, Hb, ropec, ropes, YA);
#else
            attn_fast(X, Hb, ropec, ropes, (float*)(ws + WS_AO), (float*)(ws + WS_LSE));
#if defined(CHECK_BRANCHES)
            __syncthreads(); attn_naive(X, Hb, ropec, ropes, (pbf*)(ws + WS_YA2));
#endif
#endif
            __syncthreads(); }
            for (int rep = 0; rep < NREP(6); ++rep) {
#if defined(HGRN_NAIVE)
            hgrn_prep_naive(X, Hb, lbt + l * 768, FD, KY);
#else
            __syncthreads();
            hgrn_pass1(X, Hb, lbt + l * 768, FD, (float*)(ws + WS_TAB + TAB_D));
#endif
            __syncthreads(); }
            SEAM(pb + 1);
        }
        if (IN(pb + 2)) { for (int rep = 0; rep < NREP(7); ++rep) {
#if defined(HGRN_NAIVE)
            hgrn_scan_naive(X, Hb, FD, KY, OH);
#else
            hgrn_pass2(X, FD, (const float*)(ws + WS_TAB + TAB_D), (pbf*)(ws + WS_SB));
#endif
            fourier_reduce(X, FP, YF);
#if !defined(ATTN_NAIVE)
            attn_merge(X, (const float*)(ws + WS_AO), (const float*)(ws + WS_LSE), YA);
#endif
            }
#if defined(CHECK_BRANCHES)
            grid.sync(); cmp_bf16(X, YA, (const pbf*)(ws + WS_YA2), (size_t)TOK * 256, (float*)ws);
#endif
            SEAM(pb + 2); }
        if (IN(pb + 3)) { for (int rep = 0; rep < NREP(8); ++rep) {
#if defined(HGRN_NAIVE)
            hgrn_combine_naive(X, Hb, OH, args.in[9] + (size_t)l * 768, YH);
#else
            hgrn_pass3(X, Hb, lbt + l * 768, (const pbf*)(ws + WS_SB), args.in[9] + (size_t)l * 768, YH);
#if defined(CHECK_BRANCHES)
            grid.sync(); hgrn_prep_naive(X, Hb, lbt + l * 768, FD, KY);
            grid.sync(); hgrn_scan_naive(X, Hb, FD, KY, OH);
            grid.sync(); hgrn_combine_naive(X, Hb, OH, args.in[9] + (size_t)l * 768, (pbf*)(ws + WS_YH2));
            grid.sync(); cmp_bf16(X, YH, (const pbf*)(ws + WS_YH2), (size_t)TOK * 768, (float*)ws + 2);
#endif
#endif
            }
            SEAM(pb + 3); }
        if (IN(pb + 4)) { for (int rep = 0; rep < NREPG(13); ++rep) {
#ifndef SKIP_G4
            { pg8::Gemm g{YF, BRF, TOK, DM, 512, 512, 512}; pg8::StaticOrder S; S.init(TOK, DM, X.G, X.c); pg8::EpiGate<0> E{Hb + H_GATE, HW, MERGED, DM};
              pg8::gemm_phase<pg8::EpiGate<0>, pg8::StaticOrder, true, true>(ldsl, g, S, E); }
#endif
#ifndef SKIP_G5
            { pg8::Gemm g{YH, BRH, TOK, DM, 768, 768, 768}; pg8::StaticOrder S; S.init(TOK, DM, X.G, X.c); pg8::EpiGate<1> E{Hb + H_GATE + DM, HW, MERGED, DM};
              pg8::gemm_phase<pg8::EpiGate<1>, pg8::StaticOrder, true, true>(ldsl, g, S, E); }
#endif
#ifndef SKIP_G6
            { pg8::Gemm g{YA, BRA, TOK, DM, 256, 256, 256}; pg8::StaticOrder S; S.init(TOK, DM, X.G, X.c); pg8::EpiGate<2> E{Hb + H_GATE + 2 * DM, HW, MERGED, DM};
              pg8::gemm_phase<pg8::EpiGate<2>, pg8::StaticOrder, true, true>(ldsl, g, S, E); }
#endif
            }
            SEAM(pb + 4);
        }
        if (IN(pb + 5)) { for (int rep = 0; rep < NREPG(14); ++rep) {
#ifndef SKIP_G7
            pg8::Gemm g{MERGED, WoutT, TOK, DM, DM, DM, DM}; pg8::StaticOrder S; S.init(TOK, DM, X.G, X.c); pg8::EpiResid E{out, VPRE, DM, DN_ALPHA};
            pg8::gemm_phase<pg8::EpiResid, pg8::StaticOrder, true, true>(ldsl, g, S, E);
#endif
            }
            SEAM(pb + 5);
        }
        if (IN(pb + 6)) { for (int rep = 0; rep < NREP(9); ++rep) ln_phase(X, VPRE, args.in[10] + (size_t)l * DM, args.in[11] + (size_t)l * DM, out, XA); SEAM(pb + 6); }
        if (IN(pb + 7)) { for (int rep = 0; rep < NREPG(15); ++rep) {
#ifndef SKIP_G8
            pg8::Gemm g{XA, WsT, TOK, DM, DM, DM, DM}; pg8::StaticOrder S; S.init(TOK, DM, X.G, X.c); pg8::EpiF32 E{SC, DM};
            pg8::gemm_phase<pg8::EpiF32, pg8::StaticOrder, true, true>(ldsl, g, S, E);
#endif
            }
            SEAM(pb + 7);
        }
        if (IN(pb + 8)) {
#ifndef SKIP_PEER
            if (PROBE_REP == 2 && l == 0) { peer_phase(X, SC, Ub, Vb, out, VPRE, (pbf*)(ws + WS_LB), args.in[16] + (size_t)l * DM, args.in[17] + (size_t)l * DM,
                       args.in[14] + (size_t)l * NEXP * DM, args.in[15] + (size_t)l * NEXP * DM, args.in[12] + (size_t)l * DM * DM, args.in[13] + (size_t)l * 2 * 128 * 128); __syncthreads(); }
            peer_phase(X, SC, Ub, Vb, out, out, XA, args.in[16] + (size_t)l * DM, args.in[17] + (size_t)l * DM,
                       args.in[14] + (size_t)l * NEXP * DM, args.in[15] + (size_t)l * NEXP * DM, args.in[12] + (size_t)l * DM * DM, args.in[13] + (size_t)l * 2 * 128 * 128);
#endif
            if (pb + 8 + 1 < N_PHASES) SEAM(pb + 8); }
    }
#if defined(CHECK_BRANCHES)
    grid.sync();
    if (X.c == 0) { const float* cn = (const float*)ws; const float ra = cn[0] / fmaxf(cn[1], 1e-30f), rh = cn[2] / fmaxf(cn[3], 1e-30f);
        if (!(rh < 1e-3f && cn[3] > 1000.f) && X.tid < 500) { out[X.tid] += 10.f; out[500 + X.tid] += 10.f; }
        if (!(ra < 1e-3f && cn[1] > 1000.f)) { for (int i = 1000 + X.tid; i < 4000; i += NTHR) out[i] += 10.f; } }
#endif
#undef IN
#undef SEAM
}

extern "C" void kernel_launch(void* const* d_in, const int* in_sizes, int n_in, void* d_out, int out_size, void* d_ws, size_t ws_size, hipStream_t stream) {
    static int grid = 0;
    if (grid == 0) {
        if (n_in != 18 || in_sizes[0] != TOK * DM || out_size != TOK * DM || ws_size < WS_END2) {
            fprintf(stderr, "kernel_launch: unexpected shapes (n_in %d, in0 %d, out %d, ws %zu, need %zu); nothing launched\n", n_in, n_in > 0 ? in_sizes[0] : -1, out_size, ws_size, (size_t)WS_END2); grid = -1; return; }
        int dev = 0, cus = 0, per_cu = 0;
        if (hipGetDevice(&dev) != hipSuccess || hipDeviceGetAttribute(&cus, hipDeviceAttributeMultiprocessorCount, dev) != hipSuccess) { grid = -1; return; }
        if (hipFuncSetAttribute((const void*)fwd_kernel, hipFuncAttributeMaxDynamicSharedMemorySize, LDS_BYTES) != hipSuccess) { fprintf(stderr, "kernel_launch: hipFuncSetAttribute failed\n"); grid = -1; return; }
        if (hipOccupancyMaxActiveBlocksPerMultiprocessor(&per_cu, (const void*)fwd_kernel, NTHR, LDS_BYTES) != hipSuccess || per_cu < 1) { fprintf(stderr, "kernel_launch: occupancy query says %d blocks per CU\n", per_cu); grid = -1; (void)hipGetLastError(); return; }
        grid = cus * 1;
    }
    if (grid < 0) return;
    if (hipMemsetAsync(d_ws, 0, 65536, stream) != hipSuccess) { fprintf(stderr, "kernel_launch: memset failed\n"); return; }
    Args a{};
    for (int i = 0; i < 18; ++i) a.in[i] = (const float*)d_in[i];
    a.out = (float*)d_out; a.ws = (unsigned char*)d_ws;
#if MK_ONE_LAUNCH
    a.ph_lo = 0; a.ph_hi = N_PHASES;
    void* kargs[] = {&a};
    hipError_t e = hipLaunchCooperativeKernel((const void*)fwd_kernel, dim3(grid), dim3(NTHR), kargs, LDS_BYTES, stream);
    if (e != hipSuccess) fprintf(stderr, "kernel_launch: cooperative launch failed: %s (grid %d)\n", hipGetErrorString(e), grid);
#else
    for (int ph = 0; ph < N_PHASES; ++ph) { a.ph_lo = ph; a.ph_hi = ph + 1; hipLaunchKernelGGL(fwd_kernel, dim3(grid), dim3(NTHR), LDS_BYTES, stream, a); }
#endif
}
```
